# Optimizing an MI355X kernel written in HIP

```python
import math
import jax
import jax.numpy as jnp
from jax import lax
import numpy as np

D_MODEL = 2048
BATCH = 2
SEQ = 4096
DEPTH = 4

GRID_W = 64
CTX_LEN = 256
N_MIXERS = 4
MIXER_HYENA = 0
MIXER_RWKV = 1
MIXER_MLA = 2
MIXER_GQA = 3
N_MOD = 9
D_FF = 5632
NORM_EPS = 1e-6
Q_BLOCK = 128
ROPE_THETA = 10000.0

HY_ORDER = 2
HY_EMB_DIM = 33
HY_FILTER_HIDDEN = 64
HY_DECAY_TARGET = 1e-2
HY_DECAY_PCT_SHORT = 0.3
HY_DECAY_PCT_LONG = 1.5

RW_HEAD = 64
RW_HEADS = D_MODEL // RW_HEAD
RW_DECAY_LORA = 96
RW_A_LORA = 96
RW_GATE_LORA = 256
RW_GN_EPS = 1e-5 * RW_HEAD
RW_N_SHIFT = 6

MLA_HEADS = 16
MLA_NOPE = 128
MLA_ROPE = 64
MLA_V = 128
MLA_Q_RANK = 512
MLA_KV_RANK = 512

GQA_HEADS = 16
GQA_KV_HEADS = 8
GQA_HEAD = 128
GQA_Q_DIM = GQA_HEADS * GQA_HEAD

kernel_name = "hybrid_interleaved_diffusion_trunk"


def _count(m):
    return len(range(m, DEPTH, N_MIXERS))


def _ctx_needed_after(i):
    return any(j % N_MIXERS != MIXER_HYENA for j in range(i + 1, DEPTH))


def rms_norm(u, g):
    uf = u.astype(jnp.float32)
    y = uf * lax.rsqrt(jnp.mean(uf * uf, -1, keepdims=True) + NORM_EPS)
    return (y * g.astype(jnp.float32)).astype(u.dtype)


def adaln(cvec, w, b):
    m = jax.nn.silu(cvec) @ w + b
    return m.reshape(cvec.shape[0], N_MOD, 1, D_MODEL)


def modulated_norm(h, mods, s, g):
    return rms_norm(h, g) * (1.0 + mods[:, 3 * s + 1]) + mods[:, 3 * s]


def macaron_half_ffn(h, mods, s, g, w_gu, w_down):
    n = modulated_norm(h, mods, s, g)
    a, b = jnp.split(n @ w_gu, 2, axis=-1)
    return h + 0.5 * mods[:, 3 * s + 2] * ((jax.nn.silu(a) * b) @ w_down)


def shift_prev(u):
    return jnp.pad(u, ((0, 0), (1, 0), (0, 0)))[:, :-1]


def shift_next(u):
    return jnp.pad(u, ((0, 0), (0, 1), (0, 0)))[:, 1:]


def grid_positions(T):
    rows = T // GRID_W
    row = jnp.repeat(jnp.arange(rows, dtype=jnp.int32), GRID_W)
    col = jnp.tile(jnp.arange(GRID_W, dtype=jnp.int32), rows)
    return row, col


def rope_1d(u, pos):
    half = u.shape[-1] // 2
    inv_freq = ROPE_THETA ** (-jnp.arange(half, dtype=jnp.float32) / half)
    ang = pos.astype(jnp.float32)[:, None] * inv_freq[None]
    cos = jnp.cos(ang)[None, :, None]
    sin = jnp.sin(ang)[None, :, None]
    uf = u.astype(jnp.float32)
    u1, u2 = uf[..., :half], uf[..., half:]
    return jnp.concatenate([u1 * cos - u2 * sin, u1 * sin + u2 * cos], -1).astype(u.dtype)


def rope_2d(u, row, col):
    d = u.shape[-1] // 2
    return jnp.concatenate([rope_1d(u[..., :d], row), rope_1d(u[..., d:], col)], -1)


def block_attention(q, k, v, scale):
    B, T, H, dq = q.shape
    Hkv, dv = k.shape[2], v.shape[-1]
    G = H // Hkv
    nb = T // Q_BLOCK
    qb = jnp.moveaxis(q.reshape(B, nb, Q_BLOCK, Hkv, G, dq), 1, 0)

    def one(q_blk):
        s = jnp.einsum('bqhgd,bkhd->bhgqk', q_blk, k).astype(jnp.float32) * scale
        p = jax.nn.softmax(s, axis=-1).astype(v.dtype)
        return jnp.einsum('bhgqk,bkhd->bqhgd', p, v)

    o = lax.map(one, qb)
    return jnp.moveaxis(o, 0, 1).reshape(B, T, H * dv)


def short_conv3(u, w, b):
    return shift_prev(u) * w[0] + u * w[1] + shift_next(u) * w[2] + b


def hyena_filter_spectra(L, f_w1, f_b1, f_w2, f_b2, f_w3, sin_freq):
    f32 = jnp.float32
    bands = (HY_EMB_DIM - 1) // 2
    t = jnp.linspace(0.0, 1.0, L, dtype=f32)[:, None]
    w = (2.0 * math.pi / L) * jnp.arange(L, dtype=f32)[:, None]
    f = jnp.linspace(1e-4, bands - 1, bands, dtype=f32)[None]
    z = jnp.concatenate([t, jnp.cos(f * w), -jnp.sin(f * w)], -1)
    h = jnp.sin(sin_freq[0].astype(f32) * (z @ f_w1.astype(f32) + f_b1.astype(f32)))
    h = jnp.sin(sin_freq[1].astype(f32) * (h @ f_w2.astype(f32) + f_b2.astype(f32)))
    h = (h @ f_w3.astype(f32)).reshape(L, HY_ORDER, 2, D_MODEL)
    deltas = jnp.abs(jnp.linspace(math.log(HY_DECAY_TARGET) / HY_DECAY_PCT_SHORT,
                                  math.log(HY_DECAY_TARGET) / HY_DECAY_PCT_LONG, D_MODEL, dtype=f32))
    h = h * jnp.exp(-t * deltas)[:, None, None, :]
    fwd = h[:, :, 0]
    bwd = h[1:, :, 1][::-1]
    g = jnp.concatenate([fwd, jnp.zeros((1, HY_ORDER, D_MODEL), f32), bwd], 0)
    g = g * lax.rsqrt(jnp.sum(g * g, 0, keepdims=True) + 1e-12)
    return jnp.fft.rfft(g, axis=0)


def fft_long_conv(u, spec, skip):
    L = u.shape[1]
    uf = u.astype(jnp.float32)
    y = jnp.fft.irfft(jnp.fft.rfft(uf, n=2 * L, axis=1) * spec[None], n=2 * L, axis=1)[:, :L]
    return (y + uf * skip.astype(jnp.float32)).astype(u.dtype)


def hyena_sequence(h, w_in, b_in, conv_w, conv_b, f_w1, f_b1, f_w2, f_b2, f_w3, sin_freq, skip, w_out, b_out):
    L = h.shape[1]
    u = short_conv3(h @ w_in + b_in, conv_w, conv_b)
    v, x1, x2 = jnp.split(u, 3, axis=-1)
    spec = hyena_filter_spectra(L, f_w1, f_b1, f_w2, f_b2, f_w3, sin_freq)
    z = v
    for n, gate in enumerate((x1, x2)):
        z = gate * fft_long_conv(z, spec[:, n], skip[n])
    return z @ w_out + b_out


def rwkv7_token_tensors(h, mix, w_rkv, w0, w1, w2, a0, a1, a2, g1, g2, k_k, k_a):
    B, L, _ = h.shape
    f32 = jnp.float32

    def heads(t):
        return t.astype(f32).reshape(B, L, RW_HEADS, RW_HEAD)

    d_prev = shift_prev(h) - h
    d_next = shift_next(h) - h
    xs = h[:, :, None] + d_prev[:, :, None] * mix[0] + d_next[:, :, None] * mix[1]
    xr, xw, xk, xv, xa, xg = (xs[:, :, n] for n in range(RW_N_SHIFT))
    r = heads(xr @ w_rkv[0])
    k = xk @ w_rkv[1]
    v = heads(xv @ w_rkv[2])
    g = jax.nn.sigmoid(xg @ g1) @ g2
    kk = heads(k * k_k)
    kk = kk * lax.rsqrt(jnp.sum(kk * kk, -1, keepdims=True) + 1e-12)
    dirs = []
    for d in range(2):
        log_w = -jax.nn.softplus(-(w0[d] + jnp.tanh(xw @ w1[d]) @ w2[d])) - 0.5
        decay = heads(jnp.exp(-jnp.exp(log_w.astype(f32))))
        a = jax.nn.sigmoid(a0[d] + (xa @ a1[d]) @ a2[d])
        k_d = heads(k * (1.0 + (a - 1.0) * k_a))
        dirs.append((decay, k_d, -kk, kk * heads(a)))
    return r, v, g, dirs


def wkv7_scan(s0, r, decay, k, v, aa, bb, reverse):
    def step(s, inp):
        r_t, w_t, k_t, v_t, a_t, b_t = inp
        sa = jnp.einsum('bhvk,bhk->bhv', s, a_t)
        s = s * w_t[:, :, None, :] + sa[..., None] * b_t[:, :, None, :] + v_t[..., None] * k_t[:, :, None, :]
        return s, jnp.einsum('bhvk,bhk->bhv', s, r_t)

    xs = tuple(jnp.moveaxis(t, 1, 0) for t in (r, decay, k, v, aa, bb))
    s_fin, ys = lax.scan(step, s0, xs, reverse=reverse)
    return jnp.moveaxis(ys, 0, 1), s_fin


def rwkv7_readout(r, v, g, dirs, ys, r_k, ln_w, ln_b, w_o, dtype):
    B, L = r.shape[:2]
    f32 = jnp.float32
    y = ys[0] + ys[1]
    mu = jnp.mean(y, -1, keepdims=True)
    var = jnp.mean(jnp.square(y - mu), -1, keepdims=True)
    y = ((y - mu) * lax.rsqrt(var + RW_GN_EPS)).reshape(B, L, D_MODEL) * ln_w.astype(f32) + ln_b.astype(f32)
    rk = r * r_k.astype(f32)
    bonus = (jnp.sum(rk * dirs[0][1], -1, keepdims=True) + jnp.sum(rk * dirs[1][1], -1, keepdims=True)) * v
    y = y + bonus.reshape(B, L, D_MODEL)
    return (y.astype(dtype) * g) @ w_o


def rwkv7_mixer(hl, hc, ctx_out, mix, w_rkv, w0, w1, w2, a0, a1, a2, g1, g2, k_k, k_a, r_k, ln_w, ln_b, w_o):
    shared = (mix, w_rkv, w0, w1, w2, a0, a1, a2, g1, g2, k_k, k_a)
    r_l, v_l, g_l, dirs_l = rwkv7_token_tensors(hl, *shared)
    r_c, v_c, g_c, dirs_c = rwkv7_token_tensors(hc, *shared)
    s_zero = jnp.zeros((hl.shape[0], RW_HEADS, RW_HEAD, RW_HEAD), jnp.float32)
    ys_l, ys_c = [], []
    for d, rev in enumerate((False, True)):
        decay_c, k_c, aa_c, bb_c = dirs_c[d]
        y_c, s_ctx = wkv7_scan(s_zero, r_c, decay_c, k_c, v_c, aa_c, bb_c, rev)
        decay_l, k_l, aa_l, bb_l = dirs_l[d]
        y_l, _ = wkv7_scan(s_ctx, r_l, decay_l, k_l, v_l, aa_l, bb_l, rev)
        ys_c.append(y_c)
        ys_l.append(y_l)
    yl = rwkv7_readout(r_l, v_l, g_l, dirs_l, ys_l, r_k, ln_w, ln_b, w_o, hl.dtype)
    yc = rwkv7_readout(r_c, v_c, g_c, dirs_c, ys_c, r_k, ln_w, ln_b, w_o, hc.dtype) if ctx_out else None
    return yl, yc


def mla_queries(h, w_down, q_norm_g, w_uq, pos):
    B, L, _ = h.shape
    cq = rms_norm(h @ w_down[:, :MLA_Q_RANK], q_norm_g)
    q = (cq @ w_uq).reshape(B, L, MLA_HEADS, MLA_NOPE + MLA_ROPE)
    q_pe = q[..., MLA_NOPE:]
    if pos is not None:
        q_pe = rope_2d(q_pe, *pos)
    return jnp.concatenate([q[..., :MLA_NOPE], q_pe], -1)


def mla_keys_values(h, w_down, kv_norm_g, w_ukv, pos):
    B, L, _ = h.shape
    ckv = h @ w_down[:, MLA_Q_RANK:]
    c_kv = rms_norm(ckv[..., :MLA_KV_RANK], kv_norm_g)
    k_pe = ckv[..., MLA_KV_RANK:][:, :, None, :]
    if pos is not None:
        k_pe = rope_2d(k_pe, *pos)
    kv = (c_kv @ w_ukv).reshape(B, L, MLA_HEADS, MLA_NOPE + MLA_V)
    k = jnp.concatenate([kv[..., :MLA_NOPE], jnp.broadcast_to(k_pe, (B, L, MLA_HEADS, MLA_ROPE))], -1)
    return k, kv[..., MLA_NOPE:]


def mla_mixer(hl, hc, lat_pos, ctx_out, w_down, q_norm_g, w_uq, kv_norm_g, w_ukv, w_o):
    scale = (MLA_NOPE + MLA_ROPE) ** -0.5
    k_c, v_c = mla_keys_values(hc, w_down, kv_norm_g, w_ukv, None)
    k_l, v_l = mla_keys_values(hl, w_down, kv_norm_g, w_ukv, lat_pos)
    q_l = mla_queries(hl, w_down, q_norm_g, w_uq, lat_pos)
    yl = block_attention(q_l, jnp.concatenate([k_c, k_l], 1), jnp.concatenate([v_c, v_l], 1), scale) @ w_o
    yc = None
    if ctx_out:
        yc = block_attention(mla_queries(hc, w_down, q_norm_g, w_uq, None), k_c, v_c, scale) @ w_o
    return yl, yc


def gqa_queries(h, w_qkv, q_norm_g, pos):
    B, L, _ = h.shape
    q = rms_norm((h @ w_qkv[:, :GQA_Q_DIM]).reshape(B, L, GQA_HEADS, GQA_HEAD), q_norm_g)
    if pos is not None:
        q = rope_2d(q, *pos)
    return q


def gqa_keys_values(h, w_qkv, k_norm_g, pos):
    B, L, _ = h.shape
    kv = (h @ w_qkv[:, GQA_Q_DIM:]).reshape(B, L, 2, GQA_KV_HEADS, GQA_HEAD)
    k = rms_norm(kv[:, :, 0], k_norm_g)
    if pos is not None:
        k = rope_2d(k, *pos)
    return k, kv[:, :, 1]


def gqa_mixer(hl, hc, lat_pos, ctx_out, w_qkv, q_norm_g, k_norm_g, w_o):
    scale = GQA_HEAD ** -0.5
    k_c, v_c = gqa_keys_values(hc, w_qkv, k_norm_g, None)
    k_l, v_l = gqa_keys_values(hl, w_qkv, k_norm_g, lat_pos)
    q_l = gqa_queries(hl, w_qkv, q_norm_g, lat_pos)
    yl = block_attention(q_l, jnp.concatenate([k_c, k_l], 1), jnp.concatenate([v_c, v_l], 1), scale) @ w_o
    yc = None
    if ctx_out:
        yc = block_attention(gqa_queries(hc, w_qkv, q_norm_g, None), k_c, v_c, scale) @ w_o
    return yl, yc


def setup_inputs(seed: int = 0) -> dict:
    key = jax.random.key(seed)
    keys = iter(jax.random.split(key, 96))
    f32 = jnp.float32
    D = D_MODEL

    def nrm(shape, scale):
        return jax.random.normal(next(keys), shape, f32) * scale

    def near_one(shape):
        return 1.0 + nrm(shape, 0.02)

    def unif(shape, lo, hi):
        return jax.random.uniform(next(keys), shape, f32, lo, hi)

    nA, nB, nC, nD = (_count(m) for m in range(N_MIXERS))
    return {
        "x": nrm((BATCH, SEQ, D), 1.0),
        "c": nrm((BATCH, D), 1.0),
        "ctx": nrm((BATCH, CTX_LEN, D), 1.0),
        "c_ctx": nrm((D,), 1.0),
        "ada_w": nrm((DEPTH, D, N_MOD * D), 0.5 * D ** -0.5),
        "ada_b": nrm((DEPTH, N_MOD * D), 0.02),
        "norm_g": near_one((DEPTH, 3, D)),
        "ffn_w_gu": nrm((DEPTH, 2, D, 2 * D_FF), D ** -0.5),
        "ffn_w_down": nrm((DEPTH, 2, D_FF, D), D_FF ** -0.5),
        "hy_w_in": nrm((nA, D, 3 * D), D ** -0.5),
        "hy_b_in": nrm((nA, 3 * D), 0.02),
        "hy_conv_w": nrm((nA, 3, 3 * D), 3 ** -0.5),
        "hy_conv_b": nrm((nA, 3 * D), 0.02),
        "hy_f_w1": nrm((nA, HY_EMB_DIM, HY_FILTER_HIDDEN), HY_EMB_DIM ** -0.5),
        "hy_f_b1": nrm((nA, HY_FILTER_HIDDEN), 0.1),
        "hy_f_w2": nrm((nA, HY_FILTER_HIDDEN, HY_FILTER_HIDDEN), HY_FILTER_HIDDEN ** -0.5),
        "hy_f_b2": nrm((nA, HY_FILTER_HIDDEN), 0.1),
        "hy_f_w3": nrm((nA, HY_FILTER_HIDDEN, HY_ORDER * 2 * D), HY_FILTER_HIDDEN ** -0.5),
        "hy_sin_freq": near_one((nA, 2, HY_FILTER_HIDDEN)),
        "hy_skip": nrm((nA, HY_ORDER, D), 0.5),
        "hy_w_out": nrm((nA, D, D), D ** -0.5),
        "hy_b_out": nrm((nA, D), 0.02),
        "rw_mix": unif((nB, 2, RW_N_SHIFT, D), 0.0, 0.5),
        "rw_w_rkv": nrm((nB, 3, D, D), D ** -0.5),
        "rw_w0": unif((nB, 2, D), -6.5, -1.5),
        "rw_w1": nrm((nB, 2, D, RW_DECAY_LORA), D ** -0.5),
        "rw_w2": nrm((nB, 2, RW_DECAY_LORA, D), 0.3 * RW_DECAY_LORA ** -0.5),
        "rw_a0": nrm((nB, 2, D), 0.1),
        "rw_a1": nrm((nB, 2, D, RW_A_LORA), D ** -0.5),
        "rw_a2": nrm((nB, 2, RW_A_LORA, D), 0.5 * RW_A_LORA ** -0.5),
        "rw_g1": nrm((nB, D, RW_GATE_LORA), D ** -0.5),
        "rw_g2": nrm((nB, RW_GATE_LORA, D), RW_GATE_LORA ** -0.5),
        "rw_k_k": unif((nB, D), 0.7, 1.0),
        "rw_k_a": near_one((nB, D)),
        "rw_r_k": nrm((nB, RW_HEADS, RW_HEAD), 0.1),
        "rw_ln_w": near_one((nB, D)),
        "rw_ln_b": nrm((nB, D), 0.02),
        "rw_w_o": nrm((nB, D, D), D ** -0.5),
        "mla_w_down": nrm((nC, D, MLA_Q_RANK + MLA_KV_RANK + MLA_ROPE), D ** -0.5),
        "mla_q_norm_g": near_one((nC, MLA_Q_RANK)),
        "mla_w_uq": nrm((nC, MLA_Q_RANK, MLA_HEADS * (MLA_NOPE + MLA_ROPE)), MLA_Q_RANK ** -0.5),
        "mla_kv_norm_g": near_one((nC, MLA_KV_RANK)),
        "mla_w_ukv": nrm((nC, MLA_KV_RANK, MLA_HEADS * (MLA_NOPE + MLA_V)), MLA_KV_RANK ** -0.5),
        "mla_w_o": nrm((nC, MLA_HEADS * MLA_V, D), (MLA_HEADS * MLA_V) ** -0.5),
        "gqa_w_qkv": nrm((nD, D, (GQA_HEADS + 2 * GQA_KV_HEADS) * GQA_HEAD), D ** -0.5),
        "gqa_q_norm_g": near_one((nD, GQA_HEAD)),
        "gqa_k_norm_g": near_one((nD, GQA_HEAD)),
        "gqa_w_o": nrm((nD, GQA_HEADS * GQA_HEAD, D), (GQA_HEADS * GQA_HEAD) ** -0.5),
        "final_g": near_one((D,)),
    }


def reference(x, c, ctx, c_ctx, ada_w, ada_b, norm_g, ffn_w_gu, ffn_w_down,
              hy_w_in, hy_b_in, hy_conv_w, hy_conv_b, hy_f_w1, hy_f_b1, hy_f_w2, hy_f_b2, hy_f_w3,
              hy_sin_freq, hy_skip, hy_w_out, hy_b_out,
              rw_mix, rw_w_rkv, rw_w0, rw_w1, rw_w2, rw_a0, rw_a1, rw_a2, rw_g1, rw_g2,
              rw_k_k, rw_k_a, rw_r_k, rw_ln_w, rw_ln_b, rw_w_o,
              mla_w_down, mla_q_norm_g, mla_w_uq, mla_kv_norm_g, mla_w_ukv, mla_w_o,
              gqa_w_qkv, gqa_q_norm_g, gqa_k_norm_g, gqa_w_o,
              final_g):
    lat_pos = grid_positions(x.shape[1])
    for i in range(DEPTH):
        m, j = i % N_MIXERS, i // N_MIXERS
        ctx_out = _ctx_needed_after(i)
        ctx_in = ctx_out or m != MIXER_HYENA
        mod_l = adaln(c, ada_w[i], ada_b[i])
        x = macaron_half_ffn(x, mod_l, 0, norm_g[i, 0], ffn_w_gu[i, 0], ffn_w_down[i, 0])
        hl = modulated_norm(x, mod_l, 1, norm_g[i, 1])
        if ctx_in:
            mod_c = adaln(c_ctx[None], ada_w[i], ada_b[i])
            ctx = macaron_half_ffn(ctx, mod_c, 0, norm_g[i, 0], ffn_w_gu[i, 0], ffn_w_down[i, 0])
            hc = modulated_norm(ctx, mod_c, 1, norm_g[i, 1])
        if m == MIXER_HYENA:
            hy = (hy_w_in[j], hy_b_in[j], hy_conv_w[j], hy_conv_b[j], hy_f_w1[j], hy_f_b1[j], hy_f_w2[j],
                  hy_f_b2[j], hy_f_w3[j], hy_sin_freq[j], hy_skip[j], hy_w_out[j], hy_b_out[j])
            yl = hyena_sequence(hl, *hy)
            yc = hyena_sequence(hc, *hy) if ctx_out else None
        elif m == MIXER_RWKV:
            yl, yc = rwkv7_mixer(hl, hc, ctx_out, rw_mix[j], rw_w_rkv[j], rw_w0[j], rw_w1[j], rw_w2[j],
                                 rw_a0[j], rw_a1[j], rw_a2[j], rw_g1[j], rw_g2[j], rw_k_k[j], rw_k_a[j],
                                 rw_r_k[j], rw_ln_w[j], rw_ln_b[j], rw_w_o[j])
        elif m == MIXER_MLA:
            yl, yc = mla_mixer(hl, hc, lat_pos, ctx_out, mla_w_down[j], mla_q_norm_g[j], mla_w_uq[j],
                               mla_kv_norm_g[j], mla_w_ukv[j], mla_w_o[j])
        else:
            yl, yc = gqa_mixer(hl, hc, lat_pos, ctx_out, gqa_w_qkv[j], gqa_q_norm_g[j], gqa_k_norm_g[j], gqa_w_o[j])
        x = x + mod_l[:, 5] * yl
        x = macaron_half_ffn(x, mod_l, 2, norm_g[i, 2], ffn_w_gu[i, 1], ffn_w_down[i, 1])
        if ctx_out:
            ctx = ctx + mod_c[:, 5] * yc
            ctx = macaron_half_ffn(ctx, mod_c, 2, norm_g[i, 2], ffn_w_gu[i, 1], ffn_w_down[i, 1])
    return rms_norm(x, final_g)
```

```cpp
#include <hip/hip_runtime.h>
#include <stdint.h>
#include <stdio.h>

#define LAS __attribute__((address_space(3)))
typedef unsigned short bf16_t;
typedef short bf16x8 __attribute__((ext_vector_type(8)));
typedef short s16x4 __attribute__((ext_vector_type(4)));
typedef float f32x2 __attribute__((ext_vector_type(2)));
typedef float f32x4 __attribute__((ext_vector_type(4)));
typedef float f32x16 __attribute__((ext_vector_type(16)));
typedef unsigned u32x2 __attribute__((ext_vector_type(2)));
typedef unsigned u32x4 __attribute__((ext_vector_type(4)));

constexpr int DM = 2048, NB = 2, SEQ = 4096, CTXL = 256, TPB = SEQ + CTXL  , ROWS = NB * TPB  ;
constexpr int NPAN = ROWS / 256  , PPB = TPB / 256  ;
constexpr int FF = 5632, NMOD = 9, NADA = NMOD * DM  ;
constexpr int NWAVES = 8, NTHR = 512;

__device__ __forceinline__ unsigned cvt_pk_bf16(float lo, float hi) { unsigned r; asm volatile("v_cvt_pk_bf16_f32 %0, %1, %2" : "=v"(r) : "v"(lo), "v"(hi)); return r; }
__device__ __forceinline__ float bf2f(unsigned short b) { return __uint_as_float(((unsigned)b) << 16); }
__device__ __forceinline__ float wave_sum(float v) {
#pragma unroll
    for (int o = 1; o < 64; o <<= 1) v += __shfl_xor(v, o);
    return v;
}
__device__ __forceinline__ float fast_sigmoid(float x) { return __builtin_amdgcn_rcpf(1.0f + __expf(-x)); }
#define LDS_WAIT() asm volatile("s_waitcnt lgkmcnt(0)" ::: "memory")
#define VM_WAIT() asm volatile("s_waitcnt vmcnt(0)" ::: "memory")

#define XB_TMO      128
#define XB_XCNT(j)  (256  + 64 * (j))
#define XB_XSUB(j)  (1280 + 64 * (j))
#define XB_XGEN(j)  (2304 + 64 * (j))
#define XB_TOP      3328
#define XB_TOPGEN   3392
#define XCD_BAR_WORDS 3456
#define XB_SPIN_CAP (1u << 18)
__device__ __forceinline__ unsigned xb_ld(unsigned* p)              { return __hip_atomic_load(p, __ATOMIC_RELAXED, __HIP_MEMORY_SCOPE_AGENT); }
__device__ __forceinline__ unsigned xb_add(unsigned* p, unsigned v) { return __hip_atomic_fetch_add(p, v, __ATOMIC_RELAXED, __HIP_MEMORY_SCOPE_AGENT); }
__device__ __forceinline__ unsigned xb_xcc_id() { return (unsigned)__builtin_amdgcn_s_getreg((3 << 11) | 20) & 0xFu; }
#define XB_SPIN(cond, bar) do { unsigned _sp = 0; while (cond) { __builtin_amdgcn_s_sleep(1); \
    if ((++_sp & 255u) == 0u) { if (xb_ld(&(bar)[XB_TMO])) break; if (_sp > XB_SPIN_CAP) { atomicAdd(&(bar)[XB_TMO], 1u); break; } } } } while (0)
struct XcdBarrier { unsigned* bar; unsigned x; volatile LAS unsigned* st; };
__device__ __forceinline__ XcdBarrier xcd_barrier_post(unsigned* bar, volatile LAS unsigned* st) {
    XcdBarrier b; b.bar = bar; b.x = xb_xcc_id(); b.st = st;
    if (threadIdx.x == 0) (void)xb_add(&bar[XB_XCNT(b.x)], 1u);
    return b;
}
__device__ __forceinline__ void xcd_barrier_complete(unsigned* bar, unsigned x, unsigned& nloc, unsigned& nx) {
    const unsigned G = gridDim.x * gridDim.y * gridDim.z;
    unsigned sum, cnt, mine, sp = 0u;
    for (;;) {
        sum = 0u; cnt = 0u; mine = 0u;
#pragma unroll
        for (unsigned j = 0; j < 16; ++j) { const unsigned c = xb_ld(&bar[XB_XCNT(j)]); sum += c; cnt += (c > 0u) ? 1u : 0u; mine = (j == x) ? c : mine; }
        if (sum == G) break;
        __builtin_amdgcn_s_sleep(1);
        if ((++sp & 255u) == 0u) { if (xb_ld(&bar[XB_TMO])) break; if (sp > XB_SPIN_CAP) { atomicAdd(&bar[XB_TMO], 1u); break; } }
    }
    nloc = mine > 0u ? mine : 1u; nx = cnt > 0u ? cnt : 1u;
}
__device__ __forceinline__ void xcd_barrier(const XcdBarrier& b) {
    asm volatile("s_waitcnt vmcnt(0)" ::: "memory");
    __syncthreads();
    if (threadIdx.x == 0) {
        unsigned* bar = b.bar;
        __builtin_amdgcn_s_waitcnt(0);
        unsigned nloc = b.st[0], nx = b.st[1];
        if (nloc == 0u) { xcd_barrier_complete(bar, b.x, nloc, nx); b.st[0] = nloc; b.st[1] = nx; }
        const unsigned old = xb_add(&bar[XB_XSUB(b.x)], 1u);
        const unsigned gen = old / nloc;
        if (old + 1u == (gen + 1u) * nloc) {
            __builtin_amdgcn_fence(__ATOMIC_RELEASE, "agent");
            asm volatile("s_waitcnt vmcnt(0)" ::: "memory");
            const unsigned og = xb_add(&bar[XB_TOP], 1u);
            const unsigned tg = og / nx;
            if (og + 1u == (tg + 1u) * nx) xb_add(&bar[XB_TOPGEN], 1u);
            else XB_SPIN(xb_ld(&bar[XB_TOPGEN]) == tg, bar);
            __builtin_amdgcn_fence(__ATOMIC_ACQUIRE, "agent");
            xb_add(&bar[XB_XGEN(b.x)], 1u);
            asm volatile("s_waitcnt vmcnt(0)" ::: "memory");
        } else {
            XB_SPIN(xb_ld(&bar[XB_XGEN(b.x)]) == gen, bar);
            __builtin_amdgcn_fence(__ATOMIC_ACQUIRE, "agent");
            asm volatile("s_waitcnt vmcnt(0)" ::: "memory");
        }
    }
    __syncthreads();
}

namespace pg8 {
constexpr int BM = 256, BK = 64, HALF = 128, HTB = HALF * BK * 2, STAGE_BYTES = 8 * HTB, NXCD = 8, WGM = 8;
__host__ __device__ __forceinline__ int lds_byte(int r, int c) { const int st = (r >> 4) * 2 + (c >> 5), rr = r & 15, cc = c & 31, ob = rr * 64 + cc * 2; return st * 1024 + (ob ^ (((ob >> 9) & 1) << 5)); }
__host__ __device__ __forceinline__ void stage_rc(int b, int& R, int& C) { const int st = b / 1024, sb = b % 1024, swz = sb ^ (((sb >> 9) & 1) << 5); R = (st >> 1) * 16 + swz / 64; C = (st & 1) * 32 + (swz % 64) / 2; }
__host__ __device__ __forceinline__ int perm32(int rho) { const int n = rho >> 4, i = rho & 15; return 8 * (i >> 2) + 4 * n + (i & 3); }

struct Unit { int pm, pn, g, lm, ln, ks, ksub; };
struct Gemm { const bf16_t* A; const bf16_t* Bt; int K; };

template <int... V>
struct TSched {
    static constexpr int NG = sizeof...(V) / 6;
    int G, c;
    __device__ __forceinline__ void init(int G_, int c_) { G = G_; c = c_; }
    __device__ __forceinline__ bool next(int i, Unit& u) const {
        constexpr int v[sizeof...(V)] = {V...};
        const int L = i * G + c;
        int g = 0, b = 0, nM = 1, nN = 1, pm0 = 0, pn0 = 0, ks = 1, rm = 0, base = 0;
#pragma unroll
        for (int k = 0; k < NG; ++k) { if (L >= base) { g = k; b = base; nM = v[6 * k]; nN = v[6 * k + 1]; pm0 = v[6 * k + 2]; pn0 = v[6 * k + 3]; ks = v[6 * k + 4]; rm = v[6 * k + 5]; } base += v[6 * k] * v[6 * k + 1] * v[6 * k + 4]; }
        if (L >= base) return false;
        const int nwg = nM * nN; const int lloc = L - b; int wgid = lloc / ks; const int ksub = lloc - wgid * ks;
        { const int q = nwg / NXCD, r = nwg % NXCD, xcd = wgid % NXCD, off = wgid / NXCD; wgid = (xcd < r ? xcd * (q + 1) : r * (q + 1) + (xcd - r) * q) + off; }
        const int nig = WGM * nN, gid = wgid / nig, fm = gid * WGM, gsz = (nM - fm) < WGM ? (nM - fm) : WGM;
        int lm = fm + ((wgid % nig) % gsz); const int ln = (wgid % nig) / gsz;
        if (rm == 1) lm = lm + 1 + (lm >= 16 ? 1 : 0);
        if (rm == 2) lm = lm * PPB;
        u.g = g; u.lm = lm; u.ln = ln; u.pm = pm0 + lm; u.pn = pn0 + ln; u.ks = ks; u.ksub = ksub; return true;
    }
};

template <class Epi, class Sched>
__device__ __forceinline__ void gemm_phase(LAS unsigned char* lds, const Gemm g, const Sched& S, const Epi& E) {
    const int tid = threadIdx.x, wid = __builtin_amdgcn_readfirstlane(tid >> 6), lane = tid & 63, wr = wid >> 2, wc = wid & 3, fr = lane & 15, fq = lane >> 4;
    const int K = g.K, ntf = K / BK;
    unsigned voffA[2], voffB[2];
#pragma unroll
    for (int i = 0; i < 2; ++i) { int R, C; stage_rc(tid * 16 + i * 8192, R, C); const int Rb = (R & ~31) + perm32(R & 31);
        voffA[i] = (unsigned)(R * K + C) * 2u; voffB[i] = (unsigned)(Rb * K + C) * 2u; }
    const size_t kstep = (size_t)(BK * 2);
    const size_t hstep = (size_t)HALF * K * 2;
    const size_t tstep = 2 * hstep;
    const unsigned ldsw = (unsigned)wid * 1024u;
    const int aoff = lds_byte(wr * 64 + fr, fq * 8), boff = lds_byte(wc * 32 + fr, fq * 8);
#define PG8_SA(b, h) (((b) * 2 + (h)) * HTB)
#define PG8_SB(b, h) ((4 + (b) * 2 + (h)) * HTB)
#define PG8_STAGE(bufoff, gbase, voff) do { _Pragma("unroll") for (int _i = 0; _i < 2; ++_i) \
        __builtin_amdgcn_global_load_lds((const unsigned*)((const char*)(gbase) + (voff)[_i]), (LAS unsigned*)(lds + (bufoff) + ldsw + _i * 8192), 16, 0, 0); } while (0)
#define PG8_LDA(dst, b, h) do { _Pragma("unroll") for (int m = 0; m < 4; ++m) _Pragma("unroll") for (int k = 0; k < 2; ++k) dst[m][k] = *(const LAS bf16x8*)(lds + PG8_SA(b, h) + aoff + m * 2048 + k * 1024); } while (0)
#define PG8_LDB(dst, b, h) do { _Pragma("unroll") for (int n = 0; n < 2; ++n) _Pragma("unroll") for (int k = 0; k < 2; ++k) dst[n][k] = *(const LAS bf16x8*)(lds + PG8_SB(b, h) + boff + n * 2048 + k * 1024); } while (0)
#define PG8_MMA(ai, bj, At, Bt) do { __builtin_amdgcn_s_setprio(1); _Pragma("unroll") for (int m = 0; m < 4; ++m) _Pragma("unroll") for (int n = 0; n < 2; ++n) _Pragma("unroll") for (int k = 0; k < 2; ++k) \
        acc[ai][bj][m][n] = __builtin_amdgcn_mfma_f32_16x16x32_bf16(Bt[n][k], At[m][k], acc[ai][bj][m][n], 0, 0, 0); __builtin_amdgcn_s_setprio(0); } while (0)
#define PG8_WAIT_V(n) asm volatile("s_waitcnt vmcnt(" #n ")" ::: "memory")
#define PG8_WAIT_L(n) asm volatile("s_waitcnt lgkmcnt(" #n ")" ::: "memory")
#define PG8_BAR __builtin_amdgcn_s_barrier()
#define PG8_SCHED __builtin_amdgcn_sched_barrier(0)
    Unit cur, nxt; int ui = 0;
    if (!S.next(0, cur)) return;
    f32x4 acc[2][2][4][2];
#pragma unroll
    for (int a = 0; a < 2; ++a)
#pragma unroll
        for (int b = 0; b < 2; ++b)
#pragma unroll
            for (int m = 0; m < 4; ++m)
#pragma unroll
                for (int n = 0; n < 2; ++n) acc[a][b][m][n] = (f32x4){0.f, 0.f, 0.f, 0.f};
    bf16x8 At[4][2], B0[2][2], B1[2][2];
    int nt = ntf / cur.ks;
    const char* cA = (const char*)g.A + (size_t)cur.pm * tstep + (size_t)(cur.ksub * nt) * kstep; const char* cB = (const char*)g.Bt + (size_t)cur.pn * tstep + (size_t)(cur.ksub * nt) * kstep;
    PG8_STAGE(PG8_SB(0, 0), cB, voffB); PG8_STAGE(PG8_SA(0, 0), cA, voffA); PG8_STAGE(PG8_SB(0, 1), cB + hstep, voffB); PG8_STAGE(PG8_SA(0, 1), cA + hstep, voffA);
    if (wr == 1) PG8_BAR;
    PG8_WAIT_V(4); PG8_BAR;
    PG8_STAGE(PG8_SB(1, 0), cB + kstep, voffB); PG8_STAGE(PG8_SA(1, 0), cA + kstep, voffA); PG8_STAGE(PG8_SB(1, 1), cB + hstep + kstep, voffB);
    PG8_WAIT_V(6); PG8_BAR;
    for (;;) {
        const bool has_next = S.next(ui + 1, nxt);
        const int nnt = has_next ? ntf / nxt.ks : nt; const size_t nko = has_next ? (size_t)(nxt.ksub * nnt) * kstep : 0;
        const char* nA = has_next ? (const char*)g.A + (size_t)nxt.pm * tstep + nko : cA; const char* nB = has_next ? (const char*)g.Bt + (size_t)nxt.pn * tstep + nko : cB;
        for (int t = 0; t < nt; t += 2) {
            const bool last = (t == nt - 2);
            const char* a1 = cA + (size_t)(t + 1) * kstep;
            const char* a2 = last ? nA : cA + (size_t)(t + 2) * kstep; const char* b2 = last ? nB : cB + (size_t)(t + 2) * kstep;
            const char* a3 = a2 + kstep; const char* b3 = b2 + kstep;
            PG8_LDB(B0, 0, 0); PG8_SCHED; PG8_LDA(At, 0, 0); PG8_STAGE(PG8_SA(1, 1), a1 + hstep, voffA);
            PG8_WAIT_L(8); PG8_BAR; PG8_WAIT_L(0); PG8_MMA(0, 0, At, B0); PG8_BAR; PG8_SCHED;
            PG8_LDB(B1, 0, 1); PG8_STAGE(PG8_SB(0, 0), b2, voffB);
            PG8_BAR; PG8_WAIT_L(0); PG8_MMA(0, 1, At, B1); PG8_BAR;
            PG8_LDA(At, 0, 1); PG8_STAGE(PG8_SA(0, 0), a2, voffA);
            PG8_BAR; PG8_WAIT_L(0); PG8_MMA(1, 0, At, B0); PG8_BAR; PG8_SCHED;
            PG8_STAGE(PG8_SB(0, 1), b2 + hstep, voffB);
            PG8_WAIT_V(6); PG8_BAR; PG8_MMA(1, 1, At, B1); PG8_BAR;
            PG8_LDB(B0, 1, 0); PG8_SCHED; PG8_LDA(At, 1, 0); PG8_STAGE(PG8_SA(0, 1), a2 + hstep, voffA);
            PG8_WAIT_L(8); PG8_BAR; PG8_WAIT_L(0); PG8_MMA(0, 0, At, B0); PG8_BAR; PG8_SCHED;
            PG8_LDB(B1, 1, 1); PG8_STAGE(PG8_SB(1, 0), b3, voffB);
            PG8_BAR; PG8_WAIT_L(0); PG8_MMA(0, 1, At, B1); PG8_BAR;
            PG8_LDA(At, 1, 1); PG8_STAGE(PG8_SA(1, 0), a3, voffA);
            PG8_BAR; PG8_WAIT_L(0); PG8_MMA(1, 0, At, B0); PG8_BAR; PG8_SCHED;
            PG8_STAGE(PG8_SB(1, 1), b3 + hstep, voffB);
            PG8_WAIT_V(6); PG8_BAR; PG8_MMA(1, 1, At, B1); PG8_BAR;
        }
        E(acc, cur, wr, wc, fr, fq);
        if (!has_next) break;
#pragma unroll
        for (int a = 0; a < 2; ++a)
#pragma unroll
            for (int b = 0; b < 2; ++b)
#pragma unroll
                for (int m = 0; m < 4; ++m)
#pragma unroll
                    for (int n = 0; n < 2; ++n) acc[a][b][m][n] = (f32x4){0.f, 0.f, 0.f, 0.f};
        cur = nxt; cA = nA; cB = nB; nt = nnt; ++ui;
    }
    PG8_WAIT_V(0);
    if (wr == 0) PG8_BAR;
    PG8_BAR;
#undef PG8_SA
#undef PG8_SB
#undef PG8_STAGE
#undef PG8_LDA
#undef PG8_LDB
#undef PG8_MMA
#undef PG8_WAIT_V
#undef PG8_WAIT_L
#undef PG8_BAR
#undef PG8_SCHED
}
}
constexpr size_t MiB = 1u << 20;
constexpr size_t WS_CTL = 0, CTL_ZERO_BYTES = 1 * MiB;
constexpr int CW_BAR = 4096;
constexpr size_t WS_MODS = 1 * MiB;
constexpr size_t WS_TW = 2 * MiB;
constexpr size_t WS_HIDA = 3 * MiB;
constexpr size_t WS_ADAP = 6 * MiB;
constexpr size_t WS_X = 22 * MiB;
constexpr size_t WS_NB = 90 * MiB;
constexpr size_t WS_ACT = 124 * MiB;
constexpr size_t WS_W = 218 * MiB;
constexpr size_t WS_MIX = WS_W + 648 * MiB;
constexpr size_t WS_PART = WS_MIX + 900 * MiB;
constexpr size_t WS_END = WS_PART + 52 * MiB;
__host__ __device__ constexpr size_t W_GU(int l, int h) { return (size_t)(l * 132 + h * 44) * MiB; }
__host__ __device__ constexpr size_t W_DN(int l, int h) { return (size_t)(l * 132 + 88 + h * 22) * MiB; }
constexpr size_t W_HY_IN = 528 * MiB, W_HY_OUT = 552 * MiB, W_HY_F3 = 560 * MiB, W_RW_BT1 = 564 * MiB, W_RW_BT2 = 591 * MiB, W_RW_WO = 596 * MiB,
                 W_ML_WD = 604 * MiB, W_ML_BT3 = 609 * MiB, W_ML_WO = 616 * MiB, W_GQ_QKV = 624 * MiB, W_GQ_WO = 640 * MiB;
constexpr size_t HY_U = 0, HY_VXT = 204 * MiB, HY_HFT = 408 * MiB  ;
constexpr size_t RW_XS = 0, RW_Y = 0  , RW_KK = 136 * MiB, RW_HLF = 204 * MiB, RW_RKV = 272 * MiB, RW_LM = 476 * MiB, RW_DEC = 492 * MiB,
                 RW_ASIG = 628 * MiB, RW_G = 764 * MiB;
constexpr size_t ML_RAW = 0, ML_CN = 43 * MiB, ML_QRAW = 60 * MiB, ML_Q = 162 * MiB, ML_K = 213 * MiB, ML_V = 264 * MiB;
constexpr size_t GQ_RAW = 0, GQ_Q = 136 * MiB, GQ_K = 170 * MiB, GQ_V = 187 * MiB;
constexpr int LDS_BYTES = 147456, MISC_OFF = 131072 + 8192;

namespace pg8 {
#define EPI_ARGS const f32x4 (&acc)[2][2][4][2], const Unit& u, int wr, int wc, int fr, int fq
struct EpiSwiglu {
    bf16_t* act;
    __device__ __forceinline__ void operator()(EPI_ARGS) const {
        const int row0 = u.lm * BM + wr * 64 + fr, col0 = u.ln * 128 + wc * 32 + 8 * fq;
#pragma unroll
        for (int ai = 0; ai < 2; ++ai)
#pragma unroll
            for (int m = 0; m < 4; ++m) {
                float v[8];
#pragma unroll
                for (int n = 0; n < 2; ++n)
#pragma unroll
                    for (int j = 0; j < 4; ++j) { const float a = acc[ai][0][m][n][j], b = acc[ai][1][m][n][j]; v[n * 4 + j] = a * fast_sigmoid(a) * b; }
                u32x4 w; w.x = cvt_pk_bf16(v[0], v[1]); w.y = cvt_pk_bf16(v[2], v[3]); w.z = cvt_pk_bf16(v[4], v[5]); w.w = cvt_pk_bf16(v[6], v[7]);
                *(u32x4*)(act + (size_t)(row0 + ai * HALF + m * 16) * FF + col0) = w;
            }
    }
};
struct EpiResid {
    float* X; const float* mods_l; int gidx; float sc; const float* bias; static constexpr size_t PART_OFF = (WS_PART - WS_X) / 4;
    __device__ __forceinline__ void operator()(EPI_ARGS) const {
        const int row0 = u.lm * BM + wr * 64 + fr;
        const int rt = (u.lm % PPB == 0) ? 2 : u.lm / PPB;
        const float* gate = mods_l + (size_t)(rt * NMOD + gidx) * DM;
#pragma unroll
        for (int bj = 0; bj < 2; ++bj) {
            const int col = u.ln * BM + bj * HALF + wc * 32 + 8 * fq;
            f32x4 g0 = *(const f32x4*)(gate + col) * sc, g1 = *(const f32x4*)(gate + col + 4) * sc;
            f32x4 b0 = (f32x4){0.f, 0.f, 0.f, 0.f}, b1 = b0;
            if (bias && u.ksub == 0) { b0 = *(const f32x4*)(bias + col); b1 = *(const f32x4*)(bias + col + 4); }
#pragma unroll
            for (int ai = 0; ai < 2; ++ai) {
#pragma unroll
                for (int m = 0; m < 4; ++m) {
                    float* p = X + (size_t)(row0 + ai * HALF + m * 16) * DM + col;
                    if (u.ks == 1) {
                        f32x4 x0 = *(f32x4*)p, x1 = *(f32x4*)(p + 4);
                        x0 += g0 * (acc[ai][bj][m][0] + b0); x1 += g1 * (acc[ai][bj][m][1] + b1);
                        *(f32x4*)p = x0; *(f32x4*)(p + 4) = x1;
                    } else {
                        const int cr = (u.lm / PPB) * CTXL + wr * 64 + fr + ai * HALF + m * 16;
                        float* q = X + PART_OFF + ((size_t)u.ksub * (NB * CTXL) + cr) * DM + col;
                        *(f32x4*)q = g0 * (acc[ai][bj][m][0] + b0); *(f32x4*)(q + 4) = g1 * (acc[ai][bj][m][1] + b1);
                    }
                }
                asm volatile("" ::: "memory");
            }
        }
    }
};
struct EpiF32 {
    float* C; int ldc; const float* bias;
    __device__ __forceinline__ void operator()(EPI_ARGS) const {
        const int row0 = u.lm * BM + wr * 64 + fr;
#pragma unroll
        for (int bj = 0; bj < 2; ++bj) {
            const int col = u.ln * BM + bj * HALF + wc * 32 + 8 * fq;
            f32x4 b0 = (f32x4){0.f, 0.f, 0.f, 0.f}, b1 = b0;
            if (bias) { b0 = *(const f32x4*)(bias + col); b1 = *(const f32x4*)(bias + col + 4); }
#pragma unroll
            for (int ai = 0; ai < 2; ++ai)
#pragma unroll
                for (int m = 0; m < 4; ++m) {
                    float* p = C + (size_t)(row0 + ai * HALF + m * 16) * ldc + col;
                    *(f32x4*)p = acc[ai][bj][m][0] + b0; *(f32x4*)(p + 4) = acc[ai][bj][m][1] + b1;
                }
        }
    }
};
template <long SL_OFF, int SL_LD, int SL_COL0>
struct EpiF32S {
    float* C; int ldc; const float* bias;
    __device__ __forceinline__ void operator()(EPI_ARGS) const {
        const int row0 = u.lm * BM + wr * 64 + fr;
#pragma unroll
        for (int bj = 0; bj < 2; ++bj) {
            const int col = u.ln * BM + bj * HALF + wc * 32 + 8 * fq;
            f32x4 b0 = (f32x4){0.f, 0.f, 0.f, 0.f}, b1 = b0;
            if (bias && u.ksub == 0) { b0 = *(const f32x4*)(bias + col); b1 = *(const f32x4*)(bias + col + 4); }
#pragma unroll
            for (int ai = 0; ai < 2; ++ai)
#pragma unroll
                for (int m = 0; m < 4; ++m) {
                    float* p;
                    if (u.ks == 1) p = C + (size_t)(row0 + ai * HALF + m * 16) * ldc + col;
                    else { const int cr = (u.lm / PPB) * CTXL + wr * 64 + fr + ai * HALF + m * 16; p = C + SL_OFF + ((size_t)u.ksub * (NB * CTXL) + cr) * SL_LD + (col - SL_COL0); }
                    *(f32x4*)p = acc[ai][bj][m][0] + b0; *(f32x4*)(p + 4) = acc[ai][bj][m][1] + b1;
                }
        }
    }
};
struct EpiBf16B {
    bf16_t* C; int ldc; const float* bias;
    __device__ __forceinline__ void operator()(EPI_ARGS) const {
        const int row0 = u.lm * BM + wr * 64 + fr;
#pragma unroll
        for (int bj = 0; bj < 2; ++bj) {
            const int col = u.ln * BM + bj * HALF + wc * 32 + 8 * fq;
            f32x4 b0 = (f32x4){0.f, 0.f, 0.f, 0.f}, b1 = b0;
            if (bias) { b0 = *(const f32x4*)(bias + col); b1 = *(const f32x4*)(bias + col + 4); }
#pragma unroll
            for (int ai = 0; ai < 2; ++ai)
#pragma unroll
                for (int m = 0; m < 4; ++m) {
                    const f32x4 v0 = acc[ai][bj][m][0] + b0, v1 = acc[ai][bj][m][1] + b1;
                    u32x4 w; w.x = cvt_pk_bf16(v0[0], v0[1]); w.y = cvt_pk_bf16(v0[2], v0[3]); w.z = cvt_pk_bf16(v1[0], v1[1]); w.w = cvt_pk_bf16(v1[2], v1[3]);
                    *(u32x4*)(C + (size_t)(row0 + ai * HALF + m * 16) * ldc + col) = w;
                }
        }
    }
};
struct EpiRw1 {
    float* rkv; bf16_t* lm;
    __device__ __forceinline__ void operator()(EPI_ARGS) const {
        const int row0 = u.lm * BM + wr * 64 + fr;
        if (u.g < 3) {
            float* C = rkv + (size_t)u.g * ROWS * DM;
#pragma unroll
            for (int bj = 0; bj < 2; ++bj) {
                const int col = u.ln * BM + bj * HALF + wc * 32 + 8 * fq;
#pragma unroll
                for (int ai = 0; ai < 2; ++ai)
#pragma unroll
                    for (int m = 0; m < 4; ++m) {
                        float* p = C + (size_t)(row0 + ai * HALF + m * 16) * DM + col;
                        *(f32x4*)p = acc[ai][bj][m][0]; *(f32x4*)(p + 4) = acc[ai][bj][m][1];
                    }
            }
        } else {
            bf16_t* O = lm + (size_t)(u.g - 3) * ROWS * 256;
            const int mode = u.g - 3;
#pragma unroll
            for (int bj = 0; bj < 2; ++bj) {
                const int col = bj * HALF + wc * 32 + 8 * fq;
#pragma unroll
                for (int ai = 0; ai < 2; ++ai)
#pragma unroll
                    for (int m = 0; m < 4; ++m) {
                        float v[8];
#pragma unroll
                        for (int n = 0; n < 2; ++n)
#pragma unroll
                            for (int j = 0; j < 4; ++j) { const float a = acc[ai][bj][m][n][j]; v[n * 4 + j] = (mode == 0) ? (1.0f - 2.0f * __builtin_amdgcn_rcpf(1.0f + __expf(2.0f * a))) : ((mode == 1) ? a : fast_sigmoid(a)); }
                        u32x4 w; w.x = cvt_pk_bf16(v[0], v[1]); w.y = cvt_pk_bf16(v[2], v[3]); w.z = cvt_pk_bf16(v[4], v[5]); w.w = cvt_pk_bf16(v[6], v[7]);
                        *(u32x4*)(O + (size_t)(row0 + ai * HALF + m * 16) * 256 + col) = w;
                    }
            }
        }
    }
};
struct EpiRw2 {
    float* dec; float* asig; float* gg; const float* w0; const float* a0;
    __device__ __forceinline__ void operator()(EPI_ARGS) const {
        const int row0 = u.lm * BM + wr * 64 + fr;
        float* C = (u.g == 0) ? dec : ((u.g == 1) ? asig : gg);
        const int ldc = (u.g == 2) ? DM : 2 * DM;
        const float* addv = (u.g == 0) ? w0 : a0;
#pragma unroll
        for (int bj = 0; bj < 2; ++bj) {
            const int col = u.ln * BM + bj * HALF + wc * 32 + 8 * fq;
            f32x4 b0 = (f32x4){0.f, 0.f, 0.f, 0.f}, b1 = b0;
            if (u.g < 2) { b0 = *(const f32x4*)(addv + col); b1 = *(const f32x4*)(addv + col + 4); }
#pragma unroll
            for (int ai = 0; ai < 2; ++ai)
#pragma unroll
                for (int m = 0; m < 4; ++m) {
                    f32x4 v0 = acc[ai][bj][m][0] + b0, v1 = acc[ai][bj][m][1] + b1;
                    if (u.g < 2) {
#pragma unroll
                        for (int j = 0; j < 4; ++j) {
                            float s0 = fast_sigmoid(v0[j]), s1 = fast_sigmoid(v1[j]);
                            if (u.g == 0) { s0 = __expf(-s0 * 0.60653065971263342f); s1 = __expf(-s1 * 0.60653065971263342f); }
                            v0[j] = s0; v1[j] = s1;
                        }
                    }
                    float* p = C + (size_t)(row0 + ai * HALF + m * 16) * ldc + col;
                    *(f32x4*)p = v0; *(f32x4*)(p + 4) = v1;
                    asm volatile("" ::: "memory");
                }
        }
    }
};
struct EpiMla3 {
    float* qraw; bf16_t* Kb; bf16_t* Vb;
    __device__ __forceinline__ void operator()(EPI_ARGS) const {
        const int row0 = u.lm * BM + wr * 64 + fr;
        if (u.g == 0) {
#pragma unroll
            for (int bj = 0; bj < 2; ++bj) {
                const int col = u.ln * BM + bj * HALF + wc * 32 + 8 * fq;
#pragma unroll
                for (int ai = 0; ai < 2; ++ai)
#pragma unroll
                    for (int m = 0; m < 4; ++m) {
                        float* p = qraw + (size_t)(row0 + ai * HALF + m * 16) * 3072 + col;
                        *(f32x4*)p = acc[ai][bj][m][0]; *(f32x4*)(p + 4) = acc[ai][bj][m][1];
                    }
            }
        } else {
#pragma unroll
            for (int bj = 0; bj < 2; ++bj) {
                bf16_t* O = bj ? Vb : Kb; const int ld = bj ? 2048 : 3072; const int col = u.ln * (bj ? 128 : 192) + wc * 32 + 8 * fq;
#pragma unroll
                for (int ai = 0; ai < 2; ++ai)
#pragma unroll
                    for (int m = 0; m < 4; ++m) {
                        const f32x4 v0 = acc[ai][bj][m][0], v1 = acc[ai][bj][m][1];
                        u32x4 w; w.x = cvt_pk_bf16(v0[0], v0[1]); w.y = cvt_pk_bf16(v0[2], v0[3]); w.z = cvt_pk_bf16(v1[0], v1[1]); w.w = cvt_pk_bf16(v1[2], v1[3]);
                        *(u32x4*)(O + (size_t)(row0 + ai * HALF + m * 16) * ld + col) = w;
                    }
            }
        }
    }
};
#undef EPI_ARGS
}
namespace pg8 {
struct EpiHyF {
    float* hft_lat; float* hft_ctx;
    __device__ __forceinline__ void operator()(const f32x4 (&acc)[2][2][4][2], const Unit& u, int wr, int wc, int fr, int fq) const {
        const bool lat = u.lm < 16; const int L = lat ? 4096 : 256;
        float* base = (lat ? hft_lat : hft_ctx) + ((u.lm - (lat ? 0 : 16)) * BM + wr * 64 + fr);
#pragma unroll
        for (int bj = 0; bj < 2; ++bj)
#pragma unroll
            for (int n = 0; n < 2; ++n)
#pragma unroll
                for (int j = 0; j < 4; ++j) {
                    float* p = base + (size_t)(u.ln * BM + bj * HALF + wc * 32 + 8 * fq + 4 * n + j) * L;
#pragma unroll
                    for (int ai = 0; ai < 2; ++ai)
#pragma unroll
                        for (int m = 0; m < 4; ++m) p[ai * HALF + m * 16] = acc[ai][bj][m][n][j];
                    asm volatile("" ::: "memory");
                }
    }
};
}
namespace att {
constexpr int NW = 8, QBLK = 32, KVBLK = 64, DV = 128;
constexpr float THR = 8.f;
#define SBAR() __builtin_amdgcn_sched_barrier(0)
__device__ __forceinline__ int crow(int r, int hi) { return (r & 3) + 8 * (r >> 2) + 4 * hi; }
template <int SCALE_ID> struct ScaleOf;
template <> struct ScaleOf<128> { static constexpr float v = 0.088388347648318440f; };
template <> struct ScaleOf<192> { static constexpr float v = 0.072168783648703220f; };

template <int DQK>
__device__ __forceinline__ void partialSM(f32x16& p0, f32x16& p1, float& m_reg, float& mn, float& alpha) {
  constexpr float SCALE = ScaleOf<DQK>::v;
  constexpr float C = SCALE * 1.4426950408889634f;
  float pmax = p0[0];
#pragma unroll
  for (int r = 1; r < 16; ++r) pmax = fmaxf(pmax, p0[r]);
#pragma unroll
  for (int r = 0; r < 16; ++r) pmax = fmaxf(pmax, p1[r]);
  { auto rr = __builtin_amdgcn_permlane32_swap(__float_as_uint(pmax), __float_as_uint(pmax), false, false);
    pmax = fmaxf(__uint_as_float(rr[0]), __uint_as_float(rr[1])); }
  if (__builtin_expect(__all(pmax - m_reg <= THR / SCALE), 1)) { mn = m_reg; alpha = 1.f; }
  else { mn = fmaxf(m_reg, pmax); alpha = __builtin_amdgcn_exp2f((m_reg - mn) * C); m_reg = mn; }
  float mnC = -mn * C;
#pragma unroll
  for (int r = 0; r < 16; ++r) p0[r] = fmaf(p0[r], C, mnC);
#pragma unroll
  for (int r = 0; r < 16; ++r) p1[r] = fmaf(p1[r], C, mnC);
#pragma unroll
  for (int r = 0; r < 16; ++r) p0[r] = __builtin_amdgcn_exp2f(p0[r]);
}
__device__ __forceinline__ void finishSM(f32x16& p0, f32x16& p1, float alpha, float& l_reg, bf16x8& pa0, bf16x8& pa1, bf16x8& pa2, bf16x8& pa3) {
#pragma unroll
  for (int r = 0; r < 16; ++r) p1[r] = __builtin_amdgcn_exp2f(p1[r]);
  float ps = 0;
#pragma unroll
  for (int r = 0; r < 16; ++r) ps += p0[r];
#pragma unroll
  for (int r = 0; r < 16; ++r) ps += p1[r];
  { auto rr = __builtin_amdgcn_permlane32_swap(__float_as_uint(ps), __float_as_uint(ps), false, false);
    ps = __uint_as_float(rr[0]) + __uint_as_float(rr[1]); }
  l_reg = l_reg * alpha + ps;
#define PK4(P, BASE, OUT) do { unsigned a0 = cvt_pk_bf16(P[BASE + 0], P[BASE + 1]), a1 = cvt_pk_bf16(P[BASE + 2], P[BASE + 3]);   \
    unsigned b0 = cvt_pk_bf16(P[BASE + 4], P[BASE + 5]), b1 = cvt_pk_bf16(P[BASE + 6], P[BASE + 7]);                              \
    auto r0 = __builtin_amdgcn_permlane32_swap(a0, b0, false, false); auto r1 = __builtin_amdgcn_permlane32_swap(a1, b1, false, false); \
    u32x4 w = {r0[0], r1[0], r0[1], r1[1]}; OUT = *reinterpret_cast<bf16x8*>(&w); } while (0)
  PK4(p0, 0, pa0); PK4(p0, 8, pa1); PK4(p1, 0, pa2); PK4(p1, 8, pa3);
#undef PK4
}
template <int DQK>
__device__ __forceinline__ int kswz(int row, int colB) { return row * (DQK * 2) + (colB ^ ((row & 7) << 4)); }
template <int DQK>
__device__ __forceinline__ void qkt(f32x16& p0, f32x16& p1, const char* Ks, const bf16x8* qr, int r32, int hi) {
  p0 = f32x16{}; p1 = f32x16{};
#pragma unroll
  for (int d0 = 0; d0 < DQK / 16; ++d0) { int cb = (d0 * 16 + hi * 8) * 2;
    bf16x8 b0 = *reinterpret_cast<const bf16x8*>(Ks + kswz<DQK>(r32, cb));
    bf16x8 b1 = *reinterpret_cast<const bf16x8*>(Ks + kswz<DQK>(32 + r32, cb));
    p0 = __builtin_amdgcn_mfma_f32_32x32x16_bf16(b0, qr[d0], p0, 0, 0, 0);
    p1 = __builtin_amdgcn_mfma_f32_32x32x16_bf16(b1, qr[d0], p1, 0, 0, 0); }
}
template <int DQK, int NQL>
__device__ __forceinline__ void qkt_l(f32x16& p0, f32x16& p1, const char* Ks, const bf16x8* qr, const char* qls, int r32, int hi) {
  p0 = f32x16{}; p1 = f32x16{};
  constexpr int ND0 = DQK / 16;
#pragma unroll
  for (int d0 = 0; d0 < ND0; ++d0) { int cb = (d0 * 16 + hi * 8) * 2;
    bf16x8 b0 = *reinterpret_cast<const bf16x8*>(Ks + kswz<DQK>(r32, cb));
    bf16x8 b1 = *reinterpret_cast<const bf16x8*>(Ks + kswz<DQK>(32 + r32, cb));
    const bf16x8 q = (d0 < ND0 - NQL) ? qr[d0 < ND0 - NQL ? d0 : 0] : *reinterpret_cast<const bf16x8*>(qls + (d0 - (ND0 - NQL)) * 1024);
    p0 = __builtin_amdgcn_mfma_f32_32x32x16_bf16(b0, q, p0, 0, 0, 0);
    p1 = __builtin_amdgcn_mfma_f32_32x32x16_bf16(b1, q, p1, 0, 0, 0); }
}
__device__ __forceinline__ int v_st(int k, int c) { const int kk = (k & ~0xC) | ((k & 4) << 1) | ((k & 8) >> 1); return ((kk >> 3) * 4 + (c >> 5)) * 512 + ((kk & 7) * 32 + (c & 31)) * 2; }
__device__ __forceinline__ int v_rd_base(int lane) { return ((lane & 3) << 3) | (((lane >> 2) & 3) << 6) | (((lane >> 4) & 1) << 5) | (((lane >> 5) & 1) << 8); }
constexpr int v_rd_off(int d0, int ks, int half) { return d0 * 512 + ks * 4096 + half * 2048; }
template <int OFF> __device__ __forceinline__ s16x4 tr_read(int vb) {
  s16x4 r; asm volatile("ds_read_b64_tr_b16 %0, %1 offset:%2" : "=&v"(r) : "v"(vb), "i"(OFF) : "memory"); return r;
}
template <int D0> __device__ __forceinline__ void pv_one(f32x16& od, int vb, bf16x8 pa0, bf16x8 pa1, bf16x8 pa2, bf16x8 pa3) {
  const s16x4 l0 = tr_read<v_rd_off(D0, 0, 0)>(vb), h0 = tr_read<v_rd_off(D0, 0, 1)>(vb), l1 = tr_read<v_rd_off(D0, 1, 0)>(vb), h1 = tr_read<v_rd_off(D0, 1, 1)>(vb);
  const s16x4 l2 = tr_read<v_rd_off(D0, 2, 0)>(vb), h2 = tr_read<v_rd_off(D0, 2, 1)>(vb), l3 = tr_read<v_rd_off(D0, 3, 0)>(vb), h3 = tr_read<v_rd_off(D0, 3, 1)>(vb);
  asm volatile("s_waitcnt lgkmcnt(0)" ::: "memory"); SBAR();
#define PK(L, H) (bf16x8){L[0], L[1], L[2], L[3], H[0], H[1], H[2], H[3]}
  od = __builtin_amdgcn_mfma_f32_32x32x16_bf16(pa0, PK(l0, h0), od, 0, 0, 0);
  od = __builtin_amdgcn_mfma_f32_32x32x16_bf16(pa1, PK(l1, h1), od, 0, 0, 0);
  od = __builtin_amdgcn_mfma_f32_32x32x16_bf16(pa2, PK(l2, h2), od, 0, 0, 0);
  od = __builtin_amdgcn_mfma_f32_32x32x16_bf16(pa3, PK(l3, h3), od, 0, 0, 0);
#undef PK
}
__device__ __forceinline__ void pv_d0(f32x16* o, int vb, bf16x8 pa0, bf16x8 pa1, bf16x8 pa2, bf16x8 pa3) {
  pv_one<0>(o[0], vb, pa0, pa1, pa2, pa3); pv_one<1>(o[1], vb, pa0, pa1, pa2, pa3); pv_one<2>(o[2], vb, pa0, pa1, pa2, pa3); pv_one<3>(o[3], vb, pa0, pa1, pa2, pa3);
}

template <int DQK, int LDQ, int LDK, int LDV, int LDO>
__device__ __forceinline__ void attn_dense_body(const bf16_t* __restrict__ Qb, const bf16_t* __restrict__ Kh, const bf16_t* __restrict__ Vh,
                                                bf16_t* __restrict__ Ob, int seq, char* lds) {
  constexpr int SHM_V = KVBLK * DV * 2, SHM_K = KVBLK * DQK * 2, NCH = DQK / 8, KCH = NCH / 8  , ND0 = DQK / 16;
  const int tid = threadIdx.x, wid = tid >> 6, lane = tid & 63, r32 = lane & 31, hi = lane >> 5;
  char* V_lds = lds; char* K_lds = lds + 2 * SHM_V;
  float* ws = (float*)(lds + 2 * SHM_V + 2 * SHM_K) + wid * 64; float* li_l = ws; float* al_l = ws + 32;
  float m_reg = -1e30f, l_reg = 0; f32x16 o[4] = {}; bf16x8 qr[ND0];
  const bf16_t* Qw = Qb + (long)(wid * QBLK + r32) * LDQ + hi * 8;
#pragma unroll
  for (int d0 = 0; d0 < ND0; ++d0) qr[d0] = *reinterpret_cast<const bf16x8*>(Qw + d0 * 16);
  const int sr = tid >> 4, sc = (tid & 15) * 8, vst0 = v_st(sr, sc), vst1 = v_st(32 + sr, sc);
  const int vb0 = (int)(uintptr_t)V_lds + v_rd_base(lane);
  bf16x8 vs0, vs1, ks[KCH];
#define SLOAD(k0) do { vs0 = *reinterpret_cast<const bf16x8*>(&Vh[(long)((k0) + sr) * LDV + sc]); vs1 = *reinterpret_cast<const bf16x8*>(&Vh[(long)((k0) + 32 + sr) * LDV + sc]); \
    _Pragma("unroll") for (int c_ = 0; c_ < KCH; ++c_) { const int q_ = tid + 512 * c_; ks[c_] = *reinterpret_cast<const bf16x8*>(&Kh[(long)((k0) + q_ / NCH) * LDK + (q_ % NCH) * 8]); } } while (0)
#define SWRITE(b) do { *(bf16x8*)(V_lds + (b) * SHM_V + vst0) = vs0; *(bf16x8*)(V_lds + (b) * SHM_V + vst1) = vs1; \
    _Pragma("unroll") for (int c_ = 0; c_ < KCH; ++c_) { const int q_ = tid + 512 * c_; *(bf16x8*)(K_lds + (b) * SHM_K + kswz<DQK>(q_ / NCH, (q_ % NCH) * 16)) = ks[c_]; } } while (0)
  const int NT = seq / KVBLK;
  SLOAD(0); asm volatile("s_waitcnt vmcnt(0)" ::: "memory"); SWRITE(0);
  SLOAD(KVBLK);
#pragma unroll 1
  for (int j = 0; j < NT; ++j) {
    const int b = j & 1;
    __syncthreads();
    if (j + 1 < NT) { asm volatile("s_waitcnt vmcnt(0)" ::: "memory"); SWRITE(b ^ 1); if (j + 2 < NT) SLOAD((j + 2) * KVBLK); }
    f32x16 p0, p1; float mn, al; bf16x8 pa0, pa1, pa2, pa3;
    SBAR(); qkt<DQK>(p0, p1, K_lds + b * SHM_K, qr, r32, hi);
    partialSM<DQK>(p0, p1, m_reg, mn, al);
    if (__any(al < 1.f)) { if (hi == 0) al_l[r32] = al; asm volatile("s_waitcnt lgkmcnt(0)" ::: "memory");
#pragma unroll
      for (int d = 0; d < 4; ++d)
#pragma unroll
        for (int r = 0; r < 16; ++r) o[d][r] *= al_l[crow(r, hi)]; }
    finishSM(p0, p1, al, l_reg, pa0, pa1, pa2, pa3); SBAR();
    pv_d0(o, vb0 + b * (int)SHM_V, pa0, pa1, pa2, pa3);
  }
  if (hi == 0) li_l[r32] = l_reg; asm volatile("s_waitcnt lgkmcnt(0)" ::: "memory");
  float rli[16];
#pragma unroll
  for (int r = 0; r < 16; ++r) rli[r] = __builtin_amdgcn_rcpf(li_l[crow(r, hi)]);
  bf16_t* Ow = Ob + (long)(wid * QBLK) * LDO;
#pragma unroll
  for (int r = 0; r < 16; ++r) { int orow = crow(r, hi);
#pragma unroll
    for (int d0 = 0; d0 < 4; ++d0) Ow[(long)orow * LDO + d0 * 32 + r32] = (bf16_t)(cvt_pk_bf16(o[d0][r] * rli[r], 0.f) & 0xffffu); }
#undef SLOAD
#undef SWRITE
}

template <int DQK, int LDQ, int LDK, int LDV, int LDO, int NQL>
__device__ __forceinline__ void attn_dense_body2(const bf16_t* __restrict__ Qb, const bf16_t* __restrict__ Kh, const bf16_t* __restrict__ Vh,
                                                 bf16_t* __restrict__ Ob, int seq, char* lds) {
  constexpr int SHM_V = KVBLK * DV * 2, SHM_K = KVBLK * DQK * 2, NCH = DQK / 8, KCH = NCH / 8, ND0 = DQK / 16;
  int tid = threadIdx.x; asm volatile("" : "+v"(tid));
  const int wid = __builtin_amdgcn_readfirstlane(tid >> 6), lane = tid & 63, r32 = lane & 31, hi = lane >> 5;
  char* V_lds = lds; char* K_lds = lds + 2 * SHM_V;
  float* ws = (float*)(lds + 2 * SHM_V + 2 * SHM_K) + wid * 64; float* li_l = ws; float* al_l = ws + 32;
  float m_reg = -1e30f, l_reg = 0; f32x16 o[4] = {}; bf16x8 qr[ND0 - NQL];
  const bf16_t* Qw = Qb + (long)(wid * QBLK + r32) * LDQ + hi * 8;
  char* qls = lds + 2 * SHM_V + 2 * SHM_K + 2048 + wid * (NQL * 1024) + lane * 16;
#pragma unroll
  for (int d0 = 0; d0 < ND0; ++d0) { const bf16x8 q = *reinterpret_cast<const bf16x8*>(Qw + d0 * 16); if (d0 < ND0 - NQL) qr[d0 < ND0 - NQL ? d0 : 0] = q; else *reinterpret_cast<bf16x8*>(qls + (d0 - (ND0 - NQL)) * 1024) = q; }
  const int sr = tid >> 4, sc = (tid & 15) * 8, vst0 = v_st(sr, sc), vst1 = v_st(32 + sr, sc);
  const int vb0 = (int)(uintptr_t)V_lds + v_rd_base(lane);
  bf16x8 vs0, vs1, ks[KCH];
#define SLOAD(k0) do { vs0 = *reinterpret_cast<const bf16x8*>(&Vh[(long)((k0) + sr) * LDV + sc]); vs1 = *reinterpret_cast<const bf16x8*>(&Vh[(long)((k0) + 32 + sr) * LDV + sc]); \
    _Pragma("unroll") for (int c_ = 0; c_ < KCH; ++c_) { const int q_ = tid + 512 * c_; ks[c_] = *reinterpret_cast<const bf16x8*>(&Kh[(long)((k0) + q_ / NCH) * LDK + (q_ % NCH) * 8]); } } while (0)
#define SWRITE(b) do { *(bf16x8*)(V_lds + (b) * SHM_V + vst0) = vs0; *(bf16x8*)(V_lds + (b) * SHM_V + vst1) = vs1; \
    _Pragma("unroll") for (int c_ = 0; c_ < KCH; ++c_) { const int q_ = tid + 512 * c_; *(bf16x8*)(K_lds + (b) * SHM_K + kswz<DQK>(q_ / NCH, (q_ % NCH) * 16)) = ks[c_]; } } while (0)
#define SWAIT() asm volatile("s_waitcnt vmcnt(0)" ::: "memory")
#define RESC(a) do { if (__any((a) < 1.f)) { if (hi == 0) al_l[r32] = (a); asm volatile("s_waitcnt lgkmcnt(0)" ::: "memory"); \
    _Pragma("unroll") for (int d = 0; d < 4; ++d) _Pragma("unroll") for (int r = 0; r < 16; ++r) o[d][r] *= al_l[crow(r, hi)]; } } while (0)
  f32x16 pA0, pA1, pB0, pB1; float mnA, mnB, alA, alB; bf16x8 pa0, pa1, pa2, pa3; const int NT = seq / KVBLK;
  SLOAD(0); SWAIT(); SWRITE(0); __syncthreads();
  qkt_l<DQK, NQL>(pA0, pA1, K_lds, qr, qls, r32, hi); partialSM<DQK>(pA0, pA1, m_reg, mnA, alA);
  SLOAD(KVBLK); SWAIT(); SWRITE(1); __syncthreads();
  for (int j = 1; j + 1 < NT; j += 2) {
    SBAR(); qkt_l<DQK, NQL>(pB0, pB1, K_lds + SHM_K, qr, qls, r32, hi);
    finishSM(pA0, pA1, alA, l_reg, pa0, pa1, pa2, pa3); SBAR();
    SLOAD((j + 1) * KVBLK); SBAR();
    pv_d0(o, vb0, pa0, pa1, pa2, pa3); partialSM<DQK>(pB0, pB1, m_reg, mnB, alB);
    __syncthreads(); SWAIT(); SWRITE(0);
    RESC(alB); __syncthreads();
    SBAR(); qkt_l<DQK, NQL>(pA0, pA1, K_lds, qr, qls, r32, hi);
    finishSM(pB0, pB1, alB, l_reg, pa0, pa1, pa2, pa3); SBAR();
    SLOAD((j + 2) * KVBLK); SBAR();
    pv_d0(o, vb0 + (int)SHM_V, pa0, pa1, pa2, pa3); partialSM<DQK>(pA0, pA1, m_reg, mnA, alA);
    __syncthreads(); SWAIT(); SWRITE(1);
    RESC(alA); __syncthreads();
  }
  SBAR(); qkt_l<DQK, NQL>(pB0, pB1, K_lds + SHM_K, qr, qls, r32, hi);
  finishSM(pA0, pA1, alA, l_reg, pa0, pa1, pa2, pa3); SBAR();
  pv_d0(o, vb0, pa0, pa1, pa2, pa3); partialSM<DQK>(pB0, pB1, m_reg, mnB, alB);
  __syncthreads(); RESC(alB);
  finishSM(pB0, pB1, alB, l_reg, pa0, pa1, pa2, pa3); SBAR();
  pv_d0(o, vb0 + (int)SHM_V, pa0, pa1, pa2, pa3);
  if (hi == 0) li_l[r32] = l_reg; asm volatile("s_waitcnt lgkmcnt(0)" ::: "memory");
  float rli[16];
#pragma unroll
  for (int r = 0; r < 16; ++r) rli[r] = __builtin_amdgcn_rcpf(li_l[crow(r, hi)]);
  bf16_t* Ow = Ob + (long)(wid * QBLK) * LDO;
#pragma unroll
  for (int r = 0; r < 16; ++r) { int orow = crow(r, hi);
#pragma unroll
    for (int d0 = 0; d0 < 4; ++d0) Ow[(long)orow * LDO + d0 * 32 + r32] = (bf16_t)(cvt_pk_bf16(o[d0][r] * rli[r], 0.f) & 0xffffu); }
#undef SLOAD
#undef SWRITE
#undef SWAIT
#undef RESC
}
}
struct Ctx { LAS unsigned char* lds; int tid, lane, wave, bid, G, gw, NGW; };

template <class F>
__device__ __forceinline__ void conv_tile(F src4, bf16_t* dst, int Kd, int n0, int k0, LAS float* scr, int lane) {
    const int kr = lane >> 3, n4 = (lane & 7) * 4;
    f32x4 v[8];
#pragma unroll
    for (int i = 0; i < 8; ++i) v[i] = src4(n0 + n4, k0 + 8 * i + kr);
#pragma unroll
    for (int i = 0; i < 8; ++i) { LAS float* o = scr + (8 * i + kr) * 33 + n4; o[0] = v[i].x; o[1] = v[i].y; o[2] = v[i].z; o[3] = v[i].w; }
    LDS_WAIT(); asm volatile("" ::: "memory");
    const int c = lane & 7;
#pragma unroll
    for (int j = 0; j < 4; ++j) { const int n = (lane >> 3) + 8 * j; const LAS float* s = scr + (8 * c) * 33 + n;
        u32x4 o; o.x = cvt_pk_bf16(s[0 * 33], s[1 * 33]); o.y = cvt_pk_bf16(s[2 * 33], s[3 * 33]); o.z = cvt_pk_bf16(s[4 * 33], s[5 * 33]); o.w = cvt_pk_bf16(s[6 * 33], s[7 * 33]);
        *(u32x4*)(dst + (size_t)(n0 + n) * Kd + k0 + 8 * c) = o; }
    LDS_WAIT(); asm volatile("" ::: "memory");
}
#define CONV_JOB(ND, KD, DST, ...) do { const int nbk_ = (ND) / 32, nit_ = nbk_ * ((KD) / 64); bf16_t* dst_ = (bf16_t*)(DST); \
    for (int it_ = F.gw; it_ < nit_; it_ += F.NGW) conv_tile(__VA_ARGS__, dst_, (KD), (it_ % nbk_) * 32, (it_ / nbk_) * 64, scr, F.lane); } while (0)
__device__ __forceinline__ float bf_hi(float w) { return __uint_as_float(cvt_pk_bf16(w, 0.f) << 16); }

__device__ __forceinline__ int row_type(int r) { const int b = r / TPB, t = r - b * TPB; return t < CTXL ? 2 : b; }

__device__ __forceinline__ void modnorm_row(float* X, const float* g, const float* mods_l, int s, int r, int lane, f32x4 (&y)[8], const float* part, int nsplit) {
    const int rt = row_type(r);
    f32x4* xr = (f32x4*)(X + (size_t)r * DM) + lane;
    if (part != nullptr && rt == 2) {
        const int cr = (r / TPB) * CTXL + (r % TPB);
#pragma unroll
        for (int j = 0; j < 8; ++j) { f32x4 a = xr[64 * j];
            for (int k = 0; k < nsplit; ++k) a += ((const f32x4*)(part + ((size_t)k * (NB * CTXL) + cr) * DM))[lane + 64 * j];
            xr[64 * j] = a; }
    }
    const f32x4* gp = (const f32x4*)g + lane;
    const f32x4* sh = (const f32x4*)(mods_l + (size_t)(rt * NMOD + 3 * s) * DM) + lane;
    const f32x4* sc = (const f32x4*)(mods_l + (size_t)(rt * NMOD + 3 * s + 1) * DM) + lane;
    float ss = 0.f;
#pragma unroll
    for (int j = 0; j < 8; ++j) { y[j] = xr[64 * j]; ss += (y[j].x * y[j].x + y[j].y * y[j].y) + (y[j].z * y[j].z + y[j].w * y[j].w); }
    const float rinv = rsqrtf(wave_sum(ss) * (1.0f / DM) + 1e-6f);
#pragma unroll
    for (int j = 0; j < 8; ++j) y[j] = (y[j] * rinv) * gp[64 * j] * (1.0f + sc[64 * j]) + sh[64 * j];
}
__device__ __forceinline__ void store_row_bf16(bf16_t* dst, int lane, const f32x4 (&y)[8]) {
    u32x2* o = (u32x2*)dst + lane;
#pragma unroll
    for (int j = 0; j < 8; ++j) { u32x2 w; w.x = cvt_pk_bf16(y[j].x, y[j].y); w.y = cvt_pk_bf16(y[j].z, y[j].w); o[64 * j] = w; }
}
__device__ __forceinline__ float rope_invfreq(int j, int half) { return powf(10000.0f, -(float)j / (float)half); }
constexpr int FFT_TW = 2730;
__device__ __forceinline__ int fft_toff(int s) { return s == 0 ? 0 : (s == 1 ? 2048 : (s == 2 ? 2560 : (s == 3 ? 2688 : (s == 4 ? 2720 : 2728)))); }
__device__ __forceinline__ f32x2 cmul(f32x2 a, f32x2 b) { return (f32x2){a.x * b.x - a.y * b.y, a.x * b.y + a.y * b.x}; }
__device__ __forceinline__ f32x2 cmulc(f32x2 a, f32x2 b) { return (f32x2){a.x * b.x + a.y * b.y, a.y * b.x - a.x * b.y}; }
template <int LOGN>
__device__ __forceinline__ void fft4_fwd(LAS f32x2* x, const LAS f32x2* twl, int tid) {
    constexpr int N = 1 << LOGN, NS = (LOGN - 1) / 2, S0 = 6 - NS, NB = (N / 4 + NTHR - 1) / NTHR, BG = NB < 2 ? NB : 2;
#pragma unroll 1
    for (int s = 0; s < NS; ++s) {
        const int q = N >> (2 * s + 2); const LAS f32x2* tw = twl + fft_toff(S0 + s);
#pragma unroll
      for (int g0 = 0; g0 < NB; g0 += BG) {
        f32x2 a0[BG], a1[BG], a2[BG], a3[BG], w1[BG], w2[BG], w3[BG]; int base[BG];
#pragma unroll
        for (int it = 0; it < BG; ++it) { const int j = tid + NTHR * (g0 + it); const int pos = j & (q - 1); base[it] = ((j - pos) << 2) + pos;
            if (j < N / 4) { a0[it] = x[base[it]]; a1[it] = x[base[it] + q]; a2[it] = x[base[it] + 2 * q]; a3[it] = x[base[it] + 3 * q]; w1[it] = tw[pos]; w2[it] = tw[FFT_TW + pos]; w3[it] = tw[2 * FFT_TW + pos]; } }
#pragma unroll
        for (int it = 0; it < BG; ++it) { const int j = tid + NTHR * (g0 + it);
            if (j < N / 4) {
                const f32x2 t0 = a0[it] + a2[it], t1 = a0[it] - a2[it], t2 = a1[it] + a3[it], d = a1[it] - a3[it], t3 = (f32x2){d.y, -d.x};
                x[base[it]] = t0 + t2; x[base[it] + q] = cmul(t1 + t3, w1[it]); x[base[it] + 2 * q] = cmul(t0 - t2, w2[it]); x[base[it] + 3 * q] = cmul(t1 - t3, w3[it]); } }
      }
        __syncthreads();
    }
}
template <int LOGN>
__device__ __forceinline__ void fft4_inv(LAS f32x2* x, const LAS f32x2* twl, int tid) {
    constexpr int N = 1 << LOGN, NS = (LOGN - 1) / 2, S0 = 6 - NS, NB = (N / 4 + NTHR - 1) / NTHR, BG = NB < 2 ? NB : 2;
#pragma unroll 1
    for (int s = NS - 1; s >= 0; --s) {
        const int q = N >> (2 * s + 2); const LAS f32x2* tw = twl + fft_toff(S0 + s);
#pragma unroll
      for (int g0 = 0; g0 < NB; g0 += BG) {
        f32x2 z0[BG], z1[BG], z2[BG], z3[BG], w1[BG], w2[BG], w3[BG]; int base[BG];
#pragma unroll
        for (int it = 0; it < BG; ++it) { const int j = tid + NTHR * (g0 + it); const int pos = j & (q - 1); base[it] = ((j - pos) << 2) + pos;
            if (j < N / 4) { z0[it] = x[base[it]]; z1[it] = x[base[it] + q]; z2[it] = x[base[it] + 2 * q]; z3[it] = x[base[it] + 3 * q]; w1[it] = tw[pos]; w2[it] = tw[FFT_TW + pos]; w3[it] = tw[2 * FFT_TW + pos]; } }
#pragma unroll
        for (int it = 0; it < BG; ++it) { const int j = tid + NTHR * (g0 + it);
            if (j < N / 4) {
                const f32x2 y1 = cmulc(z1[it], w1[it]), y2 = cmulc(z2[it], w2[it]), y3 = cmulc(z3[it], w3[it]);
                const f32x2 t0 = z0[it] + y2, t1 = z0[it] - y2, t2 = y1 + y3, d = y1 - y3, t3 = (f32x2){-d.y, d.x};
                x[base[it]] = t0 + t2; x[base[it] + q] = t1 + t3; x[base[it] + 2 * q] = t0 - t2; x[base[it] + 3 * q] = t1 - t3; } }
      }
        __syncthreads();
    }
}
__device__ __forceinline__ float block_sum(float v, LAS float* red, int tid) {
    v = wave_sum(v);
    __syncthreads();
    if ((tid & 63) == 0) red[tid >> 6] = v;
    __syncthreads();
    float s = 0.f;
#pragma unroll
    for (int i = 0; i < 8; ++i) s += red[i];
    return s;
}
template <int LOGL>
__device__ __forceinline__ void hyena_channel(const Ctx& F, int c, const bf16_t* VXT, const float* HFT, const float* skip, bf16_t* Z) {
    constexpr int L = 1 << LOGL, N = 2 * L, LOGN = LOGL + 1, NPT = (L + NTHR - 1) / NTHR, NPR = (N / 2 + NTHR - 1) / NTHR  , TOFF = (LOGL == 12) ? CTXL : 0;
    LAS f32x2* buf = (LAS f32x2*)F.lds; const LAS f32x2* twl = (const LAS f32x2*)(F.lds + 65536); LAS float* red = (LAS float*)(F.lds + 131072);
    const int tid = F.tid;
    constexpr int NTAP = N / NTHR;
    const float wdelta = fabsf(-15.350567286626973f + (float)c * ((-3.0701134573253946f + 15.350567286626973f) / (float)(DM - 1)));
    const bf16_t* v0p = VXT + ((size_t)(0 * 6144 + c)) * TPB + TOFF; const bf16_t* v1p = VXT + ((size_t)(1 * 6144 + c)) * TPB + TOFF;
    float zr[NPT], zi[NPT], gt[2][2][NPT], tp[2][NTAP];
#pragma unroll
    for (int i = 0; i < NPT; ++i) { const int t = tid + NTHR * i; zr[i] = (t < L) ? bf2f(v0p[t]) : 0.f; zi[i] = (t < L) ? bf2f(v1p[t]) : 0.f; }
#pragma unroll
    for (int o = 0; o < 2; ++o) {
        const float* kf = HFT + (size_t)((o * 2 + 0) * DM + c) * L; const float* kb = HFT + (size_t)((o * 2 + 1) * DM + c) * L;
#pragma unroll
        for (int i = 0; i < NTAP; ++i) { const int tau = tid + NTHR * i, lag = (tau < L) ? tau : N - tau;
            tp[o][i] = ((tau < L) ? kf[tau] : ((tau > L) ? kb[N - tau] : 0.f)) * __expf(-(float)lag * (1.0f / (float)(L - 1)) * wdelta); }
#pragma unroll
        for (int i = 0; i < NPT; ++i) { const int t = tid + NTHR * i;
            gt[o][0][i] = (t < L) ? bf2f(VXT[((size_t)(0 * 6144 + (o + 1) * DM + c)) * TPB + TOFF + t]) : 0.f; gt[o][1][i] = (t < L) ? bf2f(VXT[((size_t)(1 * 6144 + (o + 1) * DM + c)) * TPB + TOFF + t]) : 0.f; }
    }
#pragma unroll
    for (int o = 0; o < 2; ++o) {
        float ss = 0.f;
#pragma unroll
        for (int i = 0; i < NTAP; ++i) { const float g = tp[o][i]; ss += g * g; buf[tid + NTHR * i] = (f32x2){g, 0.f}; }
        const float scale = rsqrtf(block_sum(ss, red, tid) + 1e-12f) * (1.0f / N);
        fft4_fwd<LOGN>(buf, twl, tid);
        f32x4 G[NPR];
#pragma unroll
        for (int k = 0; k < NPR; ++k) { const int j = tid + NTHR * k; if (j < N / 2) { const f32x4 p = ((const LAS f32x4*)buf)[j]; G[k] = (f32x4){p.x + p.z, p.y + p.w, p.x - p.z, p.y - p.w}; } }
        __syncthreads();
#pragma unroll
        for (int i = 0; i < NPT; ++i) { const int t = tid + NTHR * i; if (t < L) { buf[t] = (f32x2){zr[i], zi[i]}; buf[t + L] = (f32x2){0.f, 0.f}; } }
        __syncthreads();
        fft4_fwd<LOGN>(buf, twl, tid);
#pragma unroll
        for (int k = 0; k < NPR; ++k) { const int j = tid + NTHR * k; if (j < N / 2) { const f32x4 p = ((const LAS f32x4*)buf)[j];
            const f32x2 a = (f32x2){p.x + p.z, p.y + p.w}, b = (f32x2){p.x - p.z, p.y - p.w};
            const f32x2 cc = cmul(a, (f32x2){G[k].x, G[k].y}), dd = cmul(b, (f32x2){G[k].z, G[k].w});
            ((LAS f32x4*)buf)[j] = (f32x4){cc.x + dd.x, cc.y + dd.y, cc.x - dd.x, cc.y - dd.y}; } }
        __syncthreads();
        fft4_inv<LOGN>(buf, twl, tid);
        const float sk = skip[o * DM + c];
#pragma unroll
        for (int i = 0; i < NPT; ++i) { const int t = tid + NTHR * i; if (t < L) { const f32x2 y = buf[t];
            zr[i] = gt[o][0][i] * (y.x * scale + sk * zr[i]); zi[i] = gt[o][1][i] * (y.y * scale + sk * zi[i]); } }
        __syncthreads();
    }
#pragma unroll
    for (int i = 0; i < NPT; ++i) { const int t = tid + NTHR * i; if (t < L) {
        Z[(size_t)c * ROWS + 0 * TPB + TOFF + t] = (bf16_t)(cvt_pk_bf16(zr[i], 0.f) & 0xffffu);
        Z[(size_t)c * ROWS + 1 * TPB + TOFF + t] = (bf16_t)(cvt_pk_bf16(zi[i], 0.f) & 0xffffu); } }
}
__device__ __forceinline__ void hyena_conv3_unit(const Ctx& F, int unit, const bf16_t* U, const float* cw, const float* cb, bf16_t* VXT) {
    const int cblk = unit % 96, tblk = (unit / 96) % 68, b = unit / (96 * 68);
    const int c0 = cblk * 64, t0 = tblk * 64, tid = F.tid;
    LAS float* tile = (LAS float*)F.lds;
    const int cl = tid & 63, tq = tid >> 6;
    const int ch = c0 + cl;
    const float w0 = cw[ch], w1 = cw[6144 + ch], w2 = cw[2 * 6144 + ch], bb = cb[ch];
#pragma unroll
    for (int i = 0; i < 8; ++i) { const int tl = tq + 8 * i, t = t0 + tl; const size_t row = (size_t)b * TPB + t;
        const bool hp = (t != 0) && (t != CTXL), hn = (t != CTXL - 1) && (t != TPB - 1);
        const float um = hp ? bf2f(U[(row - 1) * 6144 + ch]) : 0.f, u0 = bf2f(U[row * 6144 + ch]), up = hn ? bf2f(U[(row + 1) * 6144 + ch]) : 0.f;
        tile[cl * 65 + tl] = um * w0 + u0 * w1 + up * w2 + bb; }
    __syncthreads();
    const int tl2 = tid & 63, cq = tid >> 6;
#pragma unroll
    for (int i = 0; i < 8; ++i) { const int cc = cq + 8 * i; VXT[((size_t)b * 6144 + c0 + cc) * TPB + t0 + tl2] = (bf16_t)(cvt_pk_bf16(tile[cc * 65 + tl2], 0.f) & 0xffffu); }
    __syncthreads();
}

__device__ __forceinline__ float dpp_sum16(float v) {
    v += __int_as_float(__builtin_amdgcn_update_dpp(0, __float_as_int(v), 0xB1, 0xF, 0xF, false));
    v += __int_as_float(__builtin_amdgcn_update_dpp(0, __float_as_int(v), 0x4E, 0xF, 0xF, false));
    v += __int_as_float(__builtin_amdgcn_update_dpp(0, __float_as_int(v), 0x141, 0xF, 0xF, false));
    v += __int_as_float(__builtin_amdgcn_update_dpp(0, __float_as_int(v), 0x140, 0xF, 0xF, false));
    return v;
}
__device__ __forceinline__ float dpp_sum8(float v) {
    v += __int_as_float(__builtin_amdgcn_update_dpp(0, __float_as_int(v), 0xB1, 0xF, 0xF, false));
    v += __int_as_float(__builtin_amdgcn_update_dpp(0, __float_as_int(v), 0x4E, 0xF, 0xF, false));
    v += __int_as_float(__builtin_amdgcn_update_dpp(0, __float_as_int(v), 0x141, 0xF, 0xF, false));
    return v;
}
template <class BG>
__device__ __forceinline__ void rwkv_scan_unit(const Ctx& F, int unit, const float* DEC, const float* ASIG, const float* k_k, const float* k_a, const float* RKV, float* Y, BG bg) {
    constexpr int T = 32, NCHUNK = TPB / T;
    const int chain = unit >> 1, rh = unit & 1, d = chain >> 6, b = (chain >> 5) & 1, h = chain & 31;
    LAS float* buf = (LAS float*)F.lds;
    const int tid = F.tid, wave = F.wave, lane = F.lane;
    const int rl = wave * 8 + (lane >> 3), kq = lane & 7;
    float* Yd = Y + (size_t)d * ROWS * DM + h * 64 + rh * 32 + rl;
#define RW_ROW(sg) ((size_t)b * TPB + (d == 0 ? (sg) : ((sg) < CTXL ? (CTXL - 1 - (sg)) : (TPB + CTXL - 1 - (sg)))))
    const int st = (tid - 256) & 255, q4 = st & 15, s0 = st >> 4;
    const int hc = h * 64 + q4 * 4;
    const f32x4 ka4 = *(const f32x4*)(k_a + hc), kk4 = *(const f32x4*)(k_k + hc);
    f32x4 R[2][5];
#define ST_ISSUE(ck_) do { _Pragma("unroll") for (int j_ = 0; j_ < 2; ++j_) { const size_t row_ = RW_ROW((ck_) * T + s0 + 16 * j_); \
            R[j_][0] = *(const f32x4*)(DEC + row_ * (2 * DM) + (size_t)d * DM + hc); R[j_][1] = *(const f32x4*)(RKV + ((size_t)ROWS + row_) * DM + hc); \
            R[j_][2] = *(const f32x4*)(ASIG + row_ * (2 * DM) + (size_t)d * DM + hc); R[j_][3] = *(const f32x4*)(RKV + row_ * DM + hc); R[j_][4] = *(const f32x4*)(RKV + ((size_t)2 * ROWS + row_) * DM + hc); } } while (0)
#define ST_WRITE(p_) do { _Pragma("unroll") for (int j_ = 0; j_ < 2; ++j_) { LAS float* o_ = buf + (((p_) * T + s0 + 16 * j_) * 6) * 64 + q4 * 4; \
            const f32x4 a_ = R[j_][2], k_ = R[j_][1]; \
            f32x4 kk_ = k_ * kk4;      \
            const float ss_ = dpp_sum16((kk_.x * kk_.x + kk_.y * kk_.y) + (kk_.z * kk_.z + kk_.w * kk_.w)); \
            kk_ = kk_ * rsqrtf(ss_ + 1e-12f); \
            *(LAS f32x4*)(o_) = R[j_][0]; *(LAS f32x4*)(o_ + 64) = k_ * (1.0f + (a_ - 1.0f) * ka4); *(LAS f32x4*)(o_ + 128) = kk_; *(LAS f32x4*)(o_ + 192) = kk_ * a_; \
            *(LAS f32x4*)(o_ + 256) = R[j_][3]; *(LAS f32x4*)(o_ + 320) = R[j_][4]; } } while (0)
    f32x2 S0 = (f32x2){0.f, 0.f}, S1 = S0, S2 = S0, S3 = S0;
    __syncthreads();
    if (wave >= 4) { ST_ISSUE(0); ST_WRITE(0); ST_ISSUE(1); }
    __syncthreads();
#define RW_LD(W0, W1, K0, K1, A0, A1, B0, B1, R0_, R1_, VT, s_) do { const LAS float* base_ = cb + (s_) * 6 * 64; \
                W0 = *(const LAS f32x4*)(base_); W1 = *(const LAS f32x4*)(base_ + 4); K0 = *(const LAS f32x4*)(base_ + 64); K1 = *(const LAS f32x4*)(base_ + 68); \
                A0 = *(const LAS f32x4*)(base_ + 128); A1 = *(const LAS f32x4*)(base_ + 132); B0 = *(const LAS f32x4*)(base_ + 192); B1 = *(const LAS f32x4*)(base_ + 196); \
                R0_ = *(const LAS f32x4*)(base_ + 256); R1_ = *(const LAS f32x4*)(base_ + 260); VT = vb[(s_) * 6 * 64]; } while (0)
    f32x4 rp0 = (f32x4){0.f, 0.f, 0.f, 0.f}, rp1 = rp0; float yk = 0.f;
#define RW_YKEEP(gv_, y_) do { yk = (kq == ((gv_) & 7)) ? (y_) : yk; \
        if (((gv_) & 7) == 7) { const int sg_ = (gv_) - 7 + kq; const int rr_ = (d == 0) ? sg_ : ((sg_ < CTXL) ? (CTXL - 1 - sg_) : (TPB + CTXL - 1 - sg_)); Yd[((size_t)b * TPB + rr_) * DM] = yk; } } while (0)
#pragma unroll 1
    for (int ck = 0; ck < NCHUNK; ++ck) {
        const int p = ck & 1;
        if (wave >= 4) { if (ck + 1 < NCHUNK) { ST_WRITE(p ^ 1); if (ck + 2 < NCHUNK) ST_ISSUE(ck + 2); } bg(ck, wave - 4); }
        else {
            const LAS float* cb = buf + p * T * 6 * 64 + kq * 8;
            const LAS float* vb = buf + p * T * 6 * 64 + 5 * 64 + rh * 32 + rl;
            f32x4 w0, w1, k0, k1, a0, a1, b0, b1, r0, r1; float vt;
            f32x4 nw0, nw1, nk0, nk1, na0, na1, nb0, nb1, nr0, nr1; float nvt;
            RW_LD(w0, w1, k0, k1, a0, a1, b0, b1, r0, r1, vt, 0);
#pragma unroll
            for (int s = 0; s < T; ++s) {
                if (s + 1 < T) RW_LD(nw0, nw1, nk0, nk1, na0, na1, nb0, nb1, nr0, nr1, nvt, s + 1);
                __builtin_amdgcn_sched_barrier(0);
                const f32x2 vt2 = (f32x2){vt, vt};
                f32x2 t0 = vt2 * (f32x2){k0.x, k0.y}, t1 = vt2 * (f32x2){k0.z, k0.w}, t2 = vt2 * (f32x2){k1.x, k1.y}, t3 = vt2 * (f32x2){k1.z, k1.w};
                asm volatile("" : "+v"(t0), "+v"(t1), "+v"(t2), "+v"(t3));
                f32x2 da = S0 * (f32x2){a0.x, a0.y}, db = S2 * (f32x2){a1.x, a1.y};
                f32x2 ya = S0 * (f32x2){rp0.x, rp0.y}, yb = S2 * (f32x2){rp1.x, rp1.y};
                da = S1 * (f32x2){a0.z, a0.w} + da; db = S3 * (f32x2){a1.z, a1.w} + db;
                ya = S1 * (f32x2){rp0.z, rp0.w} + ya; yb = S3 * (f32x2){rp1.z, rp1.w} + yb;
                da = da + db; ya = ya + yb;
                float xs = da.x + da.y, ys = ya.x + ya.y;
                xs += __int_as_float(__builtin_amdgcn_update_dpp(0, __float_as_int(xs), 0xB1, 0xF, 0xF, false)); ys += __int_as_float(__builtin_amdgcn_update_dpp(0, __float_as_int(ys), 0xB1, 0xF, 0xF, false));
                xs += __int_as_float(__builtin_amdgcn_update_dpp(0, __float_as_int(xs), 0x4E, 0xF, 0xF, false)); ys += __int_as_float(__builtin_amdgcn_update_dpp(0, __float_as_int(ys), 0x4E, 0xF, 0xF, false));
                xs += __int_as_float(__builtin_amdgcn_update_dpp(0, __float_as_int(xs), 0x141, 0xF, 0xF, false)); ys += __int_as_float(__builtin_amdgcn_update_dpp(0, __float_as_int(ys), 0x141, 0xF, 0xF, false));
                const f32x2 sa2 = (f32x2){-xs, -xs};
                f32x2 u0 = sa2 * (f32x2){b0.x, b0.y} + t0, u1 = sa2 * (f32x2){b0.z, b0.w} + t1, u2 = sa2 * (f32x2){b1.x, b1.y} + t2, u3 = sa2 * (f32x2){b1.z, b1.w} + t3;
                asm volatile("" : "+v"(u0), "+v"(u1), "+v"(u2), "+v"(u3));
                S0 = S0 * (f32x2){w0.x, w0.y} + u0; S1 = S1 * (f32x2){w0.z, w0.w} + u1; S2 = S2 * (f32x2){w1.x, w1.y} + u2; S3 = S3 * (f32x2){w1.z, w1.w} + u3;
                if (s > 0) { RW_YKEEP(ck * T + s - 1, ys); } else if (ck > 0) { RW_YKEEP(ck * T - 1, ys); }
                __builtin_amdgcn_sched_barrier(0);
                rp0 = r0; rp1 = r1;
                w0 = nw0; w1 = nw1; k0 = nk0; k1 = nk1; a0 = na0; a1 = na1; b0 = nb0; b1 = nb1; r0 = nr0; r1 = nr1; vt = nvt;
            }
        }
        __syncthreads();
    }
    if (wave < 4) {
        f32x2 ya = S0 * (f32x2){rp0.x, rp0.y}, yb = S2 * (f32x2){rp1.x, rp1.y};
        ya = S1 * (f32x2){rp0.z, rp0.w} + ya; yb = S3 * (f32x2){rp1.z, rp1.w} + yb; ya = ya + yb;
        const float ys = dpp_sum8(ya.x + ya.y);
        RW_YKEEP(TPB - 1, ys);
    }
#undef RW_YKEEP
#undef RW_LD
#undef ST_ISSUE
#undef ST_WRITE
#undef RW_ROW
}
__device__ __forceinline__ float head_sum16(float v) { v += __shfl_xor(v, 1); v += __shfl_xor(v, 2); v += __shfl_xor(v, 4); v += __shfl_xor(v, 8); return v; }
__device__ __forceinline__ void rwkv_shift_row(const float* HLF, const float* mix, bf16_t* XS, int r, int lane) {
    const int t = r % TPB;
    const bool hp = (t != 0) && (t != CTXL), hn = (t != CTXL - 1) && (t != TPB - 1);
    const f32x4* h0 = (const f32x4*)(HLF + (size_t)r * DM) + lane;
    const f32x4 z4 = (f32x4){0.f, 0.f, 0.f, 0.f};
#pragma unroll 2
    for (int j = 0; j < 8; ++j) {
        const f32x4 h = h0[64 * j], p = hp ? h0[64 * j - DM / 4] : z4, n = hn ? h0[64 * j + DM / 4] : z4;
        const f32x4 dp = p - h, dn = n - h;
#pragma unroll
        for (int k = 0; k < 6; ++k) {
            const f32x4 m0 = ((const f32x4*)(mix + (size_t)k * DM))[lane + 64 * j], m1 = ((const f32x4*)(mix + (size_t)(6 + k) * DM))[lane + 64 * j];
            const f32x4 x = h + dp * m0 + dn * m1;
            u32x2 w; w.x = cvt_pk_bf16(x.x, x.y); w.y = cvt_pk_bf16(x.z, x.w);
            ((u32x2*)(XS + ((size_t)k * ROWS + r) * DM))[lane + 64 * j] = w;
        }
    }
}
__device__ __forceinline__ void rwkv_prep_row(const float* Kf, const float* k_k, float* KK, int r, int lane) {
#pragma unroll 2
    for (int j = 0; j < 8; ++j) {
        const int q = lane + 64 * j;
        const f32x4 k = ((const f32x4*)(Kf + (size_t)r * DM))[q], kkw = ((const f32x4*)k_k)[q];
        f32x4 kk = k * kkw;
        const float ss = head_sum16((kk.x * kk.x + kk.y * kk.y) + (kk.z * kk.z + kk.w * kk.w));
        ((f32x4*)(KK + (size_t)r * DM))[q] = kk * rsqrtf(ss + 1e-12f);
    }
}
__device__ __forceinline__ void rwkv_readout_row(const float* Y, const float* RKV, const float* ASIG, const float* k_a, const float* Gf, const float* r_k, const float* ln_w, const float* ln_b, bf16_t* out, int r, int lane) {
#pragma unroll 2
    for (int j = 0; j < 8; ++j) {
        const int q = lane + 64 * j;
        const f32x4 y = ((const f32x4*)(Y + (size_t)r * DM))[q] + ((const f32x4*)(Y + ((size_t)ROWS + r) * DM))[q];
        const float mu = head_sum16((y.x + y.y) + (y.z + y.w)) * (1.0f / 64.0f);
        const f32x4 dlt = y - mu;
        const float var = head_sum16((dlt.x * dlt.x + dlt.y * dlt.y) + (dlt.z * dlt.z + dlt.w * dlt.w)) * (1.0f / 64.0f);
        f32x4 yn = dlt * rsqrtf(var + 64e-5f) * ((const f32x4*)ln_w)[q] + ((const f32x4*)ln_b)[q];
        const f32x4 rr = ((const f32x4*)(RKV + (size_t)r * DM))[q], vv = ((const f32x4*)(RKV + ((size_t)2 * ROWS + r) * DM))[q];
        const f32x4 kf = ((const f32x4*)(RKV + ((size_t)ROWS + r) * DM))[q], asum = ((const f32x4*)(ASIG + (size_t)r * 2 * DM))[q] + ((const f32x4*)(ASIG + (size_t)r * 2 * DM + DM))[q];
        const f32x4 ks = kf * (2.0f + (asum - 2.0f) * ((const f32x4*)k_a)[q]);
        const f32x4 rk = rr * ((const f32x4*)r_k)[q] * ks;
        const float bs = head_sum16((rk.x + rk.y) + (rk.z + rk.w));
        yn = (yn + bs * vv) * ((const f32x4*)(Gf + (size_t)r * DM))[q];
        u32x2 w; w.x = cvt_pk_bf16(yn.x, yn.y); w.y = cvt_pk_bf16(yn.z, yn.w);
        ((u32x2*)(out + (size_t)r * DM))[q] = w;
    }
}

template <int HALF> __device__ __forceinline__ void rope_sincos(float pos, int lane, float& sn, float& cs) { sincosf(pos * rope_invfreq(lane & (HALF - 1), HALF), &sn, &cs); }
template <int HALF> __device__ __forceinline__ float rope_apply(float u, float sn, float cs, int lane) {
    const float up = __shfl_xor(u, HALF);
    return (lane & HALF) ? (up * sn + u * cs) : (u * cs - up * sn);
}
__device__ __forceinline__ void mla_row_a(const float* RAW, const float* qg, const float* kvg, bf16_t* CQN, bf16_t* CKVN, bf16_t* Kb, int r, int lane) {
    const float* raw = RAW + (size_t)r * 1280;
    const int t = r % TPB;
#pragma unroll
    for (int part = 0; part < 2; ++part) {
        const f32x4 a = ((const f32x4*)(raw + part * 512))[lane], b = ((const f32x4*)(raw + part * 512))[lane + 64];
        const float ss = wave_sum((a.x * a.x + a.y * a.y) + (a.z * a.z + a.w * a.w) + (b.x * b.x + b.y * b.y) + (b.z * b.z + b.w * b.w));
        const float rinv = rsqrtf(ss * (1.0f / 512.0f) + 1e-6f);
        const float* g = part ? kvg : qg;
        const f32x4 ya = a * rinv * ((const f32x4*)g)[lane], yb = b * rinv * ((const f32x4*)g)[lane + 64];
        bf16_t* o = (part ? CKVN : CQN) + (size_t)r * 512;
        u32x2 w; w.x = cvt_pk_bf16(ya.x, ya.y); w.y = cvt_pk_bf16(ya.z, ya.w); ((u32x2*)o)[lane] = w;
        w.x = cvt_pk_bf16(yb.x, yb.y); w.y = cvt_pk_bf16(yb.z, yb.w); ((u32x2*)o)[lane + 64] = w;
    }
    float kp = raw[1024 + lane];
    if (t >= CTXL) { const int l = t - CTXL; const float pos = (lane < 32) ? (float)(l >> 6) : (float)(l & 63); float sn, cs; rope_sincos<16>(pos, lane, sn, cs); kp = rope_apply<16>(kp, sn, cs, lane); }
    const bf16_t kb = (bf16_t)(cvt_pk_bf16(kp, 0.f) & 0xffffu);
#pragma unroll
    for (int h = 0; h < 16; ++h) Kb[(size_t)r * 3072 + h * 192 + 128 + lane] = kb;
}
__device__ __forceinline__ void mla_row_q(const float* QRAW, bf16_t* Qb, int r, int lane) {
    const float* q = QRAW + (size_t)r * 3072; bf16_t* o = Qb + (size_t)r * 3072;
    const int t = r % TPB; const bool lat = t >= CTXL; const int l = t - CTXL;
    const float pos = (lane < 32) ? (float)(l >> 6) : (float)(l & 63);
    float sn = 0.f, cs = 1.f; if (lat) rope_sincos<16>(pos, lane, sn, cs);
#pragma unroll 4
    for (int h = 0; h < 16; ++h) {
        const f32x2 a = ((const f32x2*)(q + h * 192))[lane];
        ((unsigned*)(o + h * 192))[lane] = cvt_pk_bf16(a.x, a.y);
        float pe = q[h * 192 + 128 + lane];
        if (lat) pe = rope_apply<16>(pe, sn, cs, lane);
        o[h * 192 + 128 + lane] = (bf16_t)(cvt_pk_bf16(pe, 0.f) & 0xffffu);
    }
}
template <bool CTX>
__device__ __forceinline__ void gqa_row(const float* RAW, const float* SL, const float* qg, const float* kg, bf16_t* Qb, bf16_t* Kb, bf16_t* Vb, int r, int lane) {
    const float* raw = RAW + (size_t)r * 4096;
    const float* sl = SL + (size_t)((r / TPB) * CTXL + (r % TPB)) * 2048 - 2048;
    constexpr size_t SS = (size_t)(NB * CTXL) * 2048;
    const int l = (r % TPB) - CTXL;
    float sn0 = 0.f, cs0 = 1.f, sn1 = 0.f, cs1 = 1.f; if (!CTX && l >= 0) { rope_sincos<32>((float)(l >> 6), lane, sn0, cs0); rope_sincos<32>((float)(l & 63), lane, sn1, cs1); }
#pragma unroll 2
    for (int h = CTX ? 16 : 0; h < 24; ++h) {
        float x0, x1;
        if (!CTX) { x0 = raw[h * 128 + lane]; x1 = raw[h * 128 + 64 + lane]; }
        else { x0 = (sl[h * 128 + lane] + sl[SS + h * 128 + lane]) + (sl[2 * SS + h * 128 + lane] + sl[3 * SS + h * 128 + lane]);
               x1 = (sl[h * 128 + 64 + lane] + sl[SS + h * 128 + 64 + lane]) + (sl[2 * SS + h * 128 + 64 + lane] + sl[3 * SS + h * 128 + 64 + lane]); }
        const float rinv = rsqrtf(wave_sum(x0 * x0 + x1 * x1) * (1.0f / 128.0f) + 1e-6f);
        const float* g = (h < 16) ? qg : kg;
        x0 = x0 * rinv * g[lane]; x1 = x1 * rinv * g[64 + lane];
        if (!CTX) { x0 = rope_apply<32>(x0, sn0, cs0, lane); x1 = rope_apply<32>(x1, sn1, cs1, lane); }
        bf16_t* o = (h < 16) ? (Qb + (size_t)r * 2048 + h * 128) : (Kb + (size_t)r * 1024 + (h - 16) * 128);
        o[lane] = (bf16_t)(cvt_pk_bf16(x0, 0.f) & 0xffffu); o[64 + lane] = (bf16_t)(cvt_pk_bf16(x1, 0.f) & 0xffffu);
    }
#pragma unroll
    for (int j = 0; j < 4; ++j) { f32x4 a;
        if (!CTX) a = ((const f32x4*)(raw + 3072))[lane + 64 * j];
        else a = (((const f32x4*)(sl + 3072))[lane + 64 * j] + ((const f32x4*)(sl + SS + 3072))[lane + 64 * j]) + (((const f32x4*)(sl + 2 * SS + 3072))[lane + 64 * j] + ((const f32x4*)(sl + 3 * SS + 3072))[lane + 64 * j]);
        u32x2 w; w.x = cvt_pk_bf16(a.x, a.y); w.y = cvt_pk_bf16(a.z, a.w); ((u32x2*)(Vb + (size_t)r * 1024))[lane + 64 * j] = w; }
}
struct Args { const float* in[49]; float* out; unsigned char* ws; int ph_lo, ph_hi, li, pad; };
constexpr int N_PHASES = 52;

#define RUN_GEMM(EPI_T, epi, A_, Bt_, K_, ...) do { typedef pg8::TSched<__VA_ARGS__> Sch_; Sch_ S_; S_.init(F.G, F.bid); pg8::gemm_phase<EPI_T, Sch_>(F.lds, pg8::Gemm{(const bf16_t*)(A_), (const bf16_t*)(Bt_), (K_)}, S_, (epi)); } while (0)

#define FFN_PHASES(p0, l, s, lat_only, nsp) do { \
    const float* mods_l_ = MODS + (size_t)(l) * 3 * NMOD * DM; const int h_ = (s) ? 1 : 0; \
    PHASE((p0)) { const float* g_ = AIN(6) + (size_t)((l) * 3 + (s)) * DM; \
        for (int r = F.gw; r < ROWS; r += F.NGW) { if ((lat_only) && (r % TPB) < CTXL) continue; f32x4 y[8]; modnorm_row(X, g_, mods_l_, (s), r, F.lane, y, (nsp) ? PART : nullptr, (nsp)); store_row_bf16(NBF + (size_t)r * DM, F.lane, y); } \
        if (BOTH((p0))) GRID_BAR(); } \
    PHASE((p0) + 1) { pg8::EpiSwiglu E{ACT}; \
        RUN_GEMM(pg8::EpiSwiglu, E, NBF, ws + WS_W + W_GU((l), h_), DM, (lat_only) ? 32 : NPAN, 44, 0, 0, 1, (lat_only) ? 1 : 0); if (BOTH((p0) + 1)) GRID_BAR(); } \
    PHASE((p0) + 2) { pg8::EpiResid E{X, mods_l_, 3 * (s) + 2, A.pad ? 0.f : 0.5f, nullptr}; \
        RUN_GEMM(pg8::EpiResid, E, ACT, ws + WS_W + W_DN((l), h_), FF, 32, 8, 0, 0, 1, 1, (lat_only) ? 0 : 2, 8, 0, 0, 11, 2);     if (BOTH((p0) + 2)) GRID_BAR(); } \
} while (0)

__device__ __forceinline__ const float* ain_(const Args& A, int i) { asm volatile("" : "+s"(i)); return A.in[i]; }
constexpr int BG_NSLOTS = 4 * 16896 + 1280 + 1792 + 2048 + 4096 + 2048;
__device__ __forceinline__ void bg_convert_slot(const Args& A, int slot, LAS float* scr, int lane) {
    if (slot >= BG_NSLOTS) return;
    unsigned char* W = A.ws + WS_W;
    const f32x4 z4 = (f32x4){0.f, 0.f, 0.f, 0.f};
#define LD4(p_) (*(const f32x4*)(p_))
#define CONV_ONE(ND, KD, DST, it_, ...) conv_tile(__VA_ARGS__, (bf16_t*)(DST), (KD), ((it_) % ((ND) / 32)) * 32, ((it_) / ((ND) / 32)) * 64, scr, lane)
    if (slot < 4 * 16896) {
        const int lh = 4 + slot / 16896, r = slot % 16896;
        if (r < 11264) { const float* sg = ain_(A, 7) + (size_t)lh * DM * (2 * FF);
            CONV_ONE(2 * FF, DM, W + W_GU(lh >> 1, lh & 1), r, [=](int n, int k) { const int sn = ((n >> 7) & 1) * FF + (n >> 8) * 128 + (n & 127); return LD4(sg + (size_t)k * (2 * FF) + sn); }); }
        else { const float* sd = ain_(A, 8) + (size_t)lh * FF * DM;
            CONV_ONE(DM, FF, W + W_DN(lh >> 1, lh & 1), r - 11264, [=](int n, int k) { return LD4(sd + (size_t)k * DM + n); }); }
        return;
    }
    int r = slot - 4 * 16896;
    if (r < 1280) { const float* s = ain_(A, 38); CONV_ONE(1280, DM, W + W_ML_WD, r, [=](int n, int k) { return n < 1088 ? LD4(s + (size_t)k * 1088 + n) : z4; }); return; } r -= 1280;
    if (r < 1792) { const float* s = ain_(A, 40); const float* s2 = ain_(A, 42); CONV_ONE(7168, 512, W + W_ML_BT3, r, [=](int n, int k) { return n < 3072 ? LD4(s + (size_t)k * 3072 + n) : LD4(s2 + (size_t)k * 4096 + (n - 3072)); }); return; } r -= 1792;
    if (r < 2048) { const float* s = ain_(A, 43); CONV_ONE(DM, DM, W + W_ML_WO, r, [=](int n, int k) { return LD4(s + (size_t)k * DM + n); }); return; } r -= 2048;
    if (r < 4096) { const float* s = ain_(A, 44); CONV_ONE(2 * DM, DM, W + W_GQ_QKV, r, [=](int n, int k) { return LD4(s + (size_t)k * (2 * DM) + n); }); return; } r -= 4096;
    { const float* s = ain_(A, 47); CONV_ONE(DM, DM, W + W_GQ_WO, r, [=](int n, int k) { return LD4(s + (size_t)k * DM + n); }); }
#undef CONV_ONE
#undef LD4
}
__global__ void __launch_bounds__(NTHR, 2) fwd_kernel(Args A) {
    extern __shared__ __attribute__((aligned(16))) unsigned char lds_raw[];
    Ctx F;
    F.lds = (LAS unsigned char*)lds_raw;
    F.tid = threadIdx.x; F.lane = F.tid & 63; F.wave = __builtin_amdgcn_readfirstlane(F.tid >> 6);
    F.bid = blockIdx.x; F.G = gridDim.x; F.gw = F.bid * NWAVES + F.wave; F.NGW = F.G * NWAVES;
    volatile LAS unsigned* MISC = (volatile LAS unsigned*)(F.lds + MISC_OFF);
    if (F.tid < 32) MISC[F.tid] = 0u;
    __syncthreads();
    const int lo = A.ph_lo, hi = A.ph_hi;
    XcdBarrier bar; bar.bar = (unsigned*)(A.ws + WS_CTL) + CW_BAR + A.li * XCD_BAR_WORDS; bar.x = 0; bar.st = MISC + 8;
    if (hi - lo > 1) bar = xcd_barrier_post((unsigned*)(A.ws + WS_CTL) + CW_BAR + A.li * XCD_BAR_WORDS, MISC + 8);
#ifndef PH_MIN
#define PH_MIN 0
#define PH_MAX 1000
#endif
#define IN(k) ((k) >= PH_MIN && (k) <= PH_MAX && lo <= (k) && (k) < hi)
#define BOTH(k) (IN(k) && IN((k) + 1))
#define PHASE(k) if (IN(k))
#define GRID_BAR() xcd_barrier(bar)
#define ws (A.ws)
#define AIN(i) ain_(A, (i))
#define MODS ((float*)(ws + WS_MODS))
#define TW ((f32x2*)(ws + WS_TW))
#define HIDA ((bf16_t*)(ws + WS_HIDA))
#define ADAP ((float*)(ws + WS_ADAP))
#define X ((float*)(ws + WS_X))
#define NBF ((bf16_t*)(ws + WS_NB))
#define ACT ((bf16_t*)(ws + WS_ACT))
#define mix (ws + WS_MIX)
#define PART ((float*)(ws + WS_PART))

    PHASE(0) {
        { const float* xin = AIN(0); const float* cin = AIN(2);
          for (size_t i = (size_t)F.bid * NTHR + F.tid; i < (size_t)ROWS * (DM / 4); i += (size_t)F.G * NTHR) {
              const int r = (int)(i / (DM / 4)), c4 = (int)(i % (DM / 4)), b = r / TPB, t = r % TPB;
              const float* src = (t < CTXL) ? cin + ((size_t)b * CTXL + t) * DM : xin + ((size_t)b * SEQ + (t - CTXL)) * DM;
              ((f32x4*)(X + (size_t)r * DM))[c4] = ((const f32x4*)src)[c4]; } }
        for (int k = F.bid * NTHR + F.tid; k < 8192; k += F.G * NTHR) { float sn, cs; sincospif((float)k * (1.0f / 4096.0f), &sn, &cs); TW[k] = (f32x2){cs, -sn}; }
        { LAS float* sl = (LAS float*)(F.lds + 73728);
          for (int i = F.tid; i < 3 * DM; i += NTHR) { const float v = (i < 2 * DM) ? AIN(1)[i] : AIN(3)[i - 2 * DM]; sl[i] = v / (1.0f + expf(-v)); }
          __syncthreads();
          const float* aw = AIN(4);
          for (int unit = F.bid; unit < 4 * 9 * 16; unit += F.G) {
              const int l = unit / 144, rem = unit % 144, cc = rem / 16, kc = rem % 16, col = cc * 2048 + F.tid * 4;
              f32x4 a0 = (f32x4){0.f, 0.f, 0.f, 0.f}, a1 = a0, a2 = a0;
              const float* wp = aw + ((size_t)l * DM + kc * 128) * NADA + col;
#pragma unroll 8
              for (int k = 0; k < 128; ++k) { const f32x4 w = *(const f32x4*)(wp + (size_t)k * NADA); const int kk = kc * 128 + k;
                  a0 += w * sl[kk]; a1 += w * sl[DM + kk]; a2 += w * sl[2 * DM + kk]; }
              float* op = ADAP + ((size_t)(kc * 4 + l) * 3) * NADA + col;
              *(f32x4*)op = a0; *(f32x4*)(op + NADA) = a1; *(f32x4*)(op + 2 * NADA) = a2; }
          __syncthreads(); }
        { LAS float* scr = (LAS float*)(F.lds + F.wave * 8448);
          unsigned char* W = ws + WS_W;
#define LD4(p_) (*(const f32x4*)(p_))
          const f32x4 z4 = (f32x4){0.f, 0.f, 0.f, 0.f};
#pragma unroll 1
          for (int lh = 0; lh < 4; ++lh) {
              const float* sg = AIN(7) + (size_t)lh * DM * (2 * FF); const float* sd = AIN(8) + (size_t)lh * FF * DM;
              CONV_JOB(2 * FF, DM, W + W_GU(lh >> 1, lh & 1), [=](int n, int k) { const int sn = ((n >> 7) & 1) * FF + (n >> 8) * 128 + (n & 127); return LD4(sg + (size_t)k * (2 * FF) + sn); });
              CONV_JOB(DM, FF, W + W_DN(lh >> 1, lh & 1), [=](int n, int k) { return LD4(sd + (size_t)k * DM + n); });
          }
          { const float* s = AIN(9);  CONV_JOB(3 * DM, DM, W + W_HY_IN, [=](int n, int k) { return LD4(s + (size_t)k * (3 * DM) + n); }); }
          { const float* s = AIN(20); CONV_JOB(DM, DM, W + W_HY_OUT, [=](int n, int k) { return LD4(s + (size_t)k * DM + n); }); }
          { const float* s = AIN(17); CONV_JOB(4 * DM, 256, W + W_HY_F3, [=](int n, int k) { const int seg = k >> 6; if (seg == 3) return z4; const f32x4 w = LD4(s + (size_t)(k & 63) * (4 * DM) + n);
                const f32x4 h = (f32x4){bf_hi(w.x), bf_hi(w.y), bf_hi(w.z), bf_hi(w.w)}; return seg == 2 ? w - h : h; }); }
          { const float* s = AIN(23); const float* w1 = AIN(25); const float* a1 = AIN(28); const float* g1 = AIN(30);
            CONV_JOB(6912, DM, W + W_RW_BT1, [=](int n, int k) { if (n < 3 * DM) return LD4(s + ((size_t)(n >> 11) * DM + k) * DM + (n & (DM - 1)));
                const int j = n - 3 * DM, blk = j >> 8, jj = j & 255; if (blk == 2) return LD4(g1 + (size_t)k * 256 + jj); if (jj >= 192) return z4;
                const int d = jj / 96, e = jj - d * 96; return LD4((blk ? a1 : w1) + ((size_t)d * DM + k) * 96 + e); }); }
          { const float* w2 = AIN(26); const float* a2 = AIN(29); const float* g2 = AIN(31);
            CONV_JOB(10240, 256, W + W_RW_BT2, [=](int n, int k) { if (n >= 4 * DM) return LD4(g2 + (size_t)k * DM + (n - 4 * DM));
                const int blk = n >> 12, nn = n & 4095, d = nn >> 11, c = nn & (DM - 1), kk = k - 96 * d; if (kk < 0 || kk >= 96) return z4;
                return LD4((blk ? a2 : w2) + ((size_t)d * 96 + kk) * DM + c); }); }
          { const float* s = AIN(37); CONV_JOB(DM, DM, W + W_RW_WO, [=](int n, int k) { return LD4(s + (size_t)k * DM + n); }); }
#undef LD4
        }
        {
        const float* fw1 = AIN(13); const float* fb1 = AIN(14); const float* fw2 = AIN(15); const float* fb2 = AIN(16); const float* sf = AIN(18);
        for (int m = F.gw; m < 4352; m += F.NGW) {
            const int L = (m < 4096) ? 4096 : 256, mm = (m < 4096) ? m : m - 4096, j = F.lane;
            const float wv = (float)(6.283185307179586 / (double)L) * (float)mm;
            float z = 0.f;
            if (j == 0) z = (float)mm / (float)(L - 1);
            else if (j <= 16) z = cosf((1e-4f + (float)(j - 1) * ((15.0f - 1e-4f) / 15.0f)) * wv);
            else if (j <= 32) z = -sinf((1e-4f + (float)(j - 17) * ((15.0f - 1e-4f) / 15.0f)) * wv);
            float acc = fb1[j];
#pragma unroll
            for (int i = 0; i < 33; ++i) acc += __shfl(z, i) * fw1[i * 64 + j];
            const float h1 = sinf(sf[j] * acc);
            acc = fb2[j];
#pragma unroll
            for (int i = 0; i < 64; ++i) acc += __shfl(h1, i) * fw2[i * 64 + j];
            const float h2 = sinf(sf[64 + j] * acc);
            const float hh = bf_hi(h2);
            bf16_t* o = HIDA + (size_t)m * 256;
            const bf16_t bh = (bf16_t)(cvt_pk_bf16(hh, 0.f) & 0xffffu), bl = (bf16_t)(cvt_pk_bf16(h2 - hh, 0.f) & 0xffffu);
            o[j] = bh; o[64 + j] = bl; o[128 + j] = bh; o[192 + j] = 0; }
        }
        if (BOTH(0)) GRID_BAR();
    }
    PHASE(1) {
        const float* ab = AIN(5);
        for (int i = F.bid * NTHR + F.tid; i < 4 * 3 * NADA; i += F.G * NTHR) {
            const int l = i / (3 * NADA), n = i % NADA; float s = ab[(size_t)l * NADA + n];
#pragma unroll
            for (int kc = 0; kc < 16; ++kc) s += ADAP[(size_t)kc * 12 * NADA + i];
            MODS[i] = s; }
        if (BOTH(1)) GRID_BAR();
    }
    FFN_PHASES(2, 0, 0, 0, 0);
    { const float* mods_l = MODS;
      bf16_t* U = (bf16_t*)(mix + HY_U); bf16_t* VXT = (bf16_t*)(mix + HY_VXT); float* HFT = (float*)(mix + HY_HFT); bf16_t* ZT = (bf16_t*)(mix + HY_U);
      PHASE(5) { const float* g = AIN(6) + (size_t)(0 * 3 + 1) * DM;
          for (int r = F.gw; r < ROWS; r += F.NGW) { f32x4 y[8]; modnorm_row(X, g, mods_l, 1, r, F.lane, y, PART, 11); store_row_bf16(NBF + (size_t)r * DM, F.lane, y); }
          { pg8::EpiHyF E{HFT, HFT + (size_t)8192 * 4096}; RUN_GEMM(pg8::EpiHyF, E, HIDA, ws + WS_W + W_HY_F3, 256, 17, 32, 0, 0, 1, 0); }
          if (BOTH(5)) GRID_BAR(); }
      PHASE(6) { pg8::EpiBf16B E{U, 3 * DM, AIN(10)};
          RUN_GEMM(pg8::EpiBf16B, E, NBF, ws + WS_W + W_HY_IN, DM, NPAN, 24, 0, 0, 1, 0); if (BOTH(6)) GRID_BAR(); }
      PHASE(7) { for (int unit = F.bid; unit < 2 * 68 * 96; unit += F.G) hyena_conv3_unit(F, unit, U, AIN(11), AIN(12), VXT); if (BOTH(7)) GRID_BAR(); }
      PHASE(8) { __syncthreads();
          { LAS f32x2* twl = (LAS f32x2*)(F.lds + 65536);
            for (int e = F.tid; e < FFT_TW; e += NTHR) { const int s = e < 2048 ? 0 : (e < 2560 ? 1 : (e < 2688 ? 2 : (e < 2720 ? 3 : (e < 2728 ? 4 : 5)))); const int ix = (e - fft_toff(s)) << (2 * s);
                twl[e] = TW[ix]; twl[FFT_TW + e] = TW[2 * ix]; twl[2 * FFT_TW + e] = TW[3 * ix]; }
            __syncthreads(); }
          for (int c = F.bid; c < DM; c += F.G) hyena_channel<12>(F, c, VXT, HFT, AIN(19), ZT);
          for (int c = F.bid; c < DM; c += F.G) hyena_channel<8>(F, c, VXT, HFT + (size_t)8192 * 4096, AIN(19), ZT);
          if (BOTH(8)) GRID_BAR(); }
      PHASE(9) { __syncthreads();
          LAS bf16_t* tile = (LAS bf16_t*)F.lds;
          for (int unit = F.bid; unit < 136 * 32; unit += F.G) { const int r0 = (unit % 136) * 64, c0 = (unit / 136) * 64;
#pragma unroll
              for (int k = 0; k < 8; ++k) { const int cl = 8 * k + (F.tid >> 6); tile[cl * 66 + F.lane] = ZT[(size_t)(c0 + cl) * ROWS + r0 + F.lane]; }
              __syncthreads();
              { const int rl = F.tid >> 3, cs = (F.tid & 7) * 8; unsigned w[4];
#pragma unroll
                for (int e = 0; e < 4; ++e) w[e] = (unsigned)tile[(cs + 2 * e) * 66 + rl] | ((unsigned)tile[(cs + 2 * e + 1) * 66 + rl] << 16);
                *(u32x4*)(NBF + (size_t)(r0 + rl) * DM + c0 + cs) = (u32x4){w[0], w[1], w[2], w[3]}; }
              __syncthreads(); }
          if (BOTH(9)) GRID_BAR(); }
      PHASE(10) { pg8::EpiResid E{X, mods_l, 5, A.pad ? 0.f : 1.0f, AIN(21)};
          RUN_GEMM(pg8::EpiResid, E, NBF, ws + WS_W + W_HY_OUT, DM, 32, 8, 0, 0, 1, 1, 2, 8, 0, 0, 4, 2); if (BOTH(10)) GRID_BAR(); }
    }
    FFN_PHASES(11, 0, 2, 0, 4);
    FFN_PHASES(14, 1, 0, 0, 11);
    { const float* mods_l = MODS + (size_t)1 * 3 * NMOD * DM;
      bf16_t* XS = (bf16_t*)(mix + RW_XS); float* HLF = (float*)(mix + RW_HLF);
      float* RKV = (float*)(mix + RW_RKV); bf16_t* LM = (bf16_t*)(mix + RW_LM); float* DEC = (float*)(mix + RW_DEC); float* ASIG = (float*)(mix + RW_ASIG); float* Y = (float*)(mix + RW_Y);
      float* Gf = (float*)(mix + RW_G);
      PHASE(17) { const float* g = AIN(6) + (size_t)(1 * 3 + 1) * DM;
          for (int r = F.gw; r < ROWS; r += F.NGW) { f32x4 y[8]; modnorm_row(X, g, mods_l, 1, r, F.lane, y, PART, 11);
#pragma unroll
              for (int j = 0; j < 8; ++j) ((f32x4*)(HLF + (size_t)r * DM))[F.lane + 64 * j] = y[j]; }
          if (BOTH(17)) GRID_BAR(); }
      PHASE(18) { for (int r = F.gw; r < ROWS; r += F.NGW) rwkv_shift_row(HLF, AIN(22), XS, r, F.lane); if (BOTH(18)) GRID_BAR(); }
      PHASE(19) {
          pg8::EpiRw1 E{RKV, LM}; RUN_GEMM(pg8::EpiRw1, E, XS, ws + WS_W + W_RW_BT1, DM, NPAN, 8, 0 * NPAN, 0, 1, 0, NPAN, 8, 2 * NPAN, 8, 1, 0, NPAN, 8, 3 * NPAN, 16, 1, 0, NPAN, 1, 1 * NPAN, 24, 1, 0, NPAN, 1, 4 * NPAN, 25, 1, 0, NPAN, 1, 5 * NPAN, 26, 1, 0);
          if (BOTH(19)) GRID_BAR(); }
      PHASE(20) { pg8::EpiRw2 E{DEC, ASIG, Gf, AIN(24), AIN(27)};
          RUN_GEMM(pg8::EpiRw2, E, LM, ws + WS_W + W_RW_BT2, 256, NPAN, 16, 0 * NPAN, 0, 1, 0, NPAN, 16, 1 * NPAN, 16, 1, 0, NPAN, 8, 2 * NPAN, 32, 1, 0); if (BOTH(20)) GRID_BAR(); }
      PHASE(21) {
          int nslot_done = 0;
          for (int unit = F.bid; unit < 256; unit += F.G) {
              const int first = (unit == F.bid);
              auto bg = [&](int ck, int w4) { if (first) bg_convert_slot(A, ck * (F.G * 4) + F.bid * 4 + w4, (LAS float*)(F.lds + 98304 + w4 * 8448), F.lane); };
              rwkv_scan_unit(F, unit, DEC, ASIG, AIN(32), AIN(33), RKV, Y, bg);
              if (first) nslot_done = (TPB / 32) * F.G * 4; }
          __syncthreads();
          for (int slot = nslot_done + F.gw; slot < BG_NSLOTS; slot += F.NGW) bg_convert_slot(A, slot, (LAS float*)(F.lds + F.wave * 8448), F.lane);
          if (BOTH(21)) GRID_BAR(); }
      PHASE(22) { for (int r = F.gw; r < ROWS; r += F.NGW) rwkv_readout_row(Y, RKV, ASIG, AIN(33), Gf, AIN(34), AIN(35), AIN(36), NBF, r, F.lane); if (BOTH(22)) GRID_BAR(); }
      PHASE(23) { pg8::EpiResid E{X, mods_l, 5, A.pad ? 0.f : 1.0f, nullptr};
          RUN_GEMM(pg8::EpiResid, E, NBF, ws + WS_W + W_RW_WO, DM, 32, 8, 0, 0, 1, 1, 2, 8, 0, 0, 4, 2); if (BOTH(23)) GRID_BAR(); }
    }
    FFN_PHASES(24, 1, 2, 0, 4);
    FFN_PHASES(27, 2, 0, 0, 11);
    { const float* mods_l = MODS + (size_t)2 * 3 * NMOD * DM;
      float* RAW = (float*)(mix + ML_RAW); bf16_t* CN = (bf16_t*)(mix + ML_CN); float* QRAW = (float*)(mix + ML_QRAW);
      bf16_t* Qb = (bf16_t*)(mix + ML_Q); bf16_t* Kb = (bf16_t*)(mix + ML_K); bf16_t* Vb = (bf16_t*)(mix + ML_V);
      PHASE(30) { const float* g = AIN(6) + (size_t)(2 * 3 + 1) * DM;
          for (int r = F.gw; r < ROWS; r += F.NGW) { f32x4 y[8]; modnorm_row(X, g, mods_l, 1, r, F.lane, y, PART, 11); store_row_bf16(NBF + (size_t)r * DM, F.lane, y); }
          if (BOTH(30)) GRID_BAR(); }
      PHASE(31) { pg8::EpiF32 E{RAW, 1280, nullptr};
          RUN_GEMM(pg8::EpiF32, E, NBF, ws + WS_W + W_ML_WD, DM, NPAN, 5, 0, 0, 1, 0); if (BOTH(31)) GRID_BAR(); }
      PHASE(32) { for (int r = F.gw; r < ROWS; r += F.NGW) mla_row_a(RAW, AIN(39), AIN(41), CN, CN + (size_t)ROWS * 512, Kb, r, F.lane); if (BOTH(32)) GRID_BAR(); }
      PHASE(33) { pg8::EpiMla3 E{QRAW, Kb, Vb};
          RUN_GEMM(pg8::EpiMla3, E, CN, ws + WS_W + W_ML_BT3, 512, NPAN, 12, 0, 0, 1, 0, NPAN, 16, NPAN, 12, 1, 0); if (BOTH(33)) GRID_BAR(); }
      PHASE(34) { for (int r = F.gw; r < ROWS; r += F.NGW) mla_row_q(QRAW, Qb, r, F.lane); if (BOTH(34)) GRID_BAR(); }
      PHASE(35) { const int vc = (F.G % 8 == 0) ? (F.bid % 8) * (F.G / 8) + F.bid / 8 : F.bid;
          for (int i = 0;; ++i) { const int L = i * F.G + vc; if (L >= 544) break;
              int b, h, q0, seq; if (L < 512) { b = L >> 8; h = (L & 255) >> 4; q0 = b * TPB + CTXL + (L & 15) * 256; seq = TPB; } else { const int u = L - 512; b = u >> 4; h = u & 15; q0 = b * TPB; seq = CTXL; }
              __syncthreads();
              att::attn_dense_body<192, 3072, 3072, 2048, 2048>(Qb + (size_t)q0 * 3072 + h * 192, Kb + (size_t)b * TPB * 3072 + h * 192, Vb + (size_t)b * TPB * 2048 + h * 128, NBF + (size_t)q0 * DM + h * 128, seq, (char*)lds_raw); }
          if (BOTH(35)) GRID_BAR(); }
      PHASE(36) { pg8::EpiResid E{X, mods_l, 5, A.pad ? 0.f : 1.0f, nullptr};
          RUN_GEMM(pg8::EpiResid, E, NBF, ws + WS_W + W_ML_WO, DM, 32, 8, 0, 0, 1, 1, 2, 8, 0, 0, 4, 2); if (BOTH(36)) GRID_BAR(); }
    }
    FFN_PHASES(37, 2, 2, 0, 4);
    FFN_PHASES(40, 3, 0, 0, 11);
    { const float* mods_l = MODS + (size_t)3 * 3 * NMOD * DM;
      float* RAW = (float*)(mix + GQ_RAW); bf16_t* Qb = (bf16_t*)(mix + GQ_Q); bf16_t* Kb = (bf16_t*)(mix + GQ_K); bf16_t* Vb = (bf16_t*)(mix + GQ_V);
      PHASE(43) { const float* g = AIN(6) + (size_t)(3 * 3 + 1) * DM;
          for (int r = F.gw; r < ROWS; r += F.NGW) { f32x4 y[8]; modnorm_row(X, g, mods_l, 1, r, F.lane, y, PART, 11); store_row_bf16(NBF + (size_t)r * DM, F.lane, y); }
          if (BOTH(43)) GRID_BAR(); }
      PHASE(44) { pg8::EpiF32 E{RAW, 4096, nullptr};
          RUN_GEMM(pg8::EpiF32, E, NBF, ws + WS_W + W_GQ_QKV, DM, NPAN, 16, 0, 0, 1, 0); if (BOTH(44)) GRID_BAR(); }
      PHASE(45) { for (int r = F.gw; r < ROWS; r += F.NGW) gqa_row<false>(RAW, PART, AIN(45), AIN(46), Qb, Kb, Vb, r, F.lane); if (BOTH(45)) GRID_BAR(); }
      PHASE(46) { const int vc = (F.G % 8 == 0) ? (F.bid % 8) * (F.G / 8) + F.bid / 8 : F.bid;
          for (int i = 0;; ++i) { const int L = i * F.G + vc; if (L >= 512) break;
              const int b = L >> 8, h = (L & 255) >> 4, q0 = b * TPB + CTXL + (L & 15) * 256;
              __syncthreads();
              att::attn_dense_body2<128, 2048, 1024, 1024, 2048, 2>(Qb + (size_t)q0 * 2048 + h * 128, Kb + (size_t)b * TPB * 1024 + (h >> 1) * 128, Vb + (size_t)b * TPB * 1024 + (h >> 1) * 128, NBF + (size_t)q0 * DM + h * 128, TPB, (char*)lds_raw); }
          if (BOTH(46)) GRID_BAR(); }
      PHASE(47) { pg8::EpiResid E{X, mods_l, 5, A.pad ? 0.f : 1.0f, nullptr};
          RUN_GEMM(pg8::EpiResid, E, NBF, ws + WS_W + W_GQ_WO, DM, 32, 8, 0, 0, 1, 1); if (BOTH(47)) GRID_BAR(); }
    }
    FFN_PHASES(48, 3, 2, 1, 0);
#ifdef EXTRA_BARS
    if (IN(51) && hi - lo > 1) { for (int eb = 0; eb < EXTRA_BARS; ++eb) GRID_BAR(); }
#endif
    PHASE(51) {
        const f32x4* fg = (const f32x4*)AIN(48) + F.lane;
        for (int i = F.gw; i < NB * SEQ; i += F.NGW) {
            const int b = i / SEQ, t = i % SEQ; const f32x4* xr = (const f32x4*)(X + ((size_t)b * TPB + CTXL + t) * DM) + F.lane;
            f32x4 y[8]; float ss = 0.f;
#pragma unroll
            for (int j = 0; j < 8; ++j) { y[j] = xr[64 * j]; ss += (y[j].x * y[j].x + y[j].y * y[j].y) + (y[j].z * y[j].z + y[j].w * y[j].w); }
            const float rinv = rsqrtf(wave_sum(ss) * (1.0f / DM) + 1e-6f);
            f32x4* o = (f32x4*)(A.out + (size_t)i * DM) + F.lane;
#pragma unroll
            for (int j = 0; j < 8; ++j) o[64 * j] = y[j] * rinv * fg[64 * j];
        }
    }
#undef IN
#undef BOTH
#undef GRID_BAR
#undef AIN
#undef ws
#undef MODS
#undef TW
#undef HIDA
#undef ADAP
#undef X
#undef NBF
#undef ACT
#undef mix
#undef PART
}

#ifndef MK_PER_PHASE
#define MK_PER_PHASE 0
#endif
extern "C" void kernel_launch(void* const* d_in, const int* in_sizes, int n_in, void* d_out, int out_size, void* d_ws, size_t ws_size, hipStream_t stream) {
    static int grid = 0;
    if (grid == 0) {
        if (n_in != 49 || ws_size < WS_END) { fprintf(stderr, "kernel_launch: expected 49 inputs and >= %zu bytes of workspace; got %d, %zu\n", (size_t)WS_END, n_in, ws_size); grid = -1; return; }
        int dev = 0, cus = 0;
        if (hipGetDevice(&dev) != hipSuccess || hipDeviceGetAttribute(&cus, hipDeviceAttributeMultiprocessorCount, dev) != hipSuccess) { grid = -1; return; }
        if (hipFuncSetAttribute((const void*)fwd_kernel, hipFuncAttributeMaxDynamicSharedMemorySize, LDS_BYTES) != hipSuccess) { fprintf(stderr, "kernel_launch: hipFuncSetAttribute failed\n"); grid = -1; return; }
        int per_cu = 0;
        if (hipOccupancyMaxActiveBlocksPerMultiprocessor(&per_cu, (const void*)fwd_kernel, NTHR, LDS_BYTES) != hipSuccess || per_cu < 1) fprintf(stderr, "kernel_launch: occupancy query reports %d\n", per_cu);
        (void)hipGetLastError();
        grid = cus;
    }
    if (grid < 0) return;
    (void)hipMemsetAsync((char*)d_ws + WS_CTL, 0, CTL_ZERO_BYTES, stream);
    Args a{};
    for (int i = 0; i < 49; ++i) a.in[i] = (const float*)d_in[i];
    a.out = (float*)d_out; a.ws = (unsigned char*)d_ws;
#if MK_PER_PHASE
    for (int p = 0; p < N_PHASES; ++p) { a.ph_lo = p; a.ph_hi = p + 1; hipLaunchKernelGGL(fwd_kernel, dim3(grid), dim3(NTHR), LDS_BYTES, stream, a); }
#elif defined(PROBE_PHASES)
    { const int pp[] = {PROBE_PHASES}; const int np = (int)(sizeof(pp) / sizeof(int)); int cur = 0, li = 0;
      for (int i = 0; i < np; ++i) { if (pp[i] > cur) { a.ph_lo = cur; a.ph_hi = pp[i]; a.li = li++; a.pad = 0; hipLaunchKernelGGL(fwd_kernel, dim3(grid), dim3(NTHR), LDS_BYTES, stream, a); }
          a.ph_lo = pp[i]; a.ph_hi = pp[i] + 1; a.li = li++; a.pad = 1; hipLaunchKernelGGL(fwd_kernel, dim3(grid), dim3(NTHR), LDS_BYTES, stream, a); cur = pp[i]; }
      a.ph_lo = cur; a.ph_hi = N_PHASES; a.li = li++; a.pad = 0; hipLaunchKernelGGL(fwd_kernel, dim3(grid), dim3(NTHR), LDS_BYTES, stream, a); }
#else
    a.ph_lo = 0; a.ph_hi = N_PHASES; a.li = 0; hipLaunchKernelGGL(fwd_kernel, dim3(grid), dim3(NTHR), LDS_BYTES, stream, a);
#endif
}
```

```cpp
#include <hip/hip_runtime.h>
#include <stdint.h>
#include <stdio.h>

#define LAS __attribute__((address_space(3)))
typedef unsigned short bf16_t;
typedef short bf16x8 __attribute__((ext_vector_type(8)));
typedef short s16x4 __attribute__((ext_vector_type(4)));
typedef float f32x2 __attribute__((ext_vector_type(2)));
typedef float f32x4 __attribute__((ext_vector_type(4)));
typedef float f32x16 __attribute__((ext_vector_type(16)));
typedef unsigned u32x2 __attribute__((ext_vector_type(2)));
typedef unsigned u32x4 __attribute__((ext_vector_type(4)));

constexpr int DM = 2048, NB = 2, SEQ = 4096, CTXL = 256, TPB = SEQ + CTXL  , ROWS = NB * TPB  ;
constexpr int NPAN = ROWS / 256  , PPB = TPB / 256  ;
constexpr int FF = 5632, NMOD = 9, NADA = NMOD * DM  ;
constexpr int NWAVES = 8, NTHR = 512;

__device__ __forceinline__ unsigned cvt_pk_bf16(float lo, float hi) { unsigned r; asm volatile("v_cvt_pk_bf16_f32 %0, %1, %2" : "=v"(r) : "v"(lo), "v"(hi)); return r; }
__device__ __forceinline__ float bf2f(unsigned short b) { return __uint_as_float(((unsigned)b) << 16); }
__device__ __forceinline__ float wave_sum(float v) {
#pragma unroll
    for (int o = 1; o < 64; o <<= 1) v += __shfl_xor(v, o);
    return v;
}
__device__ __forceinline__ float fast_sigmoid(float x) { return __builtin_amdgcn_rcpf(1.0f + __expf(-x)); }
#define LDS_WAIT() asm volatile("s_waitcnt lgkmcnt(0)" ::: "memory")
#define VM_WAIT() asm volatile("s_waitcnt vmcnt(0)" ::: "memory")

#define XB_TMO      128
#define XB_XCNT(j)  (256  + 64 * (j))
#define XB_XSUB(j)  (1280 + 64 * (j))
#define XB_XGEN(j)  (2304 + 64 * (j))
#define XB_TOP      3328
#define XB_TOPGEN   3392
#define XCD_BAR_WORDS 3456
#define XB_SPIN_CAP (1u << 18)
__device__ __forceinline__ unsigned xb_ld(unsigned* p)              { return __hip_atomic_load(p, __ATOMIC_RELAXED, __HIP_MEMORY_SCOPE_AGENT); }
__device__ __forceinline__ unsigned xb_add(unsigned* p, unsigned v) { return __hip_atomic_fetch_add(p, v, __ATOMIC_RELAXED, __HIP_MEMORY_SCOPE_AGENT); }
__device__ __forceinline__ unsigned xb_xcc_id() { return (unsigned)__builtin_amdgcn_s_getreg((3 << 11) | 20) & 0xFu; }
#define XB_SPIN(cond, bar) do { unsigned _sp = 0; while (cond) { __builtin_amdgcn_s_sleep(1); \
    if ((++_sp & 255u) == 0u) { if (xb_ld(&(bar)[XB_TMO])) break; if (_sp > XB_SPIN_CAP) { atomicAdd(&(bar)[XB_TMO], 1u); break; } } } } while (0)
struct XcdBarrier { unsigned* bar; unsigned x; volatile LAS unsigned* st; };
__device__ __forceinline__ XcdBarrier xcd_barrier_post(unsigned* bar, volatile LAS unsigned* st) {
    XcdBarrier b; b.bar = bar; b.x = xb_xcc_id(); b.st = st;
    if (threadIdx.x == 0) (void)xb_add(&bar[XB_XCNT(b.x)], 1u);
    return b;
}
__device__ __forceinline__ void xcd_barrier_complete(unsigned* bar, unsigned x, unsigned& nloc, unsigned& nx) {
    const unsigned G = gridDim.x * gridDim.y * gridDim.z;
    unsigned sum, cnt, mine, sp = 0u;
    for (;;) {
        sum = 0u; cnt = 0u; mine = 0u;
#pragma unroll
        for (unsigned j = 0; j < 16; ++j) { const unsigned c = xb_ld(&bar[XB_XCNT(j)]); sum += c; cnt += (c > 0u) ? 1u : 0u; mine = (j == x) ? c : mine; }
        if (sum == G) break;
        __builtin_amdgcn_s_sleep(1);
        if ((++sp & 255u) == 0u) { if (xb_ld(&bar[XB_TMO])) break; if (sp > XB_SPIN_CAP) { atomicAdd(&bar[XB_TMO], 1u); break; } }
    }
    nloc = mine > 0u ? mine : 1u; nx = cnt > 0u ? cnt : 1u;
}
__device__ __forceinline__ void xcd_barrier(const XcdBarrier& b) {
    asm volatile("s_waitcnt vmcnt(0)" ::: "memory");
    __syncthreads();
    if (threadIdx.x == 0) {
        unsigned* bar = b.bar;
        __builtin_amdgcn_s_waitcnt(0);
        unsigned nloc = b.st[0], nx = b.st[1];
        if (nloc == 0u) { xcd_barrier_complete(bar, b.x, nloc, nx); b.st[0] = nloc; b.st[1] = nx; }
        const unsigned old = xb_add(&bar[XB_XSUB(b.x)], 1u);
        const unsigned gen = old / nloc;
        if (old + 1u == (gen + 1u) * nloc) {
            __builtin_amdgcn_fence(__ATOMIC_RELEASE, "agent");
            asm volatile("s_waitcnt vmcnt(0)" ::: "memory");
            const unsigned og = xb_add(&bar[XB_TOP], 1u);
            const unsigned tg = og / nx;
            if (og + 1u == (tg + 1u) * nx) xb_add(&bar[XB_TOPGEN], 1u);
            else XB_SPIN(xb_ld(&bar[XB_TOPGEN]) == tg, bar);
            __builtin_amdgcn_fence(__ATOMIC_ACQUIRE, "agent");
            xb_add(&bar[XB_XGEN(b.x)], 1u);
            asm volatile("s_waitcnt vmcnt(0)" ::: "memory");
        } else {
            XB_SPIN(xb_ld(&bar[XB_XGEN(b.x)]) == gen, bar);
            __builtin_amdgcn_fence(__ATOMIC_ACQUIRE, "agent");
            asm volatile("s_waitcnt vmcnt(0)" ::: "memory");
        }
    }
    __syncthreads();
}

namespace pg8 {
constexpr int BM = 256, BK = 64, HALF = 128, HTB = HALF * BK * 2, STAGE_BYTES = 8 * HTB, NXCD = 8, WGM = 8;
__host__ __device__ __forceinline__ int lds_byte(int r, int c) { const int st = (r >> 4) * 2 + (c >> 5), rr = r & 15, cc = c & 31, ob = rr * 64 + cc * 2; return st * 1024 + (ob ^ (((ob >> 9) & 1) << 5)); }
__host__ __device__ __forceinline__ void stage_rc(int b, int& R, int& C) { const int st = b / 1024, sb = b % 1024, swz = sb ^ (((sb >> 9) & 1) << 5); R = (st >> 1) * 16 + swz / 64; C = (st & 1) * 32 + (swz % 64) / 2; }
__host__ __device__ __forceinline__ int perm32(int rho) { const int n = rho >> 4, i = rho & 15; return 8 * (i >> 2) + 4 * n + (i & 3); }

struct Unit { int pm, pn, g, lm, ln, ks, ksub; };
struct Gemm { const bf16_t* A; const bf16_t* Bt; int K; };

template <int... V>
struct TSched {
    static constexpr int NG = sizeof...(V) / 6;
    int G, c;
    __device__ __forceinline__ void init(int G_, int c_) { G = G_; c = c_; }
    __device__ __forceinline__ bool next(int i, Unit& u) const {
        constexpr int v[sizeof...(V)] = {V...};
        const int L = i * G + c;
        int g = 0, b = 0, nM = 1, nN = 1, pm0 = 0, pn0 = 0, ks = 1, rm = 0, base = 0;
#pragma unroll
        for (int k = 0; k < NG; ++k) { if (L >= base) { g = k; b = base; nM = v[6 * k]; nN = v[6 * k + 1]; pm0 = v[6 * k + 2]; pn0 = v[6 * k + 3]; ks = v[6 * k + 4]; rm = v[6 * k + 5]; } base += v[6 * k] * v[6 * k + 1] * v[6 * k + 4]; }
        if (L >= base) return false;
        const int nwg = nM * nN; const int lloc = L - b; int wgid = lloc / ks; const int ksub = lloc - wgid * ks;
        { const int q = nwg / NXCD, r = nwg % NXCD, xcd = wgid % NXCD, off = wgid / NXCD; wgid = (xcd < r ? xcd * (q + 1) : r * (q + 1) + (xcd - r) * q) + off; }
        const int nig = WGM * nN, gid = wgid / nig, fm = gid * WGM, gsz = (nM - fm) < WGM ? (nM - fm) : WGM;
        int lm = fm + ((wgid % nig) % gsz); const int ln = (wgid % nig) / gsz;
        if (rm == 1) lm = lm + 1 + (lm >= 16 ? 1 : 0);
        if (rm == 2) lm = lm * PPB;
        u.g = g; u.lm = lm; u.ln = ln; u.pm = pm0 + lm; u.pn = pn0 + ln; u.ks = ks; u.ksub = ksub; return true;
    }
};

template <class Epi, class Sched>
__device__ __forceinline__ void gemm_phase(LAS unsigned char* lds, const Gemm g, const Sched& S, const Epi& E) {
    const int tid = threadIdx.x, wid = __builtin_amdgcn_readfirstlane(tid >> 6), lane = tid & 63, wr = wid >> 2, wc = wid & 3, fr = lane & 15, fq = lane >> 4;
    const int K = g.K, ntf = K / BK;
    unsigned voffA[2], voffB[2];
#pragma unroll
    for (int i = 0; i < 2; ++i) { int R, C; stage_rc(tid * 16 + i * 8192, R, C); const int Rb = (R & ~31) + perm32(R & 31);
        voffA[i] = (unsigned)(R * K + C) * 2u; voffB[i] = (unsigned)(Rb * K + C) * 2u; }
    const size_t kstep = (size_t)(BK * 2);
    const size_t hstep = (size_t)HALF * K * 2;
    const size_t tstep = 2 * hstep;
    const unsigned ldsw = (unsigned)wid * 1024u;
    const int aoff = lds_byte(wr * 64 + fr, fq * 8), boff = lds_byte(wc * 32 + fr, fq * 8);
#define PG8_SA(b, h) (((b) * 2 + (h)) * HTB)
#define PG8_SB(b, h) ((4 + (b) * 2 + (h)) * HTB)
#define PG8_STAGE(bufoff, gbase, voff) do { _Pragma("unroll") for (int _i = 0; _i < 2; ++_i) \
        __builtin_amdgcn_global_load_lds((const unsigned*)((const char*)(gbase) + (voff)[_i]), (LAS unsigned*)(lds + (bufoff) + ldsw + _i * 8192), 16, 0, 0); } while (0)
#define PG8_LDA(dst, b, h) do { _Pragma("unroll") for (int m = 0; m < 4; ++m) _Pragma("unroll") for (int k = 0; k < 2; ++k) dst[m][k] = *(const LAS bf16x8*)(lds + PG8_SA(b, h) + aoff + m * 2048 + k * 1024); } while (0)
#define PG8_LDB(dst, b, h) do { _Pragma("unroll") for (int n = 0; n < 2; ++n) _Pragma("unroll") for (int k = 0; k < 2; ++k) dst[n][k] = *(const LAS bf16x8*)(lds + PG8_SB(b, h) + boff + n * 2048 + k * 1024); } while (0)
#define PG8_MMA(ai, bj, At, Bt) do { __builtin_amdgcn_s_setprio(1); _Pragma("unroll") for (int m = 0; m < 4; ++m) _Pragma("unroll") for (int n = 0; n < 2; ++n) _Pragma("unroll") for (int k = 0; k < 2; ++k) \
        acc[ai][bj][m][n] = __builtin_amdgcn_mfma_f32_16x16x32_bf16(Bt[n][k], At[m][k], acc[ai][bj][m][n], 0, 0, 0); __builtin_amdgcn_s_setprio(0); } while (0)
#define PG8_WAIT_V(n) asm volatile("s_waitcnt vmcnt(" #n ")" ::: "memory")
#define PG8_WAIT_L(n) asm volatile("s_waitcnt lgkmcnt(" #n ")" ::: "memory")
#define PG8_BAR __builtin_amdgcn_s_barrier()
#define PG8_SCHED __builtin_amdgcn_sched_barrier(0)
    Unit cur, nxt; int ui = 0;
    if (!S.next(0, cur)) return;
    f32x4 acc[2][2][4][2];
#pragma unroll
    for (int a = 0; a < 2; ++a)
#pragma unroll
        for (int b = 0; b < 2; ++b)
#pragma unroll
            for (int m = 0; m < 4; ++m)
#pragma unroll
                for (int n = 0; n < 2; ++n) acc[a][b][m][n] = (f32x4){0.f, 0.f, 0.f, 0.f};
    bf16x8 At[4][2], B0[2][2], B1[2][2];
    int nt = ntf / cur.ks;
    const char* cA = (const char*)g.A + (size_t)cur.pm * tstep + (size_t)(cur.ksub * nt) * kstep; const char* cB = (const char*)g.Bt + (size_t)cur.pn * tstep + (size_t)(cur.ksub * nt) * kstep;
    PG8_STAGE(PG8_SB(0, 0), cB, voffB); PG8_STAGE(PG8_SA(0, 0), cA, voffA); PG8_STAGE(PG8_SB(0, 1), cB + hstep, voffB); PG8_STAGE(PG8_SA(0, 1), cA + hstep, voffA);
    if (wr == 1) PG8_BAR;
    PG8_WAIT_V(4); PG8_BAR;
    PG8_STAGE(PG8_SB(1, 0), cB + kstep, voffB); PG8_STAGE(PG8_SA(1, 0), cA + kstep, voffA); PG8_STAGE(PG8_SB(1, 1), cB + hstep + kstep, voffB);
    PG8_WAIT_V(6); PG8_BAR;
    for (;;) {
        const bool has_next = S.next(ui + 1, nxt);
        const int nnt = has_next ? ntf / nxt.ks : nt; const size_t nko = has_next ? (size_t)(nxt.ksub * nnt) * kstep : 0;
        const char* nA = has_next ? (const char*)g.A + (size_t)nxt.pm * tstep + nko : cA; const char* nB = has_next ? (const char*)g.Bt + (size_t)nxt.pn * tstep + nko : cB;
        for (int t = 0; t < nt; t += 2) {
            const bool last = (t == nt - 2);
            const char* a1 = cA + (size_t)(t + 1) * kstep;
            const char* a2 = last ? nA : cA + (size_t)(t + 2) * kstep; const char* b2 = last ? nB : cB + (size_t)(t + 2) * kstep;
            const char* a3 = a2 + kstep; const char* b3 = b2 + kstep;
            PG8_LDB(B0, 0, 0); PG8_SCHED; PG8_LDA(At, 0, 0); PG8_STAGE(PG8_SA(1, 1), a1 + hstep, voffA);
            PG8_WAIT_L(8); PG8_BAR; PG8_WAIT_L(0); PG8_MMA(0, 0, At, B0); PG8_BAR; PG8_SCHED;
            PG8_LDB(B1, 0, 1); PG8_STAGE(PG8_SB(0, 0), b2, voffB);
            PG8_BAR; PG8_WAIT_L(0); PG8_MMA(0, 1, At, B1); PG8_BAR;
            PG8_LDA(At, 0, 1); PG8_STAGE(PG8_SA(0, 0), a2, voffA);
            PG8_BAR; PG8_WAIT_L(0); PG8_MMA(1, 0, At, B0); PG8_BAR; PG8_SCHED;
            PG8_STAGE(PG8_SB(0, 1), b2 + hstep, voffB);
            PG8_WAIT_V(6); PG8_BAR; PG8_MMA(1, 1, At, B1); PG8_BAR;
            PG8_LDB(B0, 1, 0); PG8_SCHED; PG8_LDA(At, 1, 0); PG8_STAGE(PG8_SA(0, 1), a2 + hstep, voffA);
            PG8_WAIT_L(8); PG8_BAR; PG8_WAIT_L(0); PG8_MMA(0, 0, At, B0); PG8_BAR; PG8_SCHED;
            PG8_LDB(B1, 1, 1); PG8_STAGE(PG8_SB(1, 0), b3, voffB);
            PG8_BAR; PG8_WAIT_L(0); PG8_MMA(0, 1, At, B1); PG8_BAR;
            PG8_LDA(At, 1, 1); PG8_STAGE(PG8_SA(1, 0), a3, voffA);
            PG8_BAR; PG8_WAIT_L(0); PG8_MMA(1, 0, At, B0); PG8_BAR; PG8_SCHED;
            PG8_STAGE(PG8_SB(1, 1), b3 + hstep, voffB);
            PG8_WAIT_V(6); PG8_BAR; PG8_MMA(1, 1, At, B1); PG8_BAR;
        }
        E(acc, cur, wr, wc, fr, fq);
        if (!has_next) break;
#pragma unroll
        for (int a = 0; a < 2; ++a)
#pragma unroll
            for (int b = 0; b < 2; ++b)
#pragma unroll
                for (int m = 0; m < 4; ++m)
#pragma unroll
                    for (int n = 0; n < 2; ++n) acc[a][b][m][n] = (f32x4){0.f, 0.f, 0.f, 0.f};
        cur = nxt; cA = nA; cB = nB; nt = nnt; ++ui;
    }
    PG8_WAIT_V(0);
    if (wr == 0) PG8_BAR;
    PG8_BAR;
#undef PG8_SA
#undef PG8_SB
#undef PG8_STAGE
#undef PG8_LDA
#undef PG8_LDB
#undef PG8_MMA
#undef PG8_WAIT_V
#undef PG8_WAIT_L
#undef PG8_BAR
#undef PG8_SCHED
}
}
constexpr size_t MiB = 1u << 20;
constexpr size_t WS_CTL = 0, CTL_ZERO_BYTES = 1 * MiB;
constexpr int CW_BAR = 4096;
constexpr size_t WS_MODS = 1 * MiB;
constexpr size_t WS_TW = 2 * MiB;
constexpr size_t WS_HIDA = 3 * MiB;
constexpr size_t WS_ADAP = 6 * MiB;
constexpr size_t WS_X = 22 * MiB;
constexpr size_t WS_NB = 90 * MiB;
constexpr size_t WS_ACT = 124 * MiB;
constexpr size_t WS_W = 218 * MiB;
constexpr size_t WS_MIX = WS_W + 648 * MiB;
constexpr size_t WS_PART = WS_MIX + 900 * MiB;
constexpr size_t WS_END = WS_PART + 52 * MiB;
__host__ __device__ constexpr size_t W_GU(int l, int h) { return (size_t)(l * 132 + h * 44) * MiB; }
__host__ __device__ constexpr size_t W_DN(int l, int h) { return (size_t)(l * 132 + 88 + h * 22) * MiB; }
constexpr size_t W_HY_IN = 528 * MiB, W_HY_OUT = 552 * MiB, W_HY_F3 = 560 * MiB, W_RW_BT1 = 564 * MiB, W_RW_BT2 = 591 * MiB, W_RW_WO = 596 * MiB,
                 W_ML_WD = 604 * MiB, W_ML_BT3 = 609 * MiB, W_ML_WO = 616 * MiB, W_GQ_QKV = 624 * MiB, W_GQ_WO = 640 * MiB;
constexpr size_t HY_U = 0, HY_VXT = 204 * MiB, HY_HFT = 408 * MiB  ;
constexpr size_t RW_XS = 0, RW_Y = 0  , RW_KK = 136 * MiB, RW_HLF = 204 * MiB, RW_RKV = 272 * MiB, RW_LM = 476 * MiB, RW_DEC = 492 * MiB,
                 RW_ASIG = 628 * MiB, RW_G = 764 * MiB;
constexpr size_t ML_RAW = 0, ML_CN = 43 * MiB, ML_QRAW = 60 * MiB, ML_Q = 162 * MiB, ML_K = 213 * MiB, ML_V = 264 * MiB;
constexpr size_t GQ_RAW = 0, GQ_Q = 136 * MiB, GQ_K = 170 * MiB, GQ_V = 187 * MiB;
constexpr int LDS_BYTES = 147456, MISC_OFF = 131072 + 8192;

namespace pg8 {
#define EPI_ARGS const f32x4 (&acc)[2][2][4][2], const Unit& u, int wr, int wc, int fr, int fq
struct EpiSwiglu {
    bf16_t* act;
    __device__ __forceinline__ void operator()(EPI_ARGS) const {
        const int row0 = u.lm * BM + wr * 64 + fr, col0 = u.ln * 128 + wc * 32 + 8 * fq;
#pragma unroll
        for (int ai = 0; ai < 2; ++ai)
#pragma unroll
            for (int m = 0; m < 4; ++m) {
                float v[8];
#pragma unroll
                for (int n = 0; n < 2; ++n)
#pragma unroll
                    for (int j = 0; j < 4; ++j) { const float a = acc[ai][0][m][n][j], b = acc[ai][1][m][n][j]; v[n * 4 + j] = a * fast_sigmoid(a) * b; }
                u32x4 w; w.x = cvt_pk_bf16(v[0], v[1]); w.y = cvt_pk_bf16(v[2], v[3]); w.z = cvt_pk_bf16(v[4], v[5]); w.w = cvt_pk_bf16(v[6], v[7]);
                *(u32x4*)(act + (size_t)(row0 + ai * HALF + m * 16) * FF + col0) = w;
            }
    }
};
struct EpiResid {
    float* X; const float* mods_l; int gidx; float sc; const float* bias; static constexpr size_t PART_OFF = (WS_PART - WS_X) / 4;
    __device__ __forceinline__ void operator()(EPI_ARGS) const {
        const int row0 = u.lm * BM + wr * 64 + fr;
        const int rt = (u.lm % PPB == 0) ? 2 : u.lm / PPB;
        const float* gate = mods_l + (size_t)(rt * NMOD + gidx) * DM;
#pragma unroll
        for (int bj = 0; bj < 2; ++bj) {
            const int col = u.ln * BM + bj * HALF + wc * 32 + 8 * fq;
            f32x4 g0 = *(const f32x4*)(gate + col) * sc, g1 = *(const f32x4*)(gate + col + 4) * sc;
            f32x4 b0 = (f32x4){0.f, 0.f, 0.f, 0.f}, b1 = b0;
            if (bias && u.ksub == 0) { b0 = *(const f32x4*)(bias + col); b1 = *(const f32x4*)(bias + col + 4); }
#pragma unroll
            for (int ai = 0; ai < 2; ++ai) {
#pragma unroll
                for (int m = 0; m < 4; ++m) {
                    float* p = X + (size_t)(row0 + ai * HALF + m * 16) * DM + col;
                    if (u.ks == 1) {
                        f32x4 x0 = *(f32x4*)p, x1 = *(f32x4*)(p + 4);
                        x0 += g0 * (acc[ai][bj][m][0] + b0); x1 += g1 * (acc[ai][bj][m][1] + b1);
                        *(f32x4*)p = x0; *(f32x4*)(p + 4) = x1;
                    } else {
                        const int cr = (u.lm / PPB) * CTXL + wr * 64 + fr + ai * HALF + m * 16;
                        float* q = X + PART_OFF + ((size_t)u.ksub * (NB * CTXL) + cr) * DM + col;
                        *(f32x4*)q = g0 * (acc[ai][bj][m][0] + b0); *(f32x4*)(q + 4) = g1 * (acc[ai][bj][m][1] + b1);
                    }
                }
                asm volatile("" ::: "memory");
            }
        }
    }
};
struct EpiF32 {
    float* C; int ldc; const float* bias;
    __device__ __forceinline__ void operator()(EPI_ARGS) const {
        const int row0 = u.lm * BM + wr * 64 + fr;
#pragma unroll
        for (int bj = 0; bj < 2; ++bj) {
            const int col = u.ln * BM + bj * HALF + wc * 32 + 8 * fq;
            f32x4 b0 = (f32x4){0.f, 0.f, 0.f, 0.f}, b1 = b0;
            if (bias) { b0 = *(const f32x4*)(bias + col); b1 = *(const f32x4*)(bias + col + 4); }
#pragma unroll
            for (int ai = 0; ai < 2; ++ai)
#pragma unroll
                for (int m = 0; m < 4; ++m) {
                    float* p = C + (size_t)(row0 + ai * HALF + m * 16) * ldc + col;
                    *(f32x4*)p = acc[ai][bj][m][0] + b0; *(f32x4*)(p + 4) = acc[ai][bj][m][1] + b1;
                }
        }
    }
};
template <long SL_OFF, int SL_LD, int SL_COL0>
struct EpiF32S {
    float* C; int ldc; const float* bias;
    __device__ __forceinline__ void operator()(EPI_ARGS) const {
        const int row0 = u.lm * BM + wr * 64 + fr;
#pragma unroll
        for (int bj = 0; bj < 2; ++bj) {
            const int col = u.ln * BM + bj * HALF + wc * 32 + 8 * fq;
            f32x4 b0 = (f32x4){0.f, 0.f, 0.f, 0.f}, b1 = b0;
            if (bias && u.ksub == 0) { b0 = *(const f32x4*)(bias + col); b1 = *(const f32x4*)(bias + col + 4); }
#pragma unroll
            for (int ai = 0; ai < 2; ++ai)
#pragma unroll
                for (int m = 0; m < 4; ++m) {
                    float* p;
                    if (u.ks == 1) p = C + (size_t)(row0 + ai * HALF + m * 16) * ldc + col;
                    else { const int cr = (u.lm / PPB) * CTXL + wr * 64 + fr + ai * HALF + m * 16; p = C + SL_OFF + ((size_t)u.ksub * (NB * CTXL) + cr) * SL_LD + (col - SL_COL0); }
                    *(f32x4*)p = acc[ai][bj][m][0] + b0; *(f32x4*)(p + 4) = acc[ai][bj][m][1] + b1;
                }
        }
    }
};
struct EpiBf16B {
    bf16_t* C; int ldc; const float* bias;
    __device__ __forceinline__ void operator()(EPI_ARGS) const {
        const int row0 = u.lm * BM + wr * 64 + fr;
#pragma unroll
        for (int bj = 0; bj < 2; ++bj) {
            const int col = u.ln * BM + bj * HALF + wc * 32 + 8 * fq;
            f32x4 b0 = (f32x4){0.f, 0.f, 0.f, 0.f}, b1 = b0;
            if (bias) { b0 = *(const f32x4*)(bias + col); b1 = *(const f32x4*)(bias + col + 4); }
#pragma unroll
            for (int ai = 0; ai < 2; ++ai)
#pragma unroll
                for (int m = 0; m < 4; ++m) {
                    const f32x4 v0 = acc[ai][bj][m][0] + b0, v1 = acc[ai][bj][m][1] + b1;
                    u32x4 w; w.x = cvt_pk_bf16(v0[0], v0[1]); w.y = cvt_pk_bf16(v0[2], v0[3]); w.z = cvt_pk_bf16(v1[0], v1[1]); w.w = cvt_pk_bf16(v1[2], v1[3]);
                    *(u32x4*)(C + (size_t)(row0 + ai * HALF + m * 16) * ldc + col) = w;
                }
        }
    }
};
struct EpiRw1 {
    float* rkv; bf16_t* lm;
    __device__ __forceinline__ void operator()(EPI_ARGS) const {
        const int row0 = u.lm * BM + wr * 64 + fr;
        if (u.g < 3) {
            float* C = rkv + (size_t)u.g * ROWS * DM;
#pragma unroll
            for (int bj = 0; bj < 2; ++bj) {
                const int col = u.ln * BM + bj * HALF + wc * 32 + 8 * fq;
#pragma unroll
                for (int ai = 0; ai < 2; ++ai)
#pragma unroll
                    for (int m = 0; m < 4; ++m) {
                        float* p = C + (size_t)(row0 + ai * HALF + m * 16) * DM + col;
                        *(f32x4*)p = acc[ai][bj][m][0]; *(f32x4*)(p + 4) = acc[ai][bj][m][1];
                    }
            }
        } else {
            bf16_t* O = lm + (size_t)(u.g - 3) * ROWS * 256;
            const int mode = u.g - 3;
#pragma unroll
            for (int bj = 0; bj < 2; ++bj) {
                const int col = bj * HALF + wc * 32 + 8 * fq;
#pragma unroll
                for (int ai = 0; ai < 2; ++ai)
#pragma unroll
                    for (int m = 0; m < 4; ++m) {
                        float v[8];
#pragma unroll
                        for (int n = 0; n < 2; ++n)
#pragma unroll
                            for (int j = 0; j < 4; ++j) { const float a = acc[ai][bj][m][n][j]; v[n * 4 + j] = (mode == 0) ? (1.0f - 2.0f * __builtin_amdgcn_rcpf(1.0f + __expf(2.0f * a))) : ((mode == 1) ? a : fast_sigmoid(a)); }
                        u32x4 w; w.x = cvt_pk_bf16(v[0], v[1]); w.y = cvt_pk_bf16(v[2], v[3]); w.z = cvt_pk_bf16(v[4], v[5]); w.w = cvt_pk_bf16(v[6], v[7]);
                        *(u32x4*)(O + (size_t)(row0 + ai * HALF + m * 16) * 256 + col) = w;
                    }
            }
        }
    }
};
struct EpiRw2 {
    float* dec; float* asig; float* gg; const float* w0; const float* a0;
    __device__ __forceinline__ void operator()(EPI_ARGS) const {
        const int row0 = u.lm * BM + wr * 64 + fr;
        float* C = (u.g == 0) ? dec : ((u.g == 1) ? asig : gg);
        const int ldc = (u.g == 2) ? DM : 2 * DM;
        const float* addv = (u.g == 0) ? w0 : a0;
#pragma unroll
        for (int bj = 0; bj < 2; ++bj) {
            const int col = u.ln * BM + bj * HALF + wc * 32 + 8 * fq;
            f32x4 b0 = (f32x4){0.f, 0.f, 0.f, 0.f}, b1 = b0;
            if (u.g < 2) { b0 = *(const f32x4*)(addv + col); b1 = *(const f32x4*)(addv + col + 4); }
#pragma unroll
            for (int ai = 0; ai < 2; ++ai)
#pragma unroll
                for (int m = 0; m < 4; ++m) {
                    f32x4 v0 = acc[ai][bj][m][0] + b0, v1 = acc[ai][bj][m][1] + b1;
                    if (u.g < 2) {
#pragma unroll
                        for (int j = 0; j < 4; ++j) {
                            float s0 = fast_sigmoid(v0[j]), s1 = fast_sigmoid(v1[j]);
                            if (u.g == 0) { s0 = __expf(-s0 * 0.60653065971263342f); s1 = __expf(-s1 * 0.60653065971263342f); }
                            v0[j] = s0; v1[j] = s1;
                        }
                    }
                    float* p = C + (size_t)(row0 + ai * HALF + m * 16) * ldc + col;
                    *(f32x4*)p = v0; *(f32x4*)(p + 4) = v1;
                    asm volatile("" ::: "memory");
                }
        }
    }
};
struct EpiMla3 {
    float* qraw; bf16_t* Kb; bf16_t* Vb;
    __device__ __forceinline__ void operator()(EPI_ARGS) const {
        const int row0 = u.lm * BM + wr * 64 + fr;
        if (u.g == 0) {
#pragma unroll
            for (int bj = 0; bj < 2; ++bj) {
                const int col = u.ln * BM + bj * HALF + wc * 32 + 8 * fq;
#pragma unroll
                for (int ai = 0; ai < 2; ++ai)
#pragma unroll
                    for (int m = 0; m < 4; ++m) {
                        float* p = qraw + (size_t)(row0 + ai * HALF + m * 16) * 3072 + col;
                        *(f32x4*)p = acc[ai][bj][m][0]; *(f32x4*)(p + 4) = acc[ai][bj][m][1];
                    }
            }
        } else {
#pragma unroll
            for (int bj = 0; bj < 2; ++bj) {
                bf16_t* O = bj ? Vb : Kb; const int ld = bj ? 2048 : 3072; const int col = u.ln * (bj ? 128 : 192) + wc * 32 + 8 * fq;
#pragma unroll
                for (int ai = 0; ai < 2; ++ai)
#pragma unroll
                    for (int m = 0; m < 4; ++m) {
                        const f32x4 v0 = acc[ai][bj][m][0], v1 = acc[ai][bj][m][1];
                        u32x4 w; w.x = cvt_pk_bf16(v0[0], v0[1]); w.y = cvt_pk_bf16(v0[2], v0[3]); w.z = cvt_pk_bf16(v1[0], v1[1]); w.w = cvt_pk_bf16(v1[2], v1[3]);
                        *(u32x4*)(O + (size_t)(row0 + ai * HALF + m * 16) * ld + col) = w;
                    }
            }
        }
    }
};
#undef EPI_ARGS
}
namespace pg8 {
struct EpiHyF {
    float* hft_lat; float* hft_ctx;
    __device__ __forceinline__ void operator()(const f32x4 (&acc)[2][2][4][2], const Unit& u, int wr, int wc, int fr, int fq) const {
        const bool lat = u.lm < 16; const int L = lat ? 4096 : 256;
        float* base = (lat ? hft_lat : hft_ctx) + ((u.lm - (lat ? 0 : 16)) * BM + wr * 64 + fr);
#pragma unroll
        for (int bj = 0; bj < 2; ++bj)
#pragma unroll
            for (int n = 0; n < 2; ++n)
#pragma unroll
                for (int j = 0; j < 4; ++j) {
                    float* p = base + (size_t)(u.ln * BM + bj * HALF + wc * 32 + 8 * fq + 4 * n + j) * L;
#pragma unroll
                    for (int ai = 0; ai < 2; ++ai)
#pragma unroll
                        for (int m = 0; m < 4; ++m) p[ai * HALF + m * 16] = acc[ai][bj][m][n][j];
                    asm volatile("" ::: "memory");
                }
    }
};
}
namespace att {
constexpr int NW = 8, QBLK = 32, KVBLK = 64, DV = 128;
constexpr float THR = 8.f;
#define SBAR() __builtin_amdgcn_sched_barrier(0)
__device__ __forceinline__ int crow(int r, int hi) { return (r & 3) + 8 * (r >> 2) + 4 * hi; }
template <int SCALE_ID> struct ScaleOf;
template <> struct ScaleOf<128> { static constexpr float v = 0.088388347648318440f; };
template <> struct ScaleOf<192> { static constexpr float v = 0.072168783648703220f; };

template <int DQK>
__device__ __forceinline__ void partialSM(f32x16& p0, f32x16& p1, float& m_reg, float& mn, float& alpha) {
  constexpr float SCALE = ScaleOf<DQK>::v;
  constexpr float C = SCALE * 1.4426950408889634f;
  float pmax = p0[0];
#pragma unroll
  for (int r = 1; r < 16; ++r) pmax = fmaxf(pmax, p0[r]);
#pragma unroll
  for (int r = 0; r < 16; ++r) pmax = fmaxf(pmax, p1[r]);
  { auto rr = __builtin_amdgcn_permlane32_swap(__float_as_uint(pmax), __float_as_uint(pmax), false, false);
    pmax = fmaxf(__uint_as_float(rr[0]), __uint_as_float(rr[1])); }
  if (__builtin_expect(__all(pmax - m_reg <= THR / SCALE), 1)) { mn = m_reg; alpha = 1.f; }
  else { mn = fmaxf(m_reg, pmax); alpha = __builtin_amdgcn_exp2f((m_reg - mn) * C); m_reg = mn; }
  float mnC = -mn * C;
#pragma unroll
  for (int r = 0; r < 16; ++r) p0[r] = fmaf(p0[r], C, mnC);
#pragma unroll
  for (int r = 0; r < 16; ++r) p1[r] = fmaf(p1[r], C, mnC);
#pragma unroll
  for (int r = 0; r < 16; ++r) p0[r] = __builtin_amdgcn_exp2f(p0[r]);
}
__device__ __forceinline__ void finishSM(f32x16& p0, f32x16& p1, float alpha, float& l_reg, bf16x8& pa0, bf16x8& pa1, bf16x8& pa2, bf16x8& pa3) {
#pragma unroll
  for (int r = 0; r < 16; ++r) p1[r] = __builtin_amdgcn_exp2f(p1[r]);
  float ps = 0;
#pragma unroll
  for (int r = 0; r < 16; ++r) ps += p0[r];
#pragma unroll
  for (int r = 0; r < 16; ++r) ps += p1[r];
  { auto rr = __builtin_amdgcn_permlane32_swap(__float_as_uint(ps), __float_as_uint(ps), false, false);
    ps = __uint_as_float(rr[0]) + __uint_as_float(rr[1]); }
  l_reg = l_reg * alpha + ps;
#define PK4(P, BASE, OUT) do { unsigned a0 = cvt_pk_bf16(P[BASE + 0], P[BASE + 1]), a1 = cvt_pk_bf16(P[BASE + 2], P[BASE + 3]);   \
    unsigned b0 = cvt_pk_bf16(P[BASE + 4], P[BASE + 5]), b1 = cvt_pk_bf16(P[BASE + 6], P[BASE + 7]);                              \
    auto r0 = __builtin_amdgcn_permlane32_swap(a0, b0, false, false); auto r1 = __builtin_amdgcn_permlane32_swap(a1, b1, false, false); \
    u32x4 w = {r0[0], r1[0], r0[1], r1[1]}; OUT = *reinterpret_cast<bf16x8*>(&w); } while (0)
  PK4(p0, 0, pa0); PK4(p0, 8, pa1); PK4(p1, 0, pa2); PK4(p1, 8, pa3);
#undef PK4
}
template <int DQK>
__device__ __forceinline__ int kswz(int row, int colB) { return row * (DQK * 2) + (colB ^ ((row & 7) << 4)); }
template <int DQK>
__device__ __forceinline__ void qkt(f32x16& p0, f32x16& p1, const char* Ks, const bf16x8* qr, int r32, int hi) {
  p0 = f32x16{}; p1 = f32x16{};
#pragma unroll
  for (int d0 = 0; d0 < DQK / 16; ++d0) { int cb = (d0 * 16 + hi * 8) * 2;
    bf16x8 b0 = *reinterpret_cast<const bf16x8*>(Ks + kswz<DQK>(r32, cb));
    bf16x8 b1 = *reinterpret_cast<const bf16x8*>(Ks + kswz<DQK>(32 + r32, cb));
    p0 = __builtin_amdgcn_mfma_f32_32x32x16_bf16(b0, qr[d0], p0, 0, 0, 0);
    p1 = __builtin_amdgcn_mfma_f32_32x32x16_bf16(b1, qr[d0], p1, 0, 0, 0); }
}
template <int DQK, int NQL>
__device__ __forceinline__ void qkt_l(f32x16& p0, f32x16& p1, const char* Ks, const bf16x8* qr, const char* qls, int r32, int hi) {
  p0 = f32x16{}; p1 = f32x16{};
  constexpr int ND0 = DQK / 16;
#pragma unroll
  for (int d0 = 0; d0 < ND0; ++d0) { int cb = (d0 * 16 + hi * 8) * 2;
    bf16x8 b0 = *reinterpret_cast<const bf16x8*>(Ks + kswz<DQK>(r32, cb));
    bf16x8 b1 = *reinterpret_cast<const bf16x8*>(Ks + kswz<DQK>(32 + r32, cb));
    const bf16x8 q = (d0 < ND0 - NQL) ? qr[d0 < ND0 - NQL ? d0 : 0] : *reinterpret_cast<const bf16x8*>(qls + (d0 - (ND0 - NQL)) * 1024);
    p0 = __builtin_amdgcn_mfma_f32_32x32x16_bf16(b0, q, p0, 0, 0, 0);
    p1 = __builtin_amdgcn_mfma_f32_32x32x16_bf16(b1, q, p1, 0, 0, 0); }
}
__device__ __forceinline__ int v_st(int k, int c) { const int kk = (k & ~0xC) | ((k & 4) << 1) | ((k & 8) >> 1); return ((kk >> 3) * 4 + (c >> 5)) * 512 + ((kk & 7) * 32 + (c & 31)) * 2; }
__device__ __forceinline__ int v_rd_base(int lane) { return ((lane & 3) << 3) | (((lane >> 2) & 3) << 6) | (((lane >> 4) & 1) << 5) | (((lane >> 5) & 1) << 8); }
constexpr int v_rd_off(int d0, int ks, int half) { return d0 * 512 + ks * 4096 + half * 2048; }
template <int OFF> __device__ __forceinline__ s16x4 tr_read(int vb) {
  s16x4 r; asm volatile("ds_read_b64_tr_b16 %0, %1 offset:%2" : "=&v"(r) : "v"(vb), "i"(OFF) : "memory"); return r;
}
template <int D0> __device__ __forceinline__ void pv_one(f32x16& od, int vb, bf16x8 pa0, bf16x8 pa1, bf16x8 pa2, bf16x8 pa3) {
  const s16x4 l0 = tr_read<v_rd_off(D0, 0, 0)>(vb), h0 = tr_read<v_rd_off(D0, 0, 1)>(vb), l1 = tr_read<v_rd_off(D0, 1, 0)>(vb), h1 = tr_read<v_rd_off(D0, 1, 1)>(vb);
  const s16x4 l2 = tr_read<v_rd_off(D0, 2, 0)>(vb), h2 = tr_read<v_rd_off(D0, 2, 1)>(vb), l3 = tr_read<v_rd_off(D0, 3, 0)>(vb), h3 = tr_read<v_rd_off(D0, 3, 1)>(vb);
  asm volatile("s_waitcnt lgkmcnt(0)" ::: "memory"); SBAR();
#define PK(L, H) (bf16x8){L[0], L[1], L[2], L[3], H[0], H[1], H[2], H[3]}
  od = __builtin_amdgcn_mfma_f32_32x32x16_bf16(pa0, PK(l0, h0), od, 0, 0, 0);
  od = __builtin_amdgcn_mfma_f32_32x32x16_bf16(pa1, PK(l1, h1), od, 0, 0, 0);
  od = __builtin_amdgcn_mfma_f32_32x32x16_bf16(pa2, PK(l2, h2), od, 0, 0, 0);
  od = __builtin_amdgcn_mfma_f32_32x32x16_bf16(pa3, PK(l3, h3), od, 0, 0, 0);
#undef PK
}
__device__ __forceinline__ void pv_d0(f32x16* o, int vb, bf16x8 pa0, bf16x8 pa1, bf16x8 pa2, bf16x8 pa3) {
  pv_one<0>(o[0], vb, pa0, pa1, pa2, pa3); pv_one<1>(o[1], vb, pa0, pa1, pa2, pa3); pv_one<2>(o[2], vb, pa0, pa1, pa2, pa3); pv_one<3>(o[3], vb, pa0, pa1, pa2, pa3);
}

template <int DQK, int LDQ, int LDK, int LDV, int LDO>
__device__ __forceinline__ void attn_dense_body(const bf16_t* __restrict__ Qb, const bf16_t* __restrict__ Kh, const bf16_t* __restrict__ Vh,
                                                bf16_t* __restrict__ Ob, int seq, char* lds) {
  constexpr int SHM_V = KVBLK * DV * 2, SHM_K = KVBLK * DQK * 2, NCH = DQK / 8, KCH = NCH / 8  , ND0 = DQK / 16;
  const int tid = threadIdx.x, wid = tid >> 6, lane = tid & 63, r32 = lane & 31, hi = lane >> 5;
  char* V_lds = lds; char* K_lds = lds + 2 * SHM_V;
  float* ws = (float*)(lds + 2 * SHM_V + 2 * SHM_K) + wid * 64; float* li_l = ws; float* al_l = ws + 32;
  float m_reg = -1e30f, l_reg = 0; f32x16 o[4] = {}; bf16x8 qr[ND0];
  const bf16_t* Qw = Qb + (long)(wid * QBLK + r32) * LDQ + hi * 8;
#pragma unroll
  for (int d0 = 0; d0 < ND0; ++d0) qr[d0] = *reinterpret_cast<const bf16x8*>(Qw + d0 * 16);
  const int sr = tid >> 4, sc = (tid & 15) * 8, vst0 = v_st(sr, sc), vst1 = v_st(32 + sr, sc);
  const int vb0 = (int)(uintptr_t)V_lds + v_rd_base(lane);
  bf16x8 vs0, vs1, ks[KCH];
#define SLOAD(k0) do { vs0 = *reinterpret_cast<const bf16x8*>(&Vh[(long)((k0) + sr) * LDV + sc]); vs1 = *reinterpret_cast<const bf16x8*>(&Vh[(long)((k0) + 32 + sr) * LDV + sc]); \
    _Pragma("unroll") for (int c_ = 0; c_ < KCH; ++c_) { const int q_ = tid + 512 * c_; ks[c_] = *reinterpret_cast<const bf16x8*>(&Kh[(long)((k0) + q_ / NCH) * LDK + (q_ % NCH) * 8]); } } while (0)
#define SWRITE(b) do { *(bf16x8*)(V_lds + (b) * SHM_V + vst0) = vs0; *(bf16x8*)(V_lds + (b) * SHM_V + vst1) = vs1; \
    _Pragma("unroll") for (int c_ = 0; c_ < KCH; ++c_) { const int q_ = tid + 512 * c_; *(bf16x8*)(K_lds + (b) * SHM_K + kswz<DQK>(q_ / NCH, (q_ % NCH) * 16)) = ks[c_]; } } while (0)
  const int NT = seq / KVBLK;
  SLOAD(0); asm volatile("s_waitcnt vmcnt(0)" ::: "memory"); SWRITE(0);
  SLOAD(KVBLK);
#pragma unroll 1
  for (int j = 0; j < NT; ++j) {
    const int b = j & 1;
    __syncthreads();
    if (j + 1 < NT) { asm volatile("s_waitcnt vmcnt(0)" ::: "memory"); SWRITE(b ^ 1); if (j + 2 < NT) SLOAD((j + 2) * KVBLK); }
    f32x16 p0, p1; float mn, al; bf16x8 pa0, pa1, pa2, pa3;
    SBAR(); qkt<DQK>(p0, p1, K_lds + b * SHM_K, qr, r32, hi);
    partialSM<DQK>(p0, p1, m_reg, mn, al);
    if (__any(al < 1.f)) { if (hi == 0) al_l[r32] = al; asm volatile("s_waitcnt lgkmcnt(0)" ::: "memory");
#pragma unroll
      for (int d = 0; d < 4; ++d)
#pragma unroll
        for (int r = 0; r < 16; ++r) o[d][r] *= al_l[crow(r, hi)]; }
    finishSM(p0, p1, al, l_reg, pa0, pa1, pa2, pa3); SBAR();
    pv_d0(o, vb0 + b * (int)SHM_V, pa0, pa1, pa2, pa3);
  }
  if (hi == 0) li_l[r32] = l_reg; asm volatile("s_waitcnt lgkmcnt(0)" ::: "memory");
  float rli[16];
#pragma unroll
  for (int r = 0; r < 16; ++r) rli[r] = __builtin_amdgcn_rcpf(li_l[crow(r, hi)]);
  bf16_t* Ow = Ob + (long)(wid * QBLK) * LDO;
#pragma unroll
  for (int r = 0; r < 16; ++r) { int orow = crow(r, hi);
#pragma unroll
    for (int d0 = 0; d0 < 4; ++d0) Ow[(long)orow * LDO + d0 * 32 + r32] = (bf16_t)(cvt_pk_bf16(o[d0][r] * rli[r], 0.f) & 0xffffu); }
#undef SLOAD
#undef SWRITE
}

template <int DQK, int LDQ, int LDK, int LDV, int LDO, int NQL>
__device__ __forceinline__ void attn_dense_body2(const bf16_t* __restrict__ Qb, const bf16_t* __restrict__ Kh, const bf16_t* __restrict__ Vh,
                                                 bf16_t* __restrict__ Ob, int seq, char* lds) {
  constexpr int SHM_V = KVBLK * DV * 2, SHM_K = KVBLK * DQK * 2, NCH = DQK / 8, KCH = NCH / 8, ND0 = DQK / 16;
  int tid = threadIdx.x; asm volatile("" : "+v"(tid));
  const int wid = __builtin_amdgcn_readfirstlane(tid >> 6), lane = tid & 63, r32 = lane & 31, hi = lane >> 5;
  char* V_lds = lds; char* K_lds = lds + 2 * SHM_V;
  float* ws = (float*)(lds + 2 * SHM_V + 2 * SHM_K) + wid * 64; float* li_l = ws; float* al_l = ws + 32;
  float m_reg = -1e30f, l_reg = 0; f32x16 o[4] = {}; bf16x8 qr[ND0 - NQL];
  const bf16_t* Qw = Qb + (long)(wid * QBLK + r32) * LDQ + hi * 8;
  char* qls = lds + 2 * SHM_V + 2 * SHM_K + 2048 + wid * (NQL * 1024) + lane * 16;
#pragma unroll
  for (int d0 = 0; d0 < ND0; ++d0) { const bf16x8 q = *reinterpret_cast<const bf16x8*>(Qw + d0 * 16); if (d0 < ND0 - NQL) qr[d0 < ND0 - NQL ? d0 : 0] = q; else *reinterpret_cast<bf16x8*>(qls + (d0 - (ND0 - NQL)) * 1024) = q; }
  const int sr = tid >> 4, sc = (tid & 15) * 8, vst0 = v_st(sr, sc), vst1 = v_st(32 + sr, sc);
  const int vb0 = (int)(uintptr_t)V_lds + v_rd_base(lane);
  bf16x8 vs0, vs1, ks[KCH];
#define SLOAD(k0) do { vs0 = *reinterpret_cast<const bf16x8*>(&Vh[(long)((k0) + sr) * LDV + sc]); vs1 = *reinterpret_cast<const bf16x8*>(&Vh[(long)((k0) + 32 + sr) * LDV + sc]); \
    _Pragma("unroll") for (int c_ = 0; c_ < KCH; ++c_) { const int q_ = tid + 512 * c_; ks[c_] = *reinterpret_cast<const bf16x8*>(&Kh[(long)((k0) + q_ / NCH) * LDK + (q_ % NCH) * 8]); } } while (0)
#define SWRITE(b) do { *(bf16x8*)(V_lds + (b) * SHM_V + vst0) = vs0; *(bf16x8*)(V_lds + (b) * SHM_V + vst1) = vs1; \
    _Pragma("unroll") for (int c_ = 0; c_ < KCH; ++c_) { const int q_ = tid + 512 * c_; *(bf16x8*)(K_lds + (b) * SHM_K + kswz<DQK>(q_ / NCH, (q_ % NCH) * 16)) = ks[c_]; } } while (0)
#define SWAIT() asm volatile("s_waitcnt vmcnt(0)" ::: "memory")
#define RESC(a) do { if (__any((a) < 1.f)) { if (hi == 0) al_l[r32] = (a); asm volatile("s_waitcnt lgkmcnt(0)" ::: "memory"); \
    _Pragma("unroll") for (int d = 0; d < 4; ++d) _Pragma("unroll") for (int r = 0; r < 16; ++r) o[d][r] *= al_l[crow(r, hi)]; } } while (0)
  f32x16 pA0, pA1, pB0, pB1; float mnA, mnB, alA, alB; bf16x8 pa0, pa1, pa2, pa3; const int NT = seq / KVBLK;
  SLOAD(0); SWAIT(); SWRITE(0); __syncthreads();
  qkt_l<DQK, NQL>(pA0, pA1, K_lds, qr, qls, r32, hi); partialSM<DQK>(pA0, pA1, m_reg, mnA, alA);
  SLOAD(KVBLK); SWAIT(); SWRITE(1); __syncthreads();
  for (int j = 1; j + 1 < NT; j += 2) {
    SBAR(); qkt_l<DQK, NQL>(pB0, pB1, K_lds + SHM_K, qr, qls, r32, hi);
    finishSM(pA0, pA1, alA, l_reg, pa0, pa1, pa2, pa3); SBAR();
    SLOAD((j + 1) * KVBLK); SBAR();
    pv_d0(o, vb0, pa0, pa1, pa2, pa3); partialSM<DQK>(pB0, pB1, m_reg, mnB, alB);
    __syncthreads(); SWAIT(); SWRITE(0);
    RESC(alB); __syncthreads();
    SBAR(); qkt_l<DQK, NQL>(pA0, pA1, K_lds, qr, qls, r32, hi);
    finishSM(pB0, pB1, alB, l_reg, pa0, pa1, pa2, pa3); SBAR();
    SLOAD((j + 2) * KVBLK); SBAR();
    pv_d0(o, vb0 + (int)SHM_V, pa0, pa1, pa2, pa3); partialSM<DQK>(pA0, pA1, m_reg, mnA, alA);
    __syncthreads(); SWAIT(); SWRITE(1);
    RESC(alA); __syncthreads();
  }
  SBAR(); qkt_l<DQK, NQL>(pB0, pB1, K_lds + SHM_K, qr, qls, r32, hi);
  finishSM(pA0, pA1, alA, l_reg, pa0, pa1, pa2, pa3); SBAR();
  pv_d0(o, vb0, pa0, pa1, pa2, pa3); partialSM<DQK>(pB0, pB1, m_reg, mnB, alB);
  __syncthreads(); RESC(alB);
  finishSM(pB0, pB1, alB, l_reg, pa0, pa1, pa2, pa3); SBAR();
  pv_d0(o, vb0 + (int)SHM_V, pa0, pa1, pa2, pa3);
  if (hi == 0) li_l[r32] = l_reg; asm volatile("s_waitcnt lgkmcnt(0)" ::: "memory");
  float rli[16];
#pragma unroll
  for (int r = 0; r < 16; ++r) rli[r] = __builtin_amdgcn_rcpf(li_l[crow(r, hi)]);
  bf16_t* Ow = Ob + (long)(wid * QBLK) * LDO;
#pragma unroll
  for (int r = 0; r < 16; ++r) { int orow = crow(r, hi);
#pragma unroll
    for (int d0 = 0; d0 < 4; ++d0) Ow[(long)orow * LDO + d0 * 32 + r32] = (bf16_t)(cvt_pk_bf16(o[d0][r] * rli[r], 0.f) & 0xffffu); }
#undef SLOAD
#undef SWRITE
#undef SWAIT
#undef RESC
}
}
struct Ctx { LAS unsigned char* lds; int tid, lane, wave, bid, G, gw, NGW; };

template <class F>
__device__ __forceinline__ void conv_tile(F src4, bf16_t* dst, int Kd, int n0, int k0, LAS float* scr, int lane) {
    const int kr = lane >> 3, n4 = (lane & 7) * 4;
    f32x4 v[8];
#pragma unroll
    for (int i = 0; i < 8; ++i) v[i] = src4(n0 + n4, k0 + 8 * i + kr);
#pragma unroll
    for (int i = 0; i < 8; ++i) { LAS float* o = scr + (8 * i + kr) * 33 + n4; o[0] = v[i].x; o[1] = v[i].y; o[2] = v[i].z; o[3] = v[i].w; }
    LDS_WAIT(); asm volatile("" ::: "memory");
    const int c = lane & 7;
#pragma unroll
    for (int j = 0; j < 4; ++j) { const int n = (lane >> 3) + 8 * j; const LAS float* s = scr + (8 * c) * 33 + n;
        u32x4 o; o.x = cvt_pk_bf16(s[0 * 33], s[1 * 33]); o.y = cvt_pk_bf16(s[2 * 33], s[3 * 33]); o.z = cvt_pk_bf16(s[4 * 33], s[5 * 33]); o.w = cvt_pk_bf16(s[6 * 33], s[7 * 33]);
        *(u32x4*)(dst + (size_t)(n0 + n) * Kd + k0 + 8 * c) = o; }
    LDS_WAIT(); asm volatile("" ::: "memory");
}
#define CONV_JOB(ND, KD, DST, ...) do { const int nbk_ = (ND) / 32, nit_ = nbk_ * ((KD) / 64); bf16_t* dst_ = (bf16_t*)(DST); \
    for (int it_ = F.gw; it_ < nit_; it_ += F.NGW) conv_tile(__VA_ARGS__, dst_, (KD), (it_ % nbk_) * 32, (it_ / nbk_) * 64, scr, F.lane); } while (0)
__device__ __forceinline__ float bf_hi(float w) { return __uint_as_float(cvt_pk_bf16(w, 0.f) << 16); }

__device__ __forceinline__ int row_type(int r) { const int b = r / TPB, t = r - b * TPB; return t < CTXL ? 2 : b; }

__device__ __forceinline__ void modnorm_row(float* X, const float* g, const float* mods_l, int s, int r, int lane, f32x4 (&y)[8], const float* part, int nsplit) {
    const int rt = row_type(r);
    f32x4* xr = (f32x4*)(X + (size_t)r * DM) + lane;
    if (part != nullptr && rt == 2) {
        const int cr = (r / TPB) * CTXL + (r % TPB);
#pragma unroll
        for (int j = 0; j < 8; ++j) { f32x4 a = xr[64 * j];
            for (int k = 0; k < nsplit; ++k) a += ((const f32x4*)(part + ((size_t)k * (NB * CTXL) + cr) * DM))[lane + 64 * j];
            xr[64 * j] = a; }
    }
    const f32x4* gp = (const f32x4*)g + lane;
    const f32x4* sh = (const f32x4*)(mods_l + (size_t)(rt * NMOD + 3 * s) * DM) + lane;
    const f32x4* sc = (const f32x4*)(mods_l + (size_t)(rt * NMOD + 3 * s + 1) * DM) + lane;
    float ss = 0.f;
#pragma unroll
    for (int j = 0; j < 8; ++j) { y[j] = xr[64 * j]; ss += (y[j].x * y[j].x + y[j].y * y[j].y) + (y[j].z * y[j].z + y[j].w * y[j].w); }
    const float rinv = rsqrtf(wave_sum(ss) * (1.0f / DM) + 1e-6f);
#pragma unroll
    for (int j = 0; j < 8; ++j) y[j] = (y[j] * rinv) * gp[64 * j] * (1.0f + sc[64 * j]) + sh[64 * j];
}
__device__ __forceinline__ void store_row_bf16(bf16_t* dst, int lane, const f32x4 (&y)[8]) {
    u32x2* o = (u32x2*)dst + lane;
#pragma unroll
    for (int j = 0; j < 8; ++j) { u32x2 w; w.x = cvt_pk_bf16(y[j].x, y[j].y); w.y = cvt_pk_bf16(y[j].z, y[j].w); o[64 * j] = w; }
}
__device__ __forceinline__ float rope_invfreq(int j, int half) { return powf(10000.0f, -(float)j / (float)half); }
constexpr int FFT_TW = 2730;
__device__ __forceinline__ int fft_toff(int s) { return s == 0 ? 0 : (s == 1 ? 2048 : (s == 2 ? 2560 : (s == 3 ? 2688 : (s == 4 ? 2720 : 2728)))); }
__device__ __forceinline__ f32x2 cmul(f32x2 a, f32x2 b) { return (f32x2){a.x * b.x - a.y * b.y, a.x * b.y + a.y * b.x}; }
__device__ __forceinline__ f32x2 cmulc(f32x2 a, f32x2 b) { return (f32x2){a.x * b.x + a.y * b.y, a.y * b.x - a.x * b.y}; }
template <int LOGN>
__device__ __forceinline__ void fft4_fwd(LAS f32x2* x, const LAS f32x2* twl, int tid) {
    constexpr int N = 1 << LOGN, NS = (LOGN - 1) / 2, S0 = 6 - NS, NB = (N / 4 + NTHR - 1) / NTHR, BG = NB < 2 ? NB : 2;
#pragma unroll 1
    for (int s = 0; s < NS; ++s) {
        const int q = N >> (2 * s + 2); const LAS f32x2* tw = twl + fft_toff(S0 + s);
#pragma unroll
      for (int g0 = 0; g0 < NB; g0 += BG) {
        f32x2 a0[BG], a1[BG], a2[BG], a3[BG], w1[BG], w2[BG], w3[BG]; int base[BG];
#pragma unroll
        for (int it = 0; it < BG; ++it) { const int j = tid + NTHR * (g0 + it); const int pos = j & (q - 1); base[it] = ((j - pos) << 2) + pos;
            if (j < N / 4) { a0[it] = x[base[it]]; a1[it] = x[base[it] + q]; a2[it] = x[base[it] + 2 * q]; a3[it] = x[base[it] + 3 * q]; w1[it] = tw[pos]; w2[it] = tw[FFT_TW + pos]; w3[it] = tw[2 * FFT_TW + pos]; } }
#pragma unroll
        for (int it = 0; it < BG; ++it) { const int j = tid + NTHR * (g0 + it);
            if (j < N / 4) {
                const f32x2 t0 = a0[it] + a2[it], t1 = a0[it] - a2[it], t2 = a1[it] + a3[it], d = a1[it] - a3[it], t3 = (f32x2){d.y, -d.x};
                x[base[it]] = t0 + t2; x[base[it] + q] = cmul(t1 + t3, w1[it]); x[base[it] + 2 * q] = cmul(t0 - t2, w2[it]); x[base[it] + 3 * q] = cmul(t1 - t3, w3[it]); } }
      }
        __syncthreads();
    }
}
template <int LOGN>
__device__ __forceinline__ void fft4_inv(LAS f32x2* x, const LAS f32x2* twl, int tid) {
    constexpr int N = 1 << LOGN, NS = (LOGN - 1) / 2, S0 = 6 - NS, NB = (N / 4 + NTHR - 1) / NTHR, BG = NB < 2 ? NB : 2;
#pragma unroll 1
    for (int s = NS - 1; s >= 0; --s) {
        const int q = N >> (2 * s + 2); const LAS f32x2* tw = twl + fft_toff(S0 + s);
#pragma unroll
      for (int g0 = 0; g0 < NB; g0 += BG) {
        f32x2 z0[BG], z1[BG], z2[BG], z3[BG], w1[BG], w2[BG], w3[BG]; int base[BG];
#pragma unroll
        for (int it = 0; it < BG; ++it) { const int j = tid + NTHR * (g0 + it); const int pos = j & (q - 1); base[it] = ((j - pos) << 2) + pos;
            if (j < N / 4) { z0[it] = x[base[it]]; z1[it] = x[base[it] + q]; z2[it] = x[base[it] + 2 * q]; z3[it] = x[base[it] + 3 * q]; w1[it] = tw[pos]; w2[it] = tw[FFT_TW + pos]; w3[it] = tw[2 * FFT_TW + pos]; } }
#pragma unroll
        for (int it = 0; it < BG; ++it) { const int j = tid + NTHR * (g0 + it);
            if (j < N / 4) {
                const f32x2 y1 = cmulc(z1[it], w1[it]), y2 = cmulc(z2[it], w2[it]), y3 = cmulc(z3[it], w3[it]);
                const f32x2 t0 = z0[it] + y2, t1 = z0[it] - y2, t2 = y1 + y3, d = y1 - y3, t3 = (f32x2){-d.y, d.x};
                x[base[it]] = t0 + t2; x[base[it] + q] = t1 + t3; x[base[it] + 2 * q] = t0 - t2; x[base[it] + 3 * q] = t1 - t3; } }
      }
        __syncthreads();
    }
}
__device__ __forceinline__ float block_sum(float v, LAS float* red, int tid) {
    v = wave_sum(v);
    __syncthreads();
    if ((tid & 63) == 0) red[tid >> 6] = v;
    __syncthreads();
    float s = 0.f;
#pragma unroll
    for (int i = 0; i < 8; ++i) s += red[i];
    return s;
}
template <int LOGL>
__device__ __forceinline__ void hyena_channel(const Ctx& F, int c, const float* VXT, const float* HFT, const float* skip, bf16_t* Z) {
    constexpr int L = 1 << LOGL, N = 2 * L, LOGN = LOGL + 1, NPT = (L + NTHR - 1) / NTHR, NPR = (N / 2 + NTHR - 1) / NTHR  , TOFF = (LOGL == 12) ? CTXL : 0;
    LAS f32x2* buf = (LAS f32x2*)F.lds; const LAS f32x2* twl = (const LAS f32x2*)(F.lds + 65536); LAS float* red = (LAS float*)(F.lds + 131072);
    const int tid = F.tid;
    constexpr int NTAP = N / NTHR;
    const float wdelta = fabsf(-15.350567286626973f + (float)c * ((-3.0701134573253946f + 15.350567286626973f) / (float)(DM - 1)));
    const float* v0p = VXT + ((size_t)(0 * 6144 + c)) * TPB + TOFF; const float* v1p = VXT + ((size_t)(1 * 6144 + c)) * TPB + TOFF;
    float zr[NPT], zi[NPT], gt[2][2][NPT], tp[2][NTAP];
#pragma unroll
    for (int i = 0; i < NPT; ++i) { const int t = tid + NTHR * i; zr[i] = (t < L) ? v0p[t] : 0.f; zi[i] = (t < L) ? v1p[t] : 0.f; }
#pragma unroll
    for (int o = 0; o < 2; ++o) {
        const float* kf = HFT + (size_t)((o * 2 + 0) * DM + c) * L; const float* kb = HFT + (size_t)((o * 2 + 1) * DM + c) * L;
#pragma unroll
        for (int i = 0; i < NTAP; ++i) { const int tau = tid + NTHR * i, lag = (tau < L) ? tau : N - tau;
            tp[o][i] = ((tau < L) ? kf[tau] : ((tau > L) ? kb[N - tau] : 0.f)) * __expf(-(float)lag * (1.0f / (float)(L - 1)) * wdelta); }
#pragma unroll
        for (int i = 0; i < NPT; ++i) { const int t = tid + NTHR * i;
            gt[o][0][i] = (t < L) ? VXT[((size_t)(0 * 6144 + (o + 1) * DM + c)) * TPB + TOFF + t] : 0.f; gt[o][1][i] = (t < L) ? VXT[((size_t)(1 * 6144 + (o + 1) * DM + c)) * TPB + TOFF + t] : 0.f; }
    }
#pragma unroll
    for (int o = 0; o < 2; ++o) {
        float ss = 0.f;
#pragma unroll
        for (int i = 0; i < NTAP; ++i) { const float g = tp[o][i]; ss += g * g; buf[tid + NTHR * i] = (f32x2){g, 0.f}; }
        const float scale = rsqrtf(block_sum(ss, red, tid) + 1e-12f) * (1.0f / N);
        fft4_fwd<LOGN>(buf, twl, tid);
        f32x4 G[NPR];
#pragma unroll
        for (int k = 0; k < NPR; ++k) { const int j = tid + NTHR * k; if (j < N / 2) { const f32x4 p = ((const LAS f32x4*)buf)[j]; G[k] = (f32x4){p.x + p.z, p.y + p.w, p.x - p.z, p.y - p.w}; } }
        __syncthreads();
#pragma unroll
        for (int i = 0; i < NPT; ++i) { const int t = tid + NTHR * i; if (t < L) { buf[t] = (f32x2){zr[i], zi[i]}; buf[t + L] = (f32x2){0.f, 0.f}; } }
        __syncthreads();
        fft4_fwd<LOGN>(buf, twl, tid);
#pragma unroll
        for (int k = 0; k < NPR; ++k) { const int j = tid + NTHR * k; if (j < N / 2) { const f32x4 p = ((const LAS f32x4*)buf)[j];
            const f32x2 a = (f32x2){p.x + p.z, p.y + p.w}, b = (f32x2){p.x - p.z, p.y - p.w};
            const f32x2 cc = cmul(a, (f32x2){G[k].x, G[k].y}), dd = cmul(b, (f32x2){G[k].z, G[k].w});
            ((LAS f32x4*)buf)[j] = (f32x4){cc.x + dd.x, cc.y + dd.y, cc.x - dd.x, cc.y - dd.y}; } }
        __syncthreads();
        fft4_inv<LOGN>(buf, twl, tid);
        const float sk = skip[o * DM + c];
#pragma unroll
        for (int i = 0; i < NPT; ++i) { const int t = tid + NTHR * i; if (t < L) { const f32x2 y = buf[t];
            zr[i] = gt[o][0][i] * (y.x * scale + sk * zr[i]); zi[i] = gt[o][1][i] * (y.y * scale + sk * zi[i]); } }
        __syncthreads();
    }
#pragma unroll
    for (int i = 0; i < NPT; ++i) { const int t = tid + NTHR * i; if (t < L) {
        Z[(size_t)c * ROWS + 0 * TPB + TOFF + t] = (bf16_t)(cvt_pk_bf16(zr[i], 0.f) & 0xffffu);
        Z[(size_t)c * ROWS + 1 * TPB + TOFF + t] = (bf16_t)(cvt_pk_bf16(zi[i], 0.f) & 0xffffu); } }
}
__device__ __forceinline__ void hyena_conv3_unit(int unit, const float* U, const float* cw, const float* cb, float* VXT, LAS float* tile  , int lane) {
    const int cblk = unit % 96, tblk = (unit / 96) % 68, b = unit / (96 * 68);
    const int c0 = cblk * 64, t0 = tblk * 64;
    const int ch = c0 + lane;
    const float w0 = cw[ch], w1 = cw[6144 + ch], w2 = cw[2 * 6144 + ch], bb = cb[ch];
    const float* up_ = U + ((size_t)b * TPB + t0) * 6144 + ch;
    const bool first = (t0 == 0) || (t0 == CTXL), last = (t0 + 64 == CTXL) || (t0 + 64 == TPB);
    float v[66];
    v[0] = first ? 0.f : up_[-6144];
#pragma unroll
    for (int i = 0; i < 64; ++i) v[i + 1] = up_[(size_t)i * 6144];
    v[65] = last ? 0.f : up_[(size_t)64 * 6144];
#pragma unroll
    for (int i = 0; i < 64; ++i) tile[lane * 65 + i] = v[i] * w0 + v[i + 1] * w1 + v[i + 2] * w2 + bb;
    LDS_WAIT(); asm volatile("" ::: "memory");
    float* op = VXT + ((size_t)b * 6144 + c0) * TPB + t0 + lane;
#pragma unroll 16
    for (int c = 0; c < 64; ++c) op[(size_t)c * TPB] = tile[c * 65 + lane];
    LDS_WAIT(); asm volatile("" ::: "memory");
}

__device__ __forceinline__ float dpp_sum16(float v) {
    v += __int_as_float(__builtin_amdgcn_update_dpp(0, __float_as_int(v), 0xB1, 0xF, 0xF, false));
    v += __int_as_float(__builtin_amdgcn_update_dpp(0, __float_as_int(v), 0x4E, 0xF, 0xF, false));
    v += __int_as_float(__builtin_amdgcn_update_dpp(0, __float_as_int(v), 0x141, 0xF, 0xF, false));
    v += __int_as_float(__builtin_amdgcn_update_dpp(0, __float_as_int(v), 0x140, 0xF, 0xF, false));
    return v;
}
__device__ __forceinline__ float dpp_sum8(float v) {
    v += __int_as_float(__builtin_amdgcn_update_dpp(0, __float_as_int(v), 0xB1, 0xF, 0xF, false));
    v += __int_as_float(__builtin_amdgcn_update_dpp(0, __float_as_int(v), 0x4E, 0xF, 0xF, false));
    v += __int_as_float(__builtin_amdgcn_update_dpp(0, __float_as_int(v), 0x141, 0xF, 0xF, false));
    return v;
}
template <class BG>
__device__ __forceinline__ void rwkv_scan_unit(const Ctx& F, int unit, const float* DEC, const float* ASIG, const float* k_k, const float* k_a, const float* RKV, float* Y, BG bg) {
    constexpr int T = 32, NCHUNK = TPB / T;
    const int chain = unit >> 1, rh = unit & 1, d = chain >> 6, b = (chain >> 5) & 1, h = chain & 31;
    LAS float* buf = (LAS float*)F.lds;
    const int tid = F.tid, wave = F.wave, lane = F.lane;
    const int rl = wave * 8 + (lane >> 3), kq = lane & 7;
    float* Yd = Y + (size_t)d * ROWS * DM + h * 64 + rh * 32 + rl;
#define RW_ROW(sg) ((size_t)b * TPB + (d == 0 ? (sg) : ((sg) < CTXL ? (CTXL - 1 - (sg)) : (TPB + CTXL - 1 - (sg)))))
    const int st = (tid - 256) & 255, q4 = st & 15, s0 = st >> 4;
    const int hc = h * 64 + q4 * 4;
    const f32x4 ka4 = *(const f32x4*)(k_a + hc), kk4 = *(const f32x4*)(k_k + hc);
    f32x4 R[2][5];
#define ST_ISSUE(ck_) do { _Pragma("unroll") for (int j_ = 0; j_ < 2; ++j_) { const size_t row_ = RW_ROW((ck_) * T + s0 + 16 * j_); \
            R[j_][0] = *(const f32x4*)(DEC + row_ * (2 * DM) + (size_t)d * DM + hc); R[j_][1] = *(const f32x4*)(RKV + ((size_t)ROWS + row_) * DM + hc); \
            R[j_][2] = *(const f32x4*)(ASIG + row_ * (2 * DM) + (size_t)d * DM + hc); R[j_][3] = *(const f32x4*)(RKV + row_ * DM + hc); R[j_][4] = *(const f32x4*)(RKV + ((size_t)2 * ROWS + row_) * DM + hc); } } while (0)
#define ST_WRITE(p_) do { _Pragma("unroll") for (int j_ = 0; j_ < 2; ++j_) { LAS float* o_ = buf + (((p_) * T + s0 + 16 * j_) * 6) * 64 + q4 * 4; \
            const f32x4 a_ = R[j_][2], k_ = R[j_][1]; \
            f32x4 kk_ = k_ * kk4;      \
            const float ss_ = dpp_sum16((kk_.x * kk_.x + kk_.y * kk_.y) + (kk_.z * kk_.z + kk_.w * kk_.w)); \
            kk_ = kk_ * rsqrtf(ss_ + 1e-12f); \
            *(LAS f32x4*)(o_) = R[j_][0]; *(LAS f32x4*)(o_ + 64) = k_ * (1.0f + (a_ - 1.0f) * ka4); *(LAS f32x4*)(o_ + 128) = kk_; *(LAS f32x4*)(o_ + 192) = kk_ * a_; \
            *(LAS f32x4*)(o_ + 256) = R[j_][3]; *(LAS f32x4*)(o_ + 320) = R[j_][4]; } } while (0)
    f32x2 S0 = (f32x2){0.f, 0.f}, S1 = S0, S2 = S0, S3 = S0;
    __syncthreads();
    if (wave >= 4) { ST_ISSUE(0); ST_WRITE(0); ST_ISSUE(1); }
    __syncthreads();
#define RW_LD(W0, W1, K0, K1, A0, A1, B0, B1, R0_, R1_, VT, s_) do { const LAS float* base_ = cb + (s_) * 6 * 64; \
                W0 = *(const LAS f32x4*)(base_); W1 = *(const LAS f32x4*)(base_ + 4); K0 = *(const LAS f32x4*)(base_ + 64); K1 = *(const LAS f32x4*)(base_ + 68); \
                A0 = *(const LAS f32x4*)(base_ + 128); A1 = *(const LAS f32x4*)(base_ + 132); B0 = *(const LAS f32x4*)(base_ + 192); B1 = *(const LAS f32x4*)(base_ + 196); \
                R0_ = *(const LAS f32x4*)(base_ + 256); R1_ = *(const LAS f32x4*)(base_ + 260); VT = vb[(s_) * 6 * 64]; } while (0)
    f32x4 rp0 = (f32x4){0.f, 0.f, 0.f, 0.f}, rp1 = rp0; float yk = 0.f;
#define RW_YKEEP(gv_, y_) do { yk = (kq == ((gv_) & 7)) ? (y_) : yk; \
        if (((gv_) & 7) == 7) { const int sg_ = (gv_) - 7 + kq; const int rr_ = (d == 0) ? sg_ : ((sg_ < CTXL) ? (CTXL - 1 - sg_) : (TPB + CTXL - 1 - sg_)); Yd[((size_t)b * TPB + rr_) * DM] = yk; } } while (0)
#pragma unroll 1
    for (int ck = 0; ck < NCHUNK; ++ck) {
        const int p = ck & 1;
        if (wave >= 4) { if (ck + 1 < NCHUNK) { ST_WRITE(p ^ 1); if (ck + 2 < NCHUNK) ST_ISSUE(ck + 2); } bg(ck, wave - 4); }
        else {
            const LAS float* cb = buf + p * T * 6 * 64 + kq * 8;
            const LAS float* vb = buf + p * T * 6 * 64 + 5 * 64 + rh * 32 + rl;
            f32x4 w0, w1, k0, k1, a0, a1, b0, b1, r0, r1; float vt;
            f32x4 nw0, nw1, nk0, nk1, na0, na1, nb0, nb1, nr0, nr1; float nvt;
            RW_LD(w0, w1, k0, k1, a0, a1, b0, b1, r0, r1, vt, 0);
#pragma unroll
            for (int s = 0; s < T; ++s) {
                if (s + 1 < T) RW_LD(nw0, nw1, nk0, nk1, na0, na1, nb0, nb1, nr0, nr1, nvt, s + 1);
                __builtin_amdgcn_sched_barrier(0);
                const f32x2 vt2 = (f32x2){vt, vt};
                f32x2 t0 = vt2 * (f32x2){k0.x, k0.y}, t1 = vt2 * (f32x2){k0.z, k0.w}, t2 = vt2 * (f32x2){k1.x, k1.y}, t3 = vt2 * (f32x2){k1.z, k1.w};
                asm volatile("" : "+v"(t0), "+v"(t1), "+v"(t2), "+v"(t3));
                f32x2 da = S0 * (f32x2){a0.x, a0.y}, db = S2 * (f32x2){a1.x, a1.y};
                f32x2 ya = S0 * (f32x2){rp0.x, rp0.y}, yb = S2 * (f32x2){rp1.x, rp1.y};
                da = S1 * (f32x2){a0.z, a0.w} + da; db = S3 * (f32x2){a1.z, a1.w} + db;
                ya = S1 * (f32x2){rp0.z, rp0.w} + ya; yb = S3 * (f32x2){rp1.z, rp1.w} + yb;
                da = da + db; ya = ya + yb;
                float xs = da.x + da.y, ys = ya.x + ya.y;
                xs += __int_as_float(__builtin_amdgcn_update_dpp(0, __float_as_int(xs), 0xB1, 0xF, 0xF, false)); ys += __int_as_float(__builtin_amdgcn_update_dpp(0, __float_as_int(ys), 0xB1, 0xF, 0xF, false));
                xs += __int_as_float(__builtin_amdgcn_update_dpp(0, __float_as_int(xs), 0x4E, 0xF, 0xF, false)); ys += __int_as_float(__builtin_amdgcn_update_dpp(0, __float_as_int(ys), 0x4E, 0xF, 0xF, false));
                xs += __int_as_float(__builtin_amdgcn_update_dpp(0, __float_as_int(xs), 0x141, 0xF, 0xF, false)); ys += __int_as_float(__builtin_amdgcn_update_dpp(0, __float_as_int(ys), 0x141, 0xF, 0xF, false));
                const f32x2 sa2 = (f32x2){-xs, -xs};
                f32x2 u0 = sa2 * (f32x2){b0.x, b0.y} + t0, u1 = sa2 * (f32x2){b0.z, b0.w} + t1, u2 = sa2 * (f32x2){b1.x, b1.y} + t2, u3 = sa2 * (f32x2){b1.z, b1.w} + t3;
                asm volatile("" : "+v"(u0), "+v"(u1), "+v"(u2), "+v"(u3));
                S0 = S0 * (f32x2){w0.x, w0.y} + u0; S1 = S1 * (f32x2){w0.z, w0.w} + u1; S2 = S2 * (f32x2){w1.x, w1.y} + u2; S3 = S3 * (f32x2){w1.z, w1.w} + u3;
                if (s > 0) { RW_YKEEP(ck * T + s - 1, ys); } else if (ck > 0) { RW_YKEEP(ck * T - 1, ys); }
                __builtin_amdgcn_sched_barrier(0);
                rp0 = r0; rp1 = r1;
                w0 = nw0; w1 = nw1; k0 = nk0; k1 = nk1; a0 = na0; a1 = na1; b0 = nb0; b1 = nb1; r0 = nr0; r1 = nr1; vt = nvt;
            }
        }
        __syncthreads();
    }
    if (wave < 4) {
        f32x2 ya = S0 * (f32x2){rp0.x, rp0.y}, yb = S2 * (f32x2){rp1.x, rp1.y};
        ya = S1 * (f32x2){rp0.z, rp0.w} + ya; yb = S3 * (f32x2){rp1.z, rp1.w} + yb; ya = ya + yb;
        const float ys = dpp_sum8(ya.x + ya.y);
        RW_YKEEP(TPB - 1, ys);
    }
#undef RW_YKEEP
#undef RW_LD
#undef ST_ISSUE
#undef ST_WRITE
#undef RW_ROW
}
__device__ __forceinline__ float head_sum16(float v) { v += __shfl_xor(v, 1); v += __shfl_xor(v, 2); v += __shfl_xor(v, 4); v += __shfl_xor(v, 8); return v; }
__device__ __forceinline__ void rwkv_shift_row(const float* HLF, const float* mix, bf16_t* XS, int r, int lane) {
    const int t = r % TPB;
    const bool hp = (t != 0) && (t != CTXL), hn = (t != CTXL - 1) && (t != TPB - 1);
    const f32x4* h0 = (const f32x4*)(HLF + (size_t)r * DM) + lane;
    const f32x4 z4 = (f32x4){0.f, 0.f, 0.f, 0.f};
#pragma unroll 2
    for (int j = 0; j < 8; ++j) {
        const f32x4 h = h0[64 * j], p = hp ? h0[64 * j - DM / 4] : z4, n = hn ? h0[64 * j + DM / 4] : z4;
        const f32x4 dp = p - h, dn = n - h;
#pragma unroll
        for (int k = 0; k < 6; ++k) {
            const f32x4 m0 = ((const f32x4*)(mix + (size_t)k * DM))[lane + 64 * j], m1 = ((const f32x4*)(mix + (size_t)(6 + k) * DM))[lane + 64 * j];
            const f32x4 x = h + dp * m0 + dn * m1;
            u32x2 w; w.x = cvt_pk_bf16(x.x, x.y); w.y = cvt_pk_bf16(x.z, x.w);
            ((u32x2*)(XS + ((size_t)k * ROWS + r) * DM))[lane + 64 * j] = w;
        }
    }
}
__device__ __forceinline__ void rwkv_prep_row(const float* Kf, const float* k_k, float* KK, int r, int lane) {
#pragma unroll 2
    for (int j = 0; j < 8; ++j) {
        const int q = lane + 64 * j;
        const f32x4 k = ((const f32x4*)(Kf + (size_t)r * DM))[q], kkw = ((const f32x4*)k_k)[q];
        f32x4 kk = k * kkw;
        const float ss = head_sum16((kk.x * kk.x + kk.y * kk.y) + (kk.z * kk.z + kk.w * kk.w));
        ((f32x4*)(KK + (size_t)r * DM))[q] = kk * rsqrtf(ss + 1e-12f);
    }
}
__device__ __forceinline__ void rwkv_readout_row(const float* Y, const float* RKV, const float* ASIG, const float* k_a, const float* Gf, const float* r_k, const float* ln_w, const float* ln_b, bf16_t* out, int r, int lane) {
#pragma unroll 2
    for (int j = 0; j < 8; ++j) {
        const int q = lane + 64 * j;
        const f32x4 y = ((const f32x4*)(Y + (size_t)r * DM))[q] + ((const f32x4*)(Y + ((size_t)ROWS + r) * DM))[q];
        const float mu = head_sum16((y.x + y.y) + (y.z + y.w)) * (1.0f / 64.0f);
        const f32x4 dlt = y - mu;
        const float var = head_sum16((dlt.x * dlt.x + dlt.y * dlt.y) + (dlt.z * dlt.z + dlt.w * dlt.w)) * (1.0f / 64.0f);
        f32x4 yn = dlt * rsqrtf(var + 64e-5f) * ((const f32x4*)ln_w)[q] + ((const f32x4*)ln_b)[q];
        const f32x4 rr = ((const f32x4*)(RKV + (size_t)r * DM))[q], vv = ((const f32x4*)(RKV + ((size_t)2 * ROWS + r) * DM))[q];
        const f32x4 kf = ((const f32x4*)(RKV + ((size_t)ROWS + r) * DM))[q], asum = ((const f32x4*)(ASIG + (size_t)r * 2 * DM))[q] + ((const f32x4*)(ASIG + (size_t)r * 2 * DM + DM))[q];
        const f32x4 ks = kf * (2.0f + (asum - 2.0f) * ((const f32x4*)k_a)[q]);
        const f32x4 rk = rr * ((const f32x4*)r_k)[q] * ks;
        const float bs = head_sum16((rk.x + rk.y) + (rk.z + rk.w));
        yn = (yn + bs * vv) * ((const f32x4*)(Gf + (size_t)r * DM))[q];
        u32x2 w; w.x = cvt_pk_bf16(yn.x, yn.y); w.y = cvt_pk_bf16(yn.z, yn.w);
        ((u32x2*)(out + (size_t)r * DM))[q] = w;
    }
}

template <int HALF> __device__ __forceinline__ void rope_sincos(float pos, int lane, float& sn, float& cs) { sincosf(pos * rope_invfreq(lane & (HALF - 1), HALF), &sn, &cs); }
template <int HALF> __device__ __forceinline__ float rope_apply(float u, float sn, float cs, int lane) {
    const float up = __shfl_xor(u, HALF);
    return (lane & HALF) ? (up * sn + u * cs) : (u * cs - up * sn);
}
__device__ __forceinline__ void mla_row_a(const float* RAW, const float* qg, const float* kvg, bf16_t* CQN, bf16_t* CKVN, bf16_t* Kb, int r, int lane) {
    const float* raw = RAW + (size_t)r * 1280;
    const int t = r % TPB;
#pragma unroll
    for (int part = 0; part < 2; ++part) {
        const f32x4 a = ((const f32x4*)(raw + part * 512))[lane], b = ((const f32x4*)(raw + part * 512))[lane + 64];
        const float ss = wave_sum((a.x * a.x + a.y * a.y) + (a.z * a.z + a.w * a.w) + (b.x * b.x + b.y * b.y) + (b.z * b.z + b.w * b.w));
        const float rinv = rsqrtf(ss * (1.0f / 512.0f) + 1e-6f);
        const float* g = part ? kvg : qg;
        const f32x4 ya = a * rinv * ((const f32x4*)g)[lane], yb = b * rinv * ((const f32x4*)g)[lane + 64];
        bf16_t* o = (part ? CKVN : CQN) + (size_t)r * 512;
        u32x2 w; w.x = cvt_pk_bf16(ya.x, ya.y); w.y = cvt_pk_bf16(ya.z, ya.w); ((u32x2*)o)[lane] = w;
        w.x = cvt_pk_bf16(yb.x, yb.y); w.y = cvt_pk_bf16(yb.z, yb.w); ((u32x2*)o)[lane + 64] = w;
    }
    float kp = raw[1024 + lane];
    if (t >= CTXL) { const int l = t - CTXL; const float pos = (lane < 32) ? (float)(l >> 6) : (float)(l & 63); float sn, cs; rope_sincos<16>(pos, lane, sn, cs); kp = rope_apply<16>(kp, sn, cs, lane); }
    const bf16_t kb = (bf16_t)(cvt_pk_bf16(kp, 0.f) & 0xffffu);
#pragma unroll
    for (int h = 0; h < 16; ++h) Kb[(size_t)r * 3072 + h * 192 + 128 + lane] = kb;
}
__device__ __forceinline__ void mla_row_q(const float* QRAW, bf16_t* Qb, int r, int lane) {
    const float* q = QRAW + (size_t)r * 3072; bf16_t* o = Qb + (size_t)r * 3072;
    const int t = r % TPB; const bool lat = t >= CTXL; const int l = t - CTXL;
    const float pos = (lane < 32) ? (float)(l >> 6) : (float)(l & 63);
    float sn = 0.f, cs = 1.f; if (lat) rope_sincos<16>(pos, lane, sn, cs);
#pragma unroll 4
    for (int h = 0; h < 16; ++h) {
        const f32x2 a = ((const f32x2*)(q + h * 192))[lane];
        ((unsigned*)(o + h * 192))[lane] = cvt_pk_bf16(a.x, a.y);
        float pe = q[h * 192 + 128 + lane];
        if (lat) pe = rope_apply<16>(pe, sn, cs, lane);
        o[h * 192 + 128 + lane] = (bf16_t)(cvt_pk_bf16(pe, 0.f) & 0xffffu);
    }
}
template <bool CTX>
__device__ __forceinline__ void gqa_row(const float* RAW, const float* SL, const float* qg, const float* kg, bf16_t* Qb, bf16_t* Kb, bf16_t* Vb, int r, int lane) {
    const float* raw = RAW + (size_t)r * 4096;
    const float* sl = SL + (size_t)((r / TPB) * CTXL + (r % TPB)) * 2048 - 2048;
    constexpr size_t SS = (size_t)(NB * CTXL) * 2048;
    const int l = (r % TPB) - CTXL;
    float sn0 = 0.f, cs0 = 1.f, sn1 = 0.f, cs1 = 1.f; if (!CTX && l >= 0) { rope_sincos<32>((float)(l >> 6), lane, sn0, cs0); rope_sincos<32>((float)(l & 63), lane, sn1, cs1); }
#pragma unroll 2
    for (int h = CTX ? 16 : 0; h < 24; ++h) {
        float x0, x1;
        if (!CTX) { x0 = raw[h * 128 + lane]; x1 = raw[h * 128 + 64 + lane]; }
        else { x0 = (sl[h * 128 + lane] + sl[SS + h * 128 + lane]) + (sl[2 * SS + h * 128 + lane] + sl[3 * SS + h * 128 + lane]);
               x1 = (sl[h * 128 + 64 + lane] + sl[SS + h * 128 + 64 + lane]) + (sl[2 * SS + h * 128 + 64 + lane] + sl[3 * SS + h * 128 + 64 + lane]); }
        const float rinv = rsqrtf(wave_sum(x0 * x0 + x1 * x1) * (1.0f / 128.0f) + 1e-6f);
        const float* g = (h < 16) ? qg : kg;
        x0 = x0 * rinv * g[lane]; x1 = x1 * rinv * g[64 + lane];
        if (!CTX) { x0 = rope_apply<32>(x0, sn0, cs0, lane); x1 = rope_apply<32>(x1, sn1, cs1, lane); }
        bf16_t* o = (h < 16) ? (Qb + (size_t)r * 2048 + h * 128) : (Kb + (size_t)r * 1024 + (h - 16) * 128);
        o[lane] = (bf16_t)(cvt_pk_bf16(x0, 0.f) & 0xffffu); o[64 + lane] = (bf16_t)(cvt_pk_bf16(x1, 0.f) & 0xffffu);
    }
#pragma unroll
    for (int j = 0; j < 4; ++j) { f32x4 a;
        if (!CTX) a = ((const f32x4*)(raw + 3072))[lane + 64 * j];
        else a = (((const f32x4*)(sl + 3072))[lane + 64 * j] + ((const f32x4*)(sl + SS + 3072))[lane + 64 * j]) + (((const f32x4*)(sl + 2 * SS + 3072))[lane + 64 * j] + ((const f32x4*)(sl + 3 * SS + 3072))[lane + 64 * j]);
        u32x2 w; w.x = cvt_pk_bf16(a.x, a.y); w.y = cvt_pk_bf16(a.z, a.w); ((u32x2*)(Vb + (size_t)r * 1024))[lane + 64 * j] = w; }
}
struct Args { const float* in[49]; float* out; unsigned char* ws; int ph_lo, ph_hi, li, pad; };
constexpr int N_PHASES = 52;

#define RUN_GEMM(EPI_T, epi, A_, Bt_, K_, ...) do { typedef pg8::TSched<__VA_ARGS__> Sch_; Sch_ S_; S_.init(F.G, F.bid); pg8::gemm_phase<EPI_T, Sch_>(F.lds, pg8::Gemm{(const bf16_t*)(A_), (const bf16_t*)(Bt_), (K_)}, S_, (epi)); } while (0)

#define FFN_PHASES(p0, l, s, lat_only, nsp) do { \
    const float* mods_l_ = MODS + (size_t)(l) * 3 * NMOD * DM; const int h_ = (s) ? 1 : 0; \
    PHASE((p0)) { const float* g_ = AIN(6) + (size_t)((l) * 3 + (s)) * DM; \
        for (int r = F.gw; r < ROWS; r += F.NGW) { if ((lat_only) && (r % TPB) < CTXL) continue; f32x4 y[8]; modnorm_row(X, g_, mods_l_, (s), r, F.lane, y, (nsp) ? PART : nullptr, (nsp)); store_row_bf16(NBF + (size_t)r * DM, F.lane, y); } \
        if (BOTH((p0))) GRID_BAR(); } \
    PHASE((p0) + 1) { pg8::EpiSwiglu E{ACT}; \
        RUN_GEMM(pg8::EpiSwiglu, E, NBF, ws + WS_W + W_GU((l), h_), DM, (lat_only) ? 32 : NPAN, 44, 0, 0, 1, (lat_only) ? 1 : 0); if (BOTH((p0) + 1)) GRID_BAR(); } \
    PHASE((p0) + 2) { pg8::EpiResid E{X, mods_l_, 3 * (s) + 2, A.pad ? 0.f : 0.5f, nullptr}; \
        RUN_GEMM(pg8::EpiResid, E, ACT, ws + WS_W + W_DN((l), h_), FF, 32, 8, 0, 0, 1, 1, (lat_only) ? 0 : 2, 8, 0, 0, 11, 2);     if (BOTH((p0) + 2)) GRID_BAR(); } \
} while (0)

__device__ __forceinline__ const float* ain_(const Args& A, int i) { asm volatile("" : "+s"(i)); return A.in[i]; }
constexpr int BG_NSLOTS = 4 * 16896 + 1280 + 1792 + 2048 + 4096 + 2048;
__device__ __forceinline__ void bg_convert_slot(const Args& A, int slot, LAS float* scr, int lane) {
    if (slot >= BG_NSLOTS) return;
    unsigned char* W = A.ws + WS_W;
    const f32x4 z4 = (f32x4){0.f, 0.f, 0.f, 0.f};
#define LD4(p_) (*(const f32x4*)(p_))
#define CONV_ONE(ND, KD, DST, it_, ...) conv_tile(__VA_ARGS__, (bf16_t*)(DST), (KD), ((it_) % ((ND) / 32)) * 32, ((it_) / ((ND) / 32)) * 64, scr, lane)
    if (slot < 4 * 16896) {
        const int lh = 4 + slot / 16896, r = slot % 16896;
        if (r < 11264) { const float* sg = ain_(A, 7) + (size_t)lh * DM * (2 * FF);
            CONV_ONE(2 * FF, DM, W + W_GU(lh >> 1, lh & 1), r, [=](int n, int k) { const int sn = ((n >> 7) & 1) * FF + (n >> 8) * 128 + (n & 127); return LD4(sg + (size_t)k * (2 * FF) + sn); }); }
        else { const float* sd = ain_(A, 8) + (size_t)lh * FF * DM;
            CONV_ONE(DM, FF, W + W_DN(lh >> 1, lh & 1), r - 11264, [=](int n, int k) { return LD4(sd + (size_t)k * DM + n); }); }
        return;
    }
    int r = slot - 4 * 16896;
    if (r < 1280) { const float* s = ain_(A, 38); CONV_ONE(1280, DM, W + W_ML_WD, r, [=](int n, int k) { return n < 1088 ? LD4(s + (size_t)k * 1088 + n) : z4; }); return; } r -= 1280;
    if (r < 1792) { const float* s = ain_(A, 40); const float* s2 = ain_(A, 42); CONV_ONE(7168, 512, W + W_ML_BT3, r, [=](int n, int k) { return n < 3072 ? LD4(s + (size_t)k * 3072 + n) : LD4(s2 + (size_t)k * 4096 + (n - 3072)); }); return; } r -= 1792;
    if (r < 2048) { const float* s = ain_(A, 43); CONV_ONE(DM, DM, W + W_ML_WO, r, [=](int n, int k) { return LD4(s + (size_t)k * DM + n); }); return; } r -= 2048;
    if (r < 4096) { const float* s = ain_(A, 44); CONV_ONE(2 * DM, DM, W + W_GQ_QKV, r, [=](int n, int k) { return LD4(s + (size_t)k * (2 * DM) + n); }); return; } r -= 4096;
    { const float* s = ain_(A, 47); CONV_ONE(DM, DM, W + W_GQ_WO, r, [=](int n, int k) { return LD4(s + (size_t)k * DM + n); }); }
#undef CONV_ONE
#undef LD4
}
__global__ void __launch_bounds__(NTHR, 2) fwd_kernel(Args A) {
    extern __shared__ __attribute__((aligned(16))) unsigned char lds_raw[];
    Ctx F;
    F.lds = (LAS unsigned char*)lds_raw;
    F.tid = threadIdx.x; F.lane = F.tid & 63; F.wave = __builtin_amdgcn_readfirstlane(F.tid >> 6);
    F.bid = blockIdx.x; F.G = gridDim.x; F.gw = F.bid * NWAVES + F.wave; F.NGW = F.G * NWAVES;
    volatile LAS unsigned* MISC = (volatile LAS unsigned*)(F.lds + MISC_OFF);
    if (F.tid < 32) MISC[F.tid] = 0u;
    __syncthreads();
    const int lo = A.ph_lo, hi = A.ph_hi;
    XcdBarrier bar; bar.bar = (unsigned*)(A.ws + WS_CTL) + CW_BAR + A.li * XCD_BAR_WORDS; bar.x = 0; bar.st = MISC + 8;
    if (hi - lo > 1) bar = xcd_barrier_post((unsigned*)(A.ws + WS_CTL) + CW_BAR + A.li * XCD_BAR_WORDS, MISC + 8);
#ifndef PH_MIN
#define PH_MIN 0
#define PH_MAX 1000
#endif
#define IN(k) ((k) >= PH_MIN && (k) <= PH_MAX && lo <= (k) && (k) < hi)
#define BOTH(k) (IN(k) && IN((k) + 1))
#define PHASE(k) if (IN(k))
#define GRID_BAR() xcd_barrier(bar)
#define ws (A.ws)
#define AIN(i) ain_(A, (i))
#define MODS ((float*)(ws + WS_MODS))
#define TW ((f32x2*)(ws + WS_TW))
#define HIDA ((bf16_t*)(ws + WS_HIDA))
#define ADAP ((float*)(ws + WS_ADAP))
#define X ((float*)(ws + WS_X))
#define NBF ((bf16_t*)(ws + WS_NB))
#define ACT ((bf16_t*)(ws + WS_ACT))
#define mix (ws + WS_MIX)
#define PART ((float*)(ws + WS_PART))

    PHASE(0) {
        { const float* xin = AIN(0); const float* cin = AIN(2);
          for (size_t i = (size_t)F.bid * NTHR + F.tid; i < (size_t)ROWS * (DM / 4); i += (size_t)F.G * NTHR) {
              const int r = (int)(i / (DM / 4)), c4 = (int)(i % (DM / 4)), b = r / TPB, t = r % TPB;
              const float* src = (t < CTXL) ? cin + ((size_t)b * CTXL + t) * DM : xin + ((size_t)b * SEQ + (t - CTXL)) * DM;
              ((f32x4*)(X + (size_t)r * DM))[c4] = ((const f32x4*)src)[c4]; } }
        for (int k = F.bid * NTHR + F.tid; k < 8192; k += F.G * NTHR) { float sn, cs; sincospif((float)k * (1.0f / 4096.0f), &sn, &cs); TW[k] = (f32x2){cs, -sn}; }
        { LAS float* sl = (LAS float*)(F.lds + 73728);
          for (int i = F.tid; i < 3 * DM; i += NTHR) { const float v = (i < 2 * DM) ? AIN(1)[i] : AIN(3)[i - 2 * DM]; sl[i] = v / (1.0f + expf(-v)); }
          __syncthreads();
          const float* aw = AIN(4);
          for (int unit = F.bid; unit < 4 * 9 * 16; unit += F.G) {
              const int l = unit / 144, rem = unit % 144, cc = rem / 16, kc = rem % 16, col = cc * 2048 + F.tid * 4;
              f32x4 a0 = (f32x4){0.f, 0.f, 0.f, 0.f}, a1 = a0, a2 = a0;
              const float* wp = aw + ((size_t)l * DM + kc * 128) * NADA + col;
#pragma unroll 8
              for (int k = 0; k < 128; ++k) { const f32x4 w = *(const f32x4*)(wp + (size_t)k * NADA); const int kk = kc * 128 + k;
                  a0 += w * sl[kk]; a1 += w * sl[DM + kk]; a2 += w * sl[2 * DM + kk]; }
              float* op = ADAP + ((size_t)(kc * 4 + l) * 3) * NADA + col;
              *(f32x4*)op = a0; *(f32x4*)(op + NADA) = a1; *(f32x4*)(op + 2 * NADA) = a2; }
          __syncthreads(); }
        { LAS float* scr = (LAS float*)(F.lds + F.wave * 8448);
          unsigned char* W = ws + WS_W;
#define LD4(p_) (*(const f32x4*)(p_))
          const f32x4 z4 = (f32x4){0.f, 0.f, 0.f, 0.f};
#pragma unroll 1
          for (int lh = 0; lh < 4; ++lh) {
              const float* sg = AIN(7) + (size_t)lh * DM * (2 * FF); const float* sd = AIN(8) + (size_t)lh * FF * DM;
              CONV_JOB(2 * FF, DM, W + W_GU(lh >> 1, lh & 1), [=](int n, int k) { const int sn = ((n >> 7) & 1) * FF + (n >> 8) * 128 + (n & 127); return LD4(sg + (size_t)k * (2 * FF) + sn); });
              CONV_JOB(DM, FF, W + W_DN(lh >> 1, lh & 1), [=](int n, int k) { return LD4(sd + (size_t)k * DM + n); });
          }
          { const float* s = AIN(9);  CONV_JOB(3 * DM, DM, W + W_HY_IN, [=](int n, int k) { return LD4(s + (size_t)k * (3 * DM) + n); }); }
          { const float* s = AIN(20); CONV_JOB(DM, DM, W + W_HY_OUT, [=](int n, int k) { return LD4(s + (size_t)k * DM + n); }); }
          { const float* s = AIN(17); CONV_JOB(4 * DM, 256, W + W_HY_F3, [=](int n, int k) { const int seg = k >> 6; if (seg == 3) return z4; const f32x4 w = LD4(s + (size_t)(k & 63) * (4 * DM) + n);
                const f32x4 h = (f32x4){bf_hi(w.x), bf_hi(w.y), bf_hi(w.z), bf_hi(w.w)}; return seg == 2 ? w - h : h; }); }
          { const float* s = AIN(23); const float* w1 = AIN(25); const float* a1 = AIN(28); const float* g1 = AIN(30);
            CONV_JOB(6912, DM, W + W_RW_BT1, [=](int n, int k) { if (n < 3 * DM) return LD4(s + ((size_t)(n >> 11) * DM + k) * DM + (n & (DM - 1)));
                const int j = n - 3 * DM, blk = j >> 8, jj = j & 255; if (blk == 2) return LD4(g1 + (size_t)k * 256 + jj); if (jj >= 192) return z4;
                const int d = jj / 96, e = jj - d * 96; return LD4((blk ? a1 : w1) + ((size_t)d * DM + k) * 96 + e); }); }
          { const float* w2 = AIN(26); const float* a2 = AIN(29); const float* g2 = AIN(31);
            CONV_JOB(10240, 256, W + W_RW_BT2, [=](int n, int k) { if (n >= 4 * DM) return LD4(g2 + (size_t)k * DM + (n - 4 * DM));
                const int blk = n >> 12, nn = n & 4095, d = nn >> 11, c = nn & (DM - 1), kk = k - 96 * d; if (kk < 0 || kk >= 96) return z4;
                return LD4((blk ? a2 : w2) + ((size_t)d * 96 + kk) * DM + c); }); }
          { const float* s = AIN(37); CONV_JOB(DM, DM, W + W_RW_WO, [=](int n, int k) { return LD4(s + (size_t)k * DM + n); }); }
#undef LD4
        }
        {
        const float* fw1 = AIN(13); const float* fb1 = AIN(14); const float* fw2 = AIN(15); const float* fb2 = AIN(16); const float* sf = AIN(18);
        for (int m = F.gw; m < 4352; m += F.NGW) {
            const int L = (m < 4096) ? 4096 : 256, mm = (m < 4096) ? m : m - 4096, j = F.lane;
            const float wv = (float)(6.283185307179586 / (double)L) * (float)mm;
            float z = 0.f;
            if (j == 0) z = (float)mm / (float)(L - 1);
            else if (j <= 16) z = cosf((1e-4f + (float)(j - 1) * ((15.0f - 1e-4f) / 15.0f)) * wv);
            else if (j <= 32) z = -sinf((1e-4f + (float)(j - 17) * ((15.0f - 1e-4f) / 15.0f)) * wv);
            float acc = fb1[j];
#pragma unroll
            for (int i = 0; i < 33; ++i) acc += __shfl(z, i) * fw1[i * 64 + j];
            const float h1 = sinf(sf[j] * acc);
            acc = fb2[j];
#pragma unroll
            for (int i = 0; i < 64; ++i) acc += __shfl(h1, i) * fw2[i * 64 + j];
            const float h2 = sinf(sf[64 + j] * acc);
            const float hh = bf_hi(h2);
            bf16_t* o = HIDA + (size_t)m * 256;
            const bf16_t bh = (bf16_t)(cvt_pk_bf16(hh, 0.f) & 0xffffu), bl = (bf16_t)(cvt_pk_bf16(h2 - hh, 0.f) & 0xffffu);
            o[j] = bh; o[64 + j] = bl; o[128 + j] = bh; o[192 + j] = 0; }
        }
        if (BOTH(0)) GRID_BAR();
    }
    PHASE(1) {
        const float* ab = AIN(5);
        for (int i = F.bid * NTHR + F.tid; i < 4 * 3 * NADA; i += F.G * NTHR) {
            const int l = i / (3 * NADA), n = i % NADA; float s = ab[(size_t)l * NADA + n];
#pragma unroll
            for (int kc = 0; kc < 16; ++kc) s += ADAP[(size_t)kc * 12 * NADA + i];
            MODS[i] = s; }
        if (BOTH(1)) GRID_BAR();
    }
    FFN_PHASES(2, 0, 0, 0, 0);
    { const float* mods_l = MODS;
      float* U = (float*)(mix + HY_U); float* VXT = (float*)(mix + HY_VXT); float* HFT = (float*)(mix + HY_HFT); bf16_t* ZT = (bf16_t*)(mix + HY_U);
      PHASE(5) { const float* g = AIN(6) + (size_t)(0 * 3 + 1) * DM;
          for (int r = F.gw; r < ROWS; r += F.NGW) { f32x4 y[8]; modnorm_row(X, g, mods_l, 1, r, F.lane, y, PART, 11); store_row_bf16(NBF + (size_t)r * DM, F.lane, y); }
          { pg8::EpiHyF E{HFT, HFT + (size_t)8192 * 4096}; RUN_GEMM(pg8::EpiHyF, E, HIDA, ws + WS_W + W_HY_F3, 256, 17, 32, 0, 0, 1, 0); }
          if (BOTH(5)) GRID_BAR(); }
      PHASE(6) { pg8::EpiF32 E{U, 3 * DM, AIN(10)};
          RUN_GEMM(pg8::EpiF32, E, NBF, ws + WS_W + W_HY_IN, DM, NPAN, 24, 0, 0, 1, 0); if (BOTH(6)) GRID_BAR(); }
      PHASE(7) { __syncthreads(); for (int unit = F.gw; unit < 2 * 68 * 96; unit += F.NGW) hyena_conv3_unit(unit, U, AIN(11), AIN(12), VXT, (LAS float*)(F.lds + F.wave * 16640), F.lane); if (BOTH(7)) GRID_BAR(); }
      PHASE(8) { __syncthreads();
          { LAS f32x2* twl = (LAS f32x2*)(F.lds + 65536);
            for (int e = F.tid; e < FFT_TW; e += NTHR) { const int s = e < 2048 ? 0 : (e < 2560 ? 1 : (e < 2688 ? 2 : (e < 2720 ? 3 : (e < 2728 ? 4 : 5)))); const int ix = (e - fft_toff(s)) << (2 * s);
                twl[e] = TW[ix]; twl[FFT_TW + e] = TW[2 * ix]; twl[2 * FFT_TW + e] = TW[3 * ix]; }
            __syncthreads(); }
          for (int c = F.bid; c < DM; c += F.G) hyena_channel<12>(F, c, VXT, HFT, AIN(19), ZT);
          for (int c = F.bid; c < DM; c += F.G) hyena_channel<8>(F, c, VXT, HFT + (size_t)8192 * 4096, AIN(19), ZT);
          if (BOTH(8)) GRID_BAR(); }
      PHASE(9) { __syncthreads();
          LAS bf16_t* tile = (LAS bf16_t*)F.lds;
          for (int unit = F.bid; unit < 136 * 32; unit += F.G) { const int r0 = (unit % 136) * 64, c0 = (unit / 136) * 64;
#pragma unroll
              for (int k = 0; k < 8; ++k) { const int cl = 8 * k + (F.tid >> 6); tile[cl * 66 + F.lane] = ZT[(size_t)(c0 + cl) * ROWS + r0 + F.lane]; }
              __syncthreads();
              { const int rl = F.tid >> 3, cs = (F.tid & 7) * 8; unsigned w[4];
#pragma unroll
                for (int e = 0; e < 4; ++e) w[e] = (unsigned)tile[(cs + 2 * e) * 66 + rl] | ((unsigned)tile[(cs + 2 * e + 1) * 66 + rl] << 16);
                *(u32x4*)(NBF + (size_t)(r0 + rl) * DM + c0 + cs) = (u32x4){w[0], w[1], w[2], w[3]}; }
              __syncthreads(); }
          if (BOTH(9)) GRID_BAR(); }
      PHASE(10) { pg8::EpiResid E{X, mods_l, 5, A.pad ? 0.f : 1.0f, AIN(21)};
          RUN_GEMM(pg8::EpiResid, E, NBF, ws + WS_W + W_HY_OUT, DM, 32, 8, 0, 0, 1, 1, 2, 8, 0, 0, 4, 2); if (BOTH(10)) GRID_BAR(); }
    }
    FFN_PHASES(11, 0, 2, 0, 4);
    FFN_PHASES(14, 1, 0, 0, 11);
    { const float* mods_l = MODS + (size_t)1 * 3 * NMOD * DM;
      bf16_t* XS = (bf16_t*)(mix + RW_XS); float* HLF = (float*)(mix + RW_HLF);
      float* RKV = (float*)(mix + RW_RKV); bf16_t* LM = (bf16_t*)(mix + RW_LM); float* DEC = (float*)(mix + RW_DEC); float* ASIG = (float*)(mix + RW_ASIG); float* Y = (float*)(mix + RW_Y);
      float* Gf = (float*)(mix + RW_G);
      PHASE(17) { const float* g = AIN(6) + (size_t)(1 * 3 + 1) * DM;
          for (int r = F.gw; r < ROWS; r += F.NGW) { f32x4 y[8]; modnorm_row(X, g, mods_l, 1, r, F.lane, y, PART, 11);
#pragma unroll
              for (int j = 0; j < 8; ++j) ((f32x4*)(HLF + (size_t)r * DM))[F.lane + 64 * j] = y[j]; }
          if (BOTH(17)) GRID_BAR(); }
      PHASE(18) { for (int r = F.gw; r < ROWS; r += F.NGW) rwkv_shift_row(HLF, AIN(22), XS, r, F.lane); if (BOTH(18)) GRID_BAR(); }
      PHASE(19) {
          pg8::EpiRw1 E{RKV, LM}; RUN_GEMM(pg8::EpiRw1, E, XS, ws + WS_W + W_RW_BT1, DM, NPAN, 8, 0 * NPAN, 0, 1, 0, NPAN, 8, 2 * NPAN, 8, 1, 0, NPAN, 8, 3 * NPAN, 16, 1, 0, NPAN, 1, 1 * NPAN, 24, 1, 0, NPAN, 1, 4 * NPAN, 25, 1, 0, NPAN, 1, 5 * NPAN, 26, 1, 0);
          if (BOTH(19)) GRID_BAR(); }
      PHASE(20) { pg8::EpiRw2 E{DEC, ASIG, Gf, AIN(24), AIN(27)};
          RUN_GEMM(pg8::EpiRw2, E, LM, ws + WS_W + W_RW_BT2, 256, NPAN, 16, 0 * NPAN, 0, 1, 0, NPAN, 16, 1 * NPAN, 16, 1, 0, NPAN, 8, 2 * NPAN, 32, 1, 0); if (BOTH(20)) GRID_BAR(); }
      PHASE(21) {
          int nslot_done = 0;
          for (int unit = F.bid; unit < 256; unit += F.G) {
              const int first = (unit == F.bid);
              auto bg = [&](int ck, int w4) { if (first) bg_convert_slot(A, ck * (F.G * 4) + F.bid * 4 + w4, (LAS float*)(F.lds + 98304 + w4 * 8448), F.lane); };
              rwkv_scan_unit(F, unit, DEC, ASIG, AIN(32), AIN(33), RKV, Y, bg);
              if (first) nslot_done = (TPB / 32) * F.G * 4; }
          __syncthreads();
          for (int slot = nslot_done + F.gw; slot < BG_NSLOTS; slot += F.NGW) bg_convert_slot(A, slot, (LAS float*)(F.lds + F.wave * 8448), F.lane);
          if (BOTH(21)) GRID_BAR(); }
      PHASE(22) { for (int r = F.gw; r < ROWS; r += F.NGW) rwkv_readout_row(Y, RKV, ASIG, AIN(33), Gf, AIN(34), AIN(35), AIN(36), NBF, r, F.lane); if (BOTH(22)) GRID_BAR(); }
      PHASE(23) { pg8::EpiResid E{X, mods_l, 5, A.pad ? 0.f : 1.0f, nullptr};
          RUN_GEMM(pg8::EpiResid, E, NBF, ws + WS_W + W_RW_WO, DM, 32, 8, 0, 0, 1, 1, 2, 8, 0, 0, 4, 2); if (BOTH(23)) GRID_BAR(); }
    }
    FFN_PHASES(24, 1, 2, 0, 4);
    FFN_PHASES(27, 2, 0, 0, 11);
    { const float* mods_l = MODS + (size_t)2 * 3 * NMOD * DM;
      float* RAW = (float*)(mix + ML_RAW); bf16_t* CN = (bf16_t*)(mix + ML_CN); float* QRAW = (float*)(mix + ML_QRAW);
      bf16_t* Qb = (bf16_t*)(mix + ML_Q); bf16_t* Kb = (bf16_t*)(mix + ML_K); bf16_t* Vb = (bf16_t*)(mix + ML_V);
      PHASE(30) { const float* g = AIN(6) + (size_t)(2 * 3 + 1) * DM;
          for (int r = F.gw; r < ROWS; r += F.NGW) { f32x4 y[8]; modnorm_row(X, g, mods_l, 1, r, F.lane, y, PART, 11); store_row_bf16(NBF + (size_t)r * DM, F.lane, y); }
          if (BOTH(30)) GRID_BAR(); }
      PHASE(31) { pg8::EpiF32 E{RAW, 1280, nullptr};
          RUN_GEMM(pg8::EpiF32, E, NBF, ws + WS_W + W_ML_WD, DM, NPAN, 5, 0, 0, 1, 0); if (BOTH(31)) GRID_BAR(); }
      PHASE(32) { for (int r = F.gw; r < ROWS; r += F.NGW) mla_row_a(RAW, AIN(39), AIN(41), CN, CN + (size_t)ROWS * 512, Kb, r, F.lane); if (BOTH(32)) GRID_BAR(); }
      PHASE(33) { pg8::EpiMla3 E{QRAW, Kb, Vb};
          RUN_GEMM(pg8::EpiMla3, E, CN, ws + WS_W + W_ML_BT3, 512, NPAN, 12, 0, 0, 1, 0, NPAN, 16, NPAN, 12, 1, 0); if (BOTH(33)) GRID_BAR(); }
      PHASE(34) { for (int r = F.gw; r < ROWS; r += F.NGW) mla_row_q(QRAW, Qb, r, F.lane); if (BOTH(34)) GRID_BAR(); }
      PHASE(35) { const int vc = (F.G % 8 == 0) ? (F.bid % 8) * (F.G / 8) + F.bid / 8 : F.bid;
          for (int i = 0;; ++i) { const int L = i * F.G + vc; if (L >= 544) break;
              int b, h, q0, seq; if (L < 512) { b = L >> 8; h = (L & 255) >> 4; q0 = b * TPB + CTXL + (L & 15) * 256; seq = TPB; } else { const int u = L - 512; b = u >> 4; h = u & 15; q0 = b * TPB; seq = CTXL; }
              __syncthreads();
              att::attn_dense_body<192, 3072, 3072, 2048, 2048>(Qb + (size_t)q0 * 3072 + h * 192, Kb + (size_t)b * TPB * 3072 + h * 192, Vb + (size_t)b * TPB * 2048 + h * 128, NBF + (size_t)q0 * DM + h * 128, seq, (char*)lds_raw); }
          if (BOTH(35)) GRID_BAR(); }
      PHASE(36) { pg8::EpiResid E{X, mods_l, 5, A.pad ? 0.f : 1.0f, nullptr};
          RUN_GEMM(pg8::EpiResid, E, NBF, ws + WS_W + W_ML_WO, DM, 32, 8, 0, 0, 1, 1, 2, 8, 0, 0, 4, 2); if (BOTH(36)) GRID_BAR(); }
    }
    FFN_PHASES(37, 2, 2, 0, 4);
    FFN_PHASES(40, 3, 0, 0, 11);
    { const float* mods_l = MODS + (size_t)3 * 3 * NMOD * DM;
      float* RAW = (float*)(mix + GQ_RAW); bf16_t* Qb = (bf16_t*)(mix + GQ_Q); bf16_t* Kb = (bf16_t*)(mix + GQ_K); bf16_t* Vb = (bf16_t*)(mix + GQ_V);
      PHASE(43) { const float* g = AIN(6) + (size_t)(3 * 3 + 1) * DM;
          for (int r = F.gw; r < ROWS; r += F.NGW) { f32x4 y[8]; modnorm_row(X, g, mods_l, 1, r, F.lane, y, PART, 11); store_row_bf16(NBF + (size_t)r * DM, F.lane, y); }
          if (BOTH(43)) GRID_BAR(); }
      PHASE(44) { pg8::EpiF32 E{RAW, 4096, nullptr};
          RUN_GEMM(pg8::EpiF32, E, NBF, ws + WS_W + W_GQ_QKV, DM, NPAN, 16, 0, 0, 1, 0); if (BOTH(44)) GRID_BAR(); }
      PHASE(45) { for (int r = F.gw; r < ROWS; r += F.NGW) gqa_row<false>(RAW, PART, AIN(45), AIN(46), Qb, Kb, Vb, r, F.lane); if (BOTH(45)) GRID_BAR(); }
      PHASE(46) { const int vc = (F.G % 8 == 0) ? (F.bid % 8) * (F.G / 8) + F.bid / 8 : F.bid;
          for (int i = 0;; ++i) { const int L = i * F.G + vc; if (L >= 512) break;
              const int b = L >> 8, h = (L & 255) >> 4, q0 = b * TPB + CTXL + (L & 15) * 256;
              __syncthreads();
              att::attn_dense_body2<128, 2048, 1024, 1024, 2048, 2>(Qb + (size_t)q0 * 2048 + h * 128, Kb + (size_t)b * TPB * 1024 + (h >> 1) * 128, Vb + (size_t)b * TPB * 1024 + (h >> 1) * 128, NBF + (size_t)q0 * DM + h * 128, TPB, (char*)lds_raw); }
          if (BOTH(46)) GRID_BAR(); }
      PHASE(47) { pg8::EpiResid E{X, mods_l, 5, A.pad ? 0.f : 1.0f, nullptr};
          RUN_GEMM(pg8::EpiResid, E, NBF, ws + WS_W + W_GQ_WO, DM, 32, 8, 0, 0, 1, 1); if (BOTH(47)) GRID_BAR(); }
    }
    FFN_PHASES(48, 3, 2, 1, 0);
#ifdef EXTRA_BARS
    if (IN(51) && hi - lo > 1) { for (int eb = 0; eb < EXTRA_BARS; ++eb) GRID_BAR(); }
#endif
    PHASE(51) {
        const f32x4* fg = (const f32x4*)AIN(48) + F.lane;
        for (int i = F.gw; i < NB * SEQ; i += F.NGW) {
            const int b = i / SEQ, t = i % SEQ; const f32x4* xr = (const f32x4*)(X + ((size_t)b * TPB + CTXL + t) * DM) + F.lane;
            f32x4 y[8]; float ss = 0.f;
#pragma unroll
            for (int j = 0; j < 8; ++j) { y[j] = xr[64 * j]; ss += (y[j].x * y[j].x + y[j].y * y[j].y) + (y[j].z * y[j].z + y[j].w * y[j].w); }
            const float rinv = rsqrtf(wave_sum(ss) * (1.0f / DM) + 1e-6f);
            f32x4* o = (f32x4*)(A.out + (size_t)i * DM) + F.lane;
#pragma unroll
            for (int j = 0; j < 8; ++j) o[64 * j] = y[j] * rinv * fg[64 * j];
        }
    }
#undef IN
#undef BOTH
#undef GRID_BAR
#undef AIN
#undef ws
#undef MODS
#undef TW
#undef HIDA
#undef ADAP
#undef X
#undef NBF
#undef ACT
#undef mix
#undef PART
}

#ifndef MK_PER_PHASE
#define MK_PER_PHASE 0
#endif
extern "C" void kernel_launch(void* const* d_in, const int* in_sizes, int n_in, void* d_out, int out_size, void* d_ws, size_t ws_size, hipStream_t stream) {
    static int grid = 0;
    if (grid == 0) {
        if (n_in != 49 || ws_size < WS_END) { fprintf(stderr, "kernel_launch: expected 49 inputs and >= %zu bytes of workspace; got %d, %zu\n", (size_t)WS_END, n_in, ws_size); grid = -1; return; }
        int dev = 0, cus = 0;
        if (hipGetDevice(&dev) != hipSuccess || hipDeviceGetAttribute(&cus, hipDeviceAttributeMultiprocessorCount, dev) != hipSuccess) { grid = -1; return; }
        if (hipFuncSetAttribute((const void*)fwd_kernel, hipFuncAttributeMaxDynamicSharedMemorySize, LDS_BYTES) != hipSuccess) { fprintf(stderr, "kernel_launch: hipFuncSetAttribute failed\n"); grid = -1; return; }
        int per_cu = 0;
        if (hipOccupancyMaxActiveBlocksPerMultiprocessor(&per_cu, (const void*)fwd_kernel, NTHR, LDS_BYTES) != hipSuccess || per_cu < 1) fprintf(stderr, "kernel_launch: occupancy query reports %d\n", per_cu);
        (void)hipGetLastError();
        grid = cus;
    }
    if (grid < 0) return;
    (void)hipMemsetAsync((char*)d_ws + WS_CTL, 0, CTL_ZERO_BYTES, stream);
    Args a{};
    for (int i = 0; i < 49; ++i) a.in[i] = (const float*)d_in[i];
    a.out = (float*)d_out; a.ws = (unsigned char*)d_ws;
#if MK_PER_PHASE
    for (int p = 0; p < N_PHASES; ++p) { a.ph_lo = p; a.ph_hi = p + 1; hipLaunchKernelGGL(fwd_kernel, dim3(grid), dim3(NTHR), LDS_BYTES, stream, a); }
#elif defined(PROBE_PHASES)
    { const int pp[] = {PROBE_PHASES}; const int np = (int)(sizeof(pp) / sizeof(int)); int cur = 0, li = 0;
      for (int i = 0; i < np; ++i) { if (pp[i] > cur) { a.ph_lo = cur; a.ph_hi = pp[i]; a.li = li++; a.pad = 0; hipLaunchKernelGGL(fwd_kernel, dim3(grid), dim3(NTHR), LDS_BYTES, stream, a); }
          a.ph_lo = pp[i]; a.ph_hi = pp[i] + 1; a.li = li++; a.pad = 1; hipLaunchKernelGGL(fwd_kernel, dim3(grid), dim3(NTHR), LDS_BYTES, stream, a); cur = pp[i]; }
      a.ph_lo = cur; a.ph_hi = N_PHASES; a.li = li++; a.pad = 0; hipLaunchKernelGGL(fwd_kernel, dim3(grid), dim3(NTHR), LDS_BYTES, stream, a); }
#else
    a.ph_lo = 0; a.ph_hi = N_PHASES; a.li = 0; hipLaunchKernelGGL(fwd_kernel, dim3(grid), dim3(NTHR), LDS_BYTES, stream, a);
#endif
}
```

```cpp
#include <hip/hip_runtime.h>
#include <stdint.h>
#include <stdio.h>

#define LAS __attribute__((address_space(3)))
typedef unsigned short bf16_t;
typedef short bf16x8 __attribute__((ext_vector_type(8)));
typedef short s16x4 __attribute__((ext_vector_type(4)));
typedef float f32x2 __attribute__((ext_vector_type(2)));
typedef float f32x4 __attribute__((ext_vector_type(4)));
typedef float f32x16 __attribute__((ext_vector_type(16)));
typedef unsigned u32x2 __attribute__((ext_vector_type(2)));
typedef unsigned u32x4 __attribute__((ext_vector_type(4)));

constexpr int DM = 2048, NB = 2, SEQ = 4096, CTXL = 256, TPB = SEQ + CTXL  , ROWS = NB * TPB  ;
constexpr int NPAN = ROWS / 256  , PPB = TPB / 256  ;
constexpr int FF = 5632, NMOD = 9, NADA = NMOD * DM  ;
constexpr int NWAVES = 8, NTHR = 512;

__device__ __forceinline__ unsigned cvt_pk_bf16(float lo, float hi) { unsigned r; asm("v_cvt_pk_bf16_f32 %0, %1, %2" : "=v"(r) : "v"(lo), "v"(hi)); return r; }
__device__ __forceinline__ float bf2f(unsigned short b) { return __uint_as_float(((unsigned)b) << 16); }
__device__ __forceinline__ f32x4 ld4bf(const bf16_t* p) {
    const u32x2 w = *(const u32x2*)p; return (f32x4){__uint_as_float(w.x << 16), __uint_as_float(w.x & 0xffff0000u), __uint_as_float(w.y << 16), __uint_as_float(w.y & 0xffff0000u)}; }
__device__ __forceinline__ void ld8bf(const bf16_t* p, f32x4& a, f32x4& b) {
    const u32x4 w = *(const u32x4*)p;
    a = (f32x4){__uint_as_float(w.x << 16), __uint_as_float(w.x & 0xffff0000u), __uint_as_float(w.y << 16), __uint_as_float(w.y & 0xffff0000u)};
    b = (f32x4){__uint_as_float(w.z << 16), __uint_as_float(w.z & 0xffff0000u), __uint_as_float(w.w << 16), __uint_as_float(w.w & 0xffff0000u)}; }
__device__ __forceinline__ void st8bf(bf16_t* p, f32x4 a, f32x4 b) { u32x4 w; w.x = cvt_pk_bf16(a.x, a.y); w.y = cvt_pk_bf16(a.z, a.w); w.z = cvt_pk_bf16(b.x, b.y); w.w = cvt_pk_bf16(b.z, b.w); *(u32x4*)p = w; }
__device__ __forceinline__ float wave_sum(float v) {
#pragma unroll
    for (int o = 1; o < 64; o <<= 1) v += __shfl_xor(v, o);
    return v;
}
__device__ __forceinline__ float fast_sigmoid(float x) { return __builtin_amdgcn_rcpf(1.0f + __expf(-x)); }
#define LDS_WAIT() asm volatile("s_waitcnt lgkmcnt(0)" ::: "memory")
#define VM_WAIT() asm volatile("s_waitcnt vmcnt(0)" ::: "memory")

#define XB_TMO      128
#define XB_XCNT(j)  (256  + 64 * (j))
#define XB_XSUB(j)  (1280 + 64 * (j))
#define XB_XGEN(j)  (2304 + 64 * (j))
#define XB_TOP      3328
#define XB_TOPGEN   3392
#define XCD_BAR_WORDS 3456
#define XB_SPIN_CAP (1u << 18)
__device__ __forceinline__ unsigned xb_ld(unsigned* p)              { return __hip_atomic_load(p, __ATOMIC_RELAXED, __HIP_MEMORY_SCOPE_AGENT); }
__device__ __forceinline__ unsigned xb_add(unsigned* p, unsigned v) { return __hip_atomic_fetch_add(p, v, __ATOMIC_RELAXED, __HIP_MEMORY_SCOPE_AGENT); }
__device__ __forceinline__ unsigned xb_xcc_id() { return (unsigned)__builtin_amdgcn_s_getreg((3 << 11) | 20) & 0xFu; }
#define XB_SPIN(cond, bar) do { unsigned _sp = 0; while (cond) { __builtin_amdgcn_s_sleep(1); \
    if ((++_sp & 255u) == 0u) { if (xb_ld(&(bar)[XB_TMO])) break; if (_sp > XB_SPIN_CAP) { atomicAdd(&(bar)[XB_TMO], 1u); break; } } } } while (0)
struct XcdBarrier { unsigned* bar; unsigned x; volatile LAS unsigned* st; };
__device__ __forceinline__ XcdBarrier xcd_barrier_post(unsigned* bar, volatile LAS unsigned* st) {
    XcdBarrier b; b.bar = bar; b.x = xb_xcc_id(); b.st = st;
    if (threadIdx.x == 0) (void)xb_add(&bar[XB_XCNT(b.x)], 1u);
    return b;
}
__device__ __forceinline__ void xcd_barrier_complete(unsigned* bar, unsigned x, unsigned& nloc, unsigned& nx) {
    const unsigned G = gridDim.x * gridDim.y * gridDim.z;
    unsigned sum, cnt, mine, sp = 0u;
    for (;;) {
        sum = 0u; cnt = 0u; mine = 0u;
#pragma unroll
        for (unsigned j = 0; j < 16; ++j) { const unsigned c = xb_ld(&bar[XB_XCNT(j)]); sum += c; cnt += (c > 0u) ? 1u : 0u; mine = (j == x) ? c : mine; }
        if (sum == G) break;
        __builtin_amdgcn_s_sleep(1);
        if ((++sp & 255u) == 0u) { if (xb_ld(&bar[XB_TMO])) break; if (sp > XB_SPIN_CAP) { atomicAdd(&bar[XB_TMO], 1u); break; } }
    }
    nloc = mine > 0u ? mine : 1u; nx = cnt > 0u ? cnt : 1u;
}
__device__ __forceinline__ void xcd_barrier(const XcdBarrier& b) {
    asm volatile("s_waitcnt vmcnt(0)" ::: "memory");
    __syncthreads();
    if (threadIdx.x == 0) {
        unsigned* bar = b.bar;
        __builtin_amdgcn_s_waitcnt(0);
        unsigned nloc = b.st[0], nx = b.st[1];
        if (nloc == 0u) { xcd_barrier_complete(bar, b.x, nloc, nx); b.st[0] = nloc; b.st[1] = nx; }
        const unsigned old = xb_add(&bar[XB_XSUB(b.x)], 1u);
        const unsigned gen = old / nloc;
        if (old + 1u == (gen + 1u) * nloc) {
            __builtin_amdgcn_fence(__ATOMIC_RELEASE, "agent");
            asm volatile("s_waitcnt vmcnt(0)" ::: "memory");
            const unsigned og = xb_add(&bar[XB_TOP], 1u);
            const unsigned tg = og / nx;
            if (og + 1u == (tg + 1u) * nx) xb_add(&bar[XB_TOPGEN], 1u);
            else XB_SPIN(xb_ld(&bar[XB_TOPGEN]) == tg, bar);
            __builtin_amdgcn_fence(__ATOMIC_ACQUIRE, "agent");
            xb_add(&bar[XB_XGEN(b.x)], 1u);
            asm volatile("s_waitcnt vmcnt(0)" ::: "memory");
        } else {
            XB_SPIN(xb_ld(&bar[XB_XGEN(b.x)]) == gen, bar);
            __builtin_amdgcn_fence(__ATOMIC_ACQUIRE, "agent");
            asm volatile("s_waitcnt vmcnt(0)" ::: "memory");
        }
    }
    __syncthreads();
}

namespace pg8 {
constexpr int BM = 256, BK = 64, HALF = 128, HTB = HALF * BK * 2, STAGE_BYTES = 8 * HTB, NXCD = 8;
__host__ __device__ __forceinline__ int lds_byte(int r, int c) { const int st = (r >> 4) * 2 + (c >> 5), rr = r & 15, cc = c & 31, ob = rr * 64 + cc * 2; return st * 1024 + (ob ^ (((ob >> 9) & 1) << 5)); }
__host__ __device__ __forceinline__ void stage_rc(int b, int& R, int& C) { const int st = b / 1024, sb = b % 1024, swz = sb ^ (((sb >> 9) & 1) << 5); R = (st >> 1) * 16 + swz / 64; C = (st & 1) * 32 + (swz % 64) / 2; }
__host__ __device__ __forceinline__ int perm32(int rho) { const int n = rho >> 4, i = rho & 15; return 8 * (i >> 2) + 4 * n + (i & 3); }

struct Unit { int pm, pn, g, lm, ln, ks, ksub; };
struct Gemm { const bf16_t* A; const bf16_t* Bt; int K; };

template <int WGM_, int... V>
struct TSched {
    static constexpr int NG = sizeof...(V) / 6, WGM = WGM_;
    int G, c;
    __device__ __forceinline__ void init(int G_, int c_) { G = G_; c = c_; }
    __device__ __forceinline__ bool next(int i, Unit& u) const {
        constexpr int v[sizeof...(V)] = {V...};
        const int L = i * G + c;
        int g = 0, b = 0, nM = 1, nN = 1, pm0 = 0, pn0 = 0, ks = 1, rm = 0, base = 0;
#pragma unroll
        for (int k = 0; k < NG; ++k) { if (L >= base) { g = k; b = base; nM = v[6 * k]; nN = v[6 * k + 1]; pm0 = v[6 * k + 2]; pn0 = v[6 * k + 3]; ks = v[6 * k + 4]; rm = v[6 * k + 5]; } base += v[6 * k] * v[6 * k + 1] * v[6 * k + 4]; }
        if (L >= base) return false;
        const int nwg = nM * nN; const int lloc = L - b; int wgid = lloc / ks; const int ksub = lloc - wgid * ks;
        { const int q = nwg / NXCD, r = nwg % NXCD, xcd = wgid % NXCD, off = wgid / NXCD; wgid = (xcd < r ? xcd * (q + 1) : r * (q + 1) + (xcd - r) * q) + off; }
        const int nig = WGM * nN, gid = wgid / nig, fm = gid * WGM, gsz = (nM - fm) < WGM ? (nM - fm) : WGM;
        int lm = fm + ((wgid % nig) % gsz); const int ln = (wgid % nig) / gsz;
        if (rm == 1) lm = lm + 1 + (lm >= 16 ? 1 : 0);
        if (rm == 2) lm = lm * PPB;
        u.g = g; u.lm = lm; u.ln = ln; u.pm = pm0 + lm; u.pn = pn0 + ln; u.ks = ks; u.ksub = ksub; return true;
    }
};

template <class Epi, class Sched>
__device__ __forceinline__ void gemm_phase(LAS unsigned char* lds, const Gemm g, const Sched& S, const Epi& E) {
    const int tid = threadIdx.x, wid = __builtin_amdgcn_readfirstlane(tid >> 6), lane = tid & 63, wr = wid >> 2, wc = wid & 3, fr = lane & 15, fq = lane >> 4;
    const int K = g.K, ntf = K / BK;
    unsigned voffA[2], voffB[2];
#pragma unroll
    for (int i = 0; i < 2; ++i) { int R, C; stage_rc(tid * 16 + i * 8192, R, C); const int Rb = (R & ~31) + perm32(R & 31);
        voffA[i] = (unsigned)(R * K + C) * 2u; voffB[i] = (unsigned)(Rb * K + C) * 2u; }
    const size_t kstep = (size_t)(BK * 2);
    const size_t hstep = (size_t)HALF * K * 2;
    const size_t tstep = 2 * hstep;
    const unsigned ldsw = (unsigned)wid * 1024u;
    const int aoff = lds_byte(wr * 64 + fr, fq * 8), boff = lds_byte(wc * 32 + fr, fq * 8);
#define PG8_SA(b, h) (((b) * 2 + (h)) * HTB)
#define PG8_SB(b, h) ((4 + (b) * 2 + (h)) * HTB)
#define PG8_STAGE(bufoff, gbase, voff) do { _Pragma("unroll") for (int _i = 0; _i < 2; ++_i) \
        __builtin_amdgcn_global_load_lds((const unsigned*)((const char*)(gbase) + (voff)[_i]), (LAS unsigned*)(lds + (bufoff) + ldsw + _i * 8192), 16, 0, 0); } while (0)
#define PG8_LDA(dst, b, h) do { _Pragma("unroll") for (int m = 0; m < 4; ++m) _Pragma("unroll") for (int k = 0; k < 2; ++k) dst[m][k] = *(const LAS bf16x8*)(lds + PG8_SA(b, h) + aoff + m * 2048 + k * 1024); } while (0)
#define PG8_LDB(dst, b, h) do { _Pragma("unroll") for (int n = 0; n < 2; ++n) _Pragma("unroll") for (int k = 0; k < 2; ++k) dst[n][k] = *(const LAS bf16x8*)(lds + PG8_SB(b, h) + boff + n * 2048 + k * 1024); } while (0)
#define PG8_MMA(ai, bj, At, Bt) do { __builtin_amdgcn_s_setprio(1); _Pragma("unroll") for (int m = 0; m < 4; ++m) _Pragma("unroll") for (int n = 0; n < 2; ++n) _Pragma("unroll") for (int k = 0; k < 2; ++k) \
        acc[ai][bj][m][n] = __builtin_amdgcn_mfma_f32_16x16x32_bf16(Bt[n][k], At[m][k], acc[ai][bj][m][n], 0, 0, 0); __builtin_amdgcn_s_setprio(0); } while (0)
#define PG8_WAIT_V(n) asm volatile("s_waitcnt vmcnt(" #n ")" ::: "memory")
#define PG8_WAIT_L(n) asm volatile("s_waitcnt lgkmcnt(" #n ")" ::: "memory")
#define PG8_BAR __builtin_amdgcn_s_barrier()
#define PG8_SCHED __builtin_amdgcn_sched_barrier(0)
    Unit cur, nxt; int ui = 0;
    if (!S.next(0, cur)) return;
    f32x4 acc[2][2][4][2];
#pragma unroll
    for (int a = 0; a < 2; ++a)
#pragma unroll
        for (int b = 0; b < 2; ++b)
#pragma unroll
            for (int m = 0; m < 4; ++m)
#pragma unroll
                for (int n = 0; n < 2; ++n) acc[a][b][m][n] = (f32x4){0.f, 0.f, 0.f, 0.f};
    bf16x8 At[4][2], B0[2][2], B1[2][2];
    int nt = ntf / cur.ks;
    const char* cA = (const char*)g.A + (size_t)cur.pm * tstep + (size_t)(cur.ksub * nt) * kstep; const char* cB = (const char*)g.Bt + (size_t)cur.pn * tstep + (size_t)(cur.ksub * nt) * kstep;
    PG8_STAGE(PG8_SB(0, 0), cB, voffB); PG8_STAGE(PG8_SA(0, 0), cA, voffA); PG8_STAGE(PG8_SB(0, 1), cB + hstep, voffB); PG8_STAGE(PG8_SA(0, 1), cA + hstep, voffA);
    if (wr == 1) PG8_BAR;
    PG8_WAIT_V(4); PG8_BAR;
    PG8_STAGE(PG8_SB(1, 0), cB + kstep, voffB); PG8_STAGE(PG8_SA(1, 0), cA + kstep, voffA); PG8_STAGE(PG8_SB(1, 1), cB + hstep + kstep, voffB);
    PG8_WAIT_V(6); PG8_BAR;
    for (;;) {
        const bool has_next = S.next(ui + 1, nxt);
        const int nnt = has_next ? ntf / nxt.ks : nt; const size_t nko = has_next ? (size_t)(nxt.ksub * nnt) * kstep : 0;
        const char* nA = has_next ? (const char*)g.A + (size_t)nxt.pm * tstep + nko : cA; const char* nB = has_next ? (const char*)g.Bt + (size_t)nxt.pn * tstep + nko : cB;
        for (int t = 0; t < nt; t += 2) {
            const bool last = (t == nt - 2);
            const char* a1 = cA + (size_t)(t + 1) * kstep;
            const char* a2 = last ? nA : cA + (size_t)(t + 2) * kstep; const char* b2 = last ? nB : cB + (size_t)(t + 2) * kstep;
            const char* a3 = a2 + kstep; const char* b3 = b2 + kstep;
            PG8_LDB(B0, 0, 0); PG8_SCHED; PG8_LDA(At, 0, 0); PG8_STAGE(PG8_SA(1, 1), a1 + hstep, voffA);
            PG8_WAIT_L(8); PG8_BAR; PG8_WAIT_L(0); PG8_MMA(0, 0, At, B0); PG8_BAR; PG8_SCHED;
            PG8_LDB(B1, 0, 1); PG8_STAGE(PG8_SB(0, 0), b2, voffB);
            PG8_BAR; PG8_WAIT_L(0); PG8_MMA(0, 1, At, B1); PG8_BAR;
            PG8_LDA(At, 0, 1); PG8_STAGE(PG8_SA(0, 0), a2, voffA);
            PG8_BAR; PG8_WAIT_L(0); PG8_MMA(1, 0, At, B0); PG8_BAR; PG8_SCHED;
            PG8_STAGE(PG8_SB(0, 1), b2 + hstep, voffB);
            PG8_WAIT_V(6); PG8_BAR; PG8_MMA(1, 1, At, B1); PG8_BAR;
            PG8_LDB(B0, 1, 0); PG8_SCHED; PG8_LDA(At, 1, 0); PG8_STAGE(PG8_SA(0, 1), a2 + hstep, voffA);
            PG8_WAIT_L(8); PG8_BAR; PG8_WAIT_L(0); PG8_MMA(0, 0, At, B0); PG8_BAR; PG8_SCHED;
            PG8_LDB(B1, 1, 1); PG8_STAGE(PG8_SB(1, 0), b3, voffB);
            PG8_BAR; PG8_WAIT_L(0); PG8_MMA(0, 1, At, B1); PG8_BAR;
            PG8_LDA(At, 1, 1); PG8_STAGE(PG8_SA(1, 0), a3, voffA);
            PG8_BAR; PG8_WAIT_L(0); PG8_MMA(1, 0, At, B0); PG8_BAR; PG8_SCHED;
            PG8_STAGE(PG8_SB(1, 1), b3 + hstep, voffB);
            PG8_WAIT_V(6); PG8_BAR; PG8_MMA(1, 1, At, B1); PG8_BAR;
        }
        E(acc, cur, wr, wc, fr, fq);
        if (!has_next) break;
#pragma unroll
        for (int a = 0; a < 2; ++a)
#pragma unroll
            for (int b = 0; b < 2; ++b)
#pragma unroll
                for (int m = 0; m < 4; ++m)
#pragma unroll
                    for (int n = 0; n < 2; ++n) acc[a][b][m][n] = (f32x4){0.f, 0.f, 0.f, 0.f};
        cur = nxt; cA = nA; cB = nB; nt = nnt; ++ui;
    }
    PG8_WAIT_V(0);
    if (wr == 0) PG8_BAR;
    PG8_BAR;
#undef PG8_SA
#undef PG8_SB
#undef PG8_STAGE
#undef PG8_LDA
#undef PG8_LDB
#undef PG8_MMA
#undef PG8_WAIT_V
#undef PG8_WAIT_L
#undef PG8_BAR
#undef PG8_SCHED
}
}
constexpr size_t MiB = 1u << 20;
constexpr size_t WS_CTL = 0, CTL_ZERO_BYTES = 1 * MiB;
constexpr int CW_BAR = 4096;
constexpr size_t WS_MODS = 1 * MiB;
constexpr size_t WS_TW = 2 * MiB;
constexpr size_t WS_HIDA = 3 * MiB;
constexpr size_t WS_ADAP = 6 * MiB;
constexpr size_t WS_X = 22 * MiB;
constexpr size_t WS_NB = 90 * MiB;
constexpr size_t WS_ACT = 124 * MiB;
constexpr size_t WS_W = 218 * MiB;
constexpr size_t WS_MIX = WS_W + 648 * MiB;
constexpr size_t WS_PART = WS_MIX + 900 * MiB;
constexpr size_t WS_END = WS_PART + 52 * MiB;
__host__ __device__ constexpr size_t W_GU(int l, int h) { return (size_t)(l * 132 + h * 44) * MiB; }
__host__ __device__ constexpr size_t W_DN(int l, int h) { return (size_t)(l * 132 + 88 + h * 22) * MiB; }
constexpr size_t W_HY_IN = 528 * MiB, W_HY_OUT = 552 * MiB, W_HY_F3 = 560 * MiB, W_RW_BT1 = 564 * MiB, W_RW_BT2 = 591 * MiB, W_RW_WO = 596 * MiB,
                 W_ML_WD = 604 * MiB, W_ML_BT3 = 609 * MiB, W_ML_WO = 616 * MiB, W_GQ_QKV = 624 * MiB, W_GQ_WO = 640 * MiB;
constexpr size_t HY_U = 0, HY_VXT = 204 * MiB, HY_HFT = 408 * MiB  ;
constexpr size_t RW_XS = 0, RW_Y = 0  , RW_KK = 136 * MiB, RW_HLF = 204 * MiB, RW_RKV = 272 * MiB, RW_LM = 476 * MiB, RW_DEC = 492 * MiB,
                 RW_ASIG = 628 * MiB, RW_G = 764 * MiB;
constexpr size_t ML_RAW = 0, ML_CN = 43 * MiB, ML_QRAW = 60 * MiB, ML_Q = 162 * MiB, ML_K = 213 * MiB, ML_V = 264 * MiB;
constexpr size_t GQ_RAW = 0, GQ_Q = 136 * MiB, GQ_K = 170 * MiB, GQ_V = 187 * MiB;
constexpr int LDS_BYTES = 147456, MISC_OFF = 131072 + 8192;

namespace pg8 {
#define EPI_ARGS const f32x4 (&acc)[2][2][4][2], const Unit& u, int wr, int wc, int fr, int fq
struct EpiSwiglu {
    bf16_t* act;
    __device__ __forceinline__ void operator()(EPI_ARGS) const {
        const int row0 = u.lm * BM + wr * 64 + fr, col0 = u.ln * 128 + wc * 32 + 8 * fq;
#pragma unroll
        for (int ai = 0; ai < 2; ++ai)
#pragma unroll
            for (int m = 0; m < 4; ++m) {
                float v[8];
#pragma unroll
                for (int n = 0; n < 2; ++n)
#pragma unroll
                    for (int j = 0; j < 4; ++j) { const float a = acc[ai][0][m][n][j], b = acc[ai][1][m][n][j]; v[n * 4 + j] = a * fast_sigmoid(a) * b; }
                u32x4 w; w.x = cvt_pk_bf16(v[0], v[1]); w.y = cvt_pk_bf16(v[2], v[3]); w.z = cvt_pk_bf16(v[4], v[5]); w.w = cvt_pk_bf16(v[6], v[7]);
                __builtin_nontemporal_store(w, (u32x4*)(act + (size_t)(row0 + ai * HALF + m * 16) * FF + col0));
            }
    }
};
struct EpiResid {
    bf16_t* X; const float* mods_l; int gidx; float sc; const float* bias; static constexpr size_t PART_OFF = WS_PART - WS_X;
    __device__ __forceinline__ void operator()(EPI_ARGS) const {
        const int row0 = u.lm * BM + wr * 64 + fr;
        const int rt = (u.lm % PPB == 0) ? 2 : u.lm / PPB;
        const float* gate = mods_l + (size_t)(rt * NMOD + gidx) * DM;
#pragma unroll
        for (int bj = 0; bj < 2; ++bj) {
            const int col = u.ln * BM + bj * HALF + wc * 32 + 8 * fq;
            f32x4 g0 = *(const f32x4*)(gate + col) * sc, g1 = *(const f32x4*)(gate + col + 4) * sc;
            f32x4 b0 = (f32x4){0.f, 0.f, 0.f, 0.f}, b1 = b0;
            if (bias && u.ksub == 0) { b0 = *(const f32x4*)(bias + col); b1 = *(const f32x4*)(bias + col + 4); }
#pragma unroll
            for (int ai = 0; ai < 2; ++ai) {
#pragma unroll
                for (int m = 0; m < 4; ++m) {
                    if (u.ks == 1) {
                        bf16_t* p = X + (size_t)(row0 + ai * HALF + m * 16) * DM + col;
                        f32x4 x0, x1; ld8bf(p, x0, x1);
                        x0 += g0 * (acc[ai][bj][m][0] + b0); x1 += g1 * (acc[ai][bj][m][1] + b1);
                        st8bf(p, x0, x1);
                    } else {
                        const int cr = (u.lm / PPB) * CTXL + wr * 64 + fr + ai * HALF + m * 16;
                        bf16_t* q = (bf16_t*)((char*)X + PART_OFF) + ((size_t)u.ksub * (NB * CTXL) + cr) * DM + col;
                        st8bf(q, g0 * (acc[ai][bj][m][0] + b0), g1 * (acc[ai][bj][m][1] + b1));
                    }
                }
                asm volatile("" ::: "memory");
            }
        }
    }
};
struct EpiF32 {
    float* C; int ldc; const float* bias;
    __device__ __forceinline__ void operator()(EPI_ARGS) const {
        const int row0 = u.lm * BM + wr * 64 + fr;
#pragma unroll
        for (int bj = 0; bj < 2; ++bj) {
            const int col = u.ln * BM + bj * HALF + wc * 32 + 8 * fq;
            f32x4 b0 = (f32x4){0.f, 0.f, 0.f, 0.f}, b1 = b0;
            if (bias) { b0 = *(const f32x4*)(bias + col); b1 = *(const f32x4*)(bias + col + 4); }
#pragma unroll
            for (int ai = 0; ai < 2; ++ai)
#pragma unroll
                for (int m = 0; m < 4; ++m) {
                    float* p = C + (size_t)(row0 + ai * HALF + m * 16) * ldc + col;
                    *(f32x4*)p = acc[ai][bj][m][0] + b0; *(f32x4*)(p + 4) = acc[ai][bj][m][1] + b1;
                }
        }
    }
};
template <long SL_OFF, int SL_LD, int SL_COL0>
struct EpiF32S {
    float* C; int ldc; const float* bias;
    __device__ __forceinline__ void operator()(EPI_ARGS) const {
        const int row0 = u.lm * BM + wr * 64 + fr;
#pragma unroll
        for (int bj = 0; bj < 2; ++bj) {
            const int col = u.ln * BM + bj * HALF + wc * 32 + 8 * fq;
            f32x4 b0 = (f32x4){0.f, 0.f, 0.f, 0.f}, b1 = b0;
            if (bias && u.ksub == 0) { b0 = *(const f32x4*)(bias + col); b1 = *(const f32x4*)(bias + col + 4); }
#pragma unroll
            for (int ai = 0; ai < 2; ++ai)
#pragma unroll
                for (int m = 0; m < 4; ++m) {
                    float* p;
                    if (u.ks == 1) p = C + (size_t)(row0 + ai * HALF + m * 16) * ldc + col;
                    else { const int cr = (u.lm / PPB) * CTXL + wr * 64 + fr + ai * HALF + m * 16; p = C + SL_OFF + ((size_t)u.ksub * (NB * CTXL) + cr) * SL_LD + (col - SL_COL0); }
                    *(f32x4*)p = acc[ai][bj][m][0] + b0; *(f32x4*)(p + 4) = acc[ai][bj][m][1] + b1;
                }
        }
    }
};
struct EpiBf16B {
    bf16_t* C; int ldc; const float* bias;
    __device__ __forceinline__ void operator()(EPI_ARGS) const {
        const int row0 = u.lm * BM + wr * 64 + fr;
#pragma unroll
        for (int bj = 0; bj < 2; ++bj) {
            const int col = u.ln * BM + bj * HALF + wc * 32 + 8 * fq;
            f32x4 b0 = (f32x4){0.f, 0.f, 0.f, 0.f}, b1 = b0;
            if (bias) { b0 = *(const f32x4*)(bias + col); b1 = *(const f32x4*)(bias + col + 4); }
#pragma unroll
            for (int ai = 0; ai < 2; ++ai)
#pragma unroll
                for (int m = 0; m < 4; ++m) {
                    const f32x4 v0 = acc[ai][bj][m][0] + b0, v1 = acc[ai][bj][m][1] + b1;
                    u32x4 w; w.x = cvt_pk_bf16(v0[0], v0[1]); w.y = cvt_pk_bf16(v0[2], v0[3]); w.z = cvt_pk_bf16(v1[0], v1[1]); w.w = cvt_pk_bf16(v1[2], v1[3]);
                    *(u32x4*)(C + (size_t)(row0 + ai * HALF + m * 16) * ldc + col) = w;
                }
        }
    }
};
struct EpiRw1 {
    bf16_t* rkv; bf16_t* lm;
    __device__ __forceinline__ void operator()(EPI_ARGS) const {
        const int row0 = u.lm * BM + wr * 64 + fr;
        if (u.g < 3) {
            bf16_t* C = rkv + (size_t)u.g * ROWS * DM;
#pragma unroll
            for (int bj = 0; bj < 2; ++bj) {
                const int col = u.ln * BM + bj * HALF + wc * 32 + 8 * fq;
#pragma unroll
                for (int ai = 0; ai < 2; ++ai)
#pragma unroll
                    for (int m = 0; m < 4; ++m) {
                        const f32x4 v0 = acc[ai][bj][m][0], v1 = acc[ai][bj][m][1];
                        u32x4 w; w.x = cvt_pk_bf16(v0[0], v0[1]); w.y = cvt_pk_bf16(v0[2], v0[3]); w.z = cvt_pk_bf16(v1[0], v1[1]); w.w = cvt_pk_bf16(v1[2], v1[3]);
                        *(u32x4*)(C + (size_t)(row0 + ai * HALF + m * 16) * DM + col) = w;
                    }
            }
        } else {
            bf16_t* O = lm + (size_t)(u.g - 3) * ROWS * 256;
            const int mode = u.g - 3;
#pragma unroll
            for (int bj = 0; bj < 2; ++bj) {
                const int col = bj * HALF + wc * 32 + 8 * fq;
#pragma unroll
                for (int ai = 0; ai < 2; ++ai)
#pragma unroll
                    for (int m = 0; m < 4; ++m) {
                        float v[8];
#pragma unroll
                        for (int n = 0; n < 2; ++n)
#pragma unroll
                            for (int j = 0; j < 4; ++j) { const float a = acc[ai][bj][m][n][j]; v[n * 4 + j] = (mode == 0) ? (1.0f - 2.0f * __builtin_amdgcn_rcpf(1.0f + __expf(2.0f * a))) : ((mode == 1) ? a : fast_sigmoid(a)); }
                        u32x4 w; w.x = cvt_pk_bf16(v[0], v[1]); w.y = cvt_pk_bf16(v[2], v[3]); w.z = cvt_pk_bf16(v[4], v[5]); w.w = cvt_pk_bf16(v[6], v[7]);
                        *(u32x4*)(O + (size_t)(row0 + ai * HALF + m * 16) * 256 + col) = w;
                    }
            }
        }
    }
};
struct EpiRw2 {
    bf16_t* dec; bf16_t* asig; bf16_t* gg; const float* w0; const float* a0;
    __device__ __forceinline__ void operator()(EPI_ARGS) const {
        const int row0 = u.lm * BM + wr * 64 + fr;
        const float* addv = (u.g == 0) ? w0 : a0;
#pragma unroll
        for (int bj = 0; bj < 2; ++bj) {
            const int col = u.ln * BM + bj * HALF + wc * 32 + 8 * fq;
            f32x4 b0 = (f32x4){0.f, 0.f, 0.f, 0.f}, b1 = b0;
            if (u.g < 2) { b0 = *(const f32x4*)(addv + col); b1 = *(const f32x4*)(addv + col + 4); }
#pragma unroll
            for (int ai = 0; ai < 2; ++ai)
#pragma unroll
                for (int m = 0; m < 4; ++m) {
                    f32x4 v0 = acc[ai][bj][m][0] + b0, v1 = acc[ai][bj][m][1] + b1;
                    if (u.g < 2) {
#pragma unroll
                        for (int j = 0; j < 4; ++j) {
                            float s0 = fast_sigmoid(v0[j]), s1 = fast_sigmoid(v1[j]);
                            if (u.g == 0) { s0 = s0 * 0.8750387749145276f; s1 = s1 * 0.8750387749145276f; }
                            v0[j] = s0; v1[j] = s1;
                        }
                    }
                    const size_t r = (size_t)(row0 + ai * HALF + m * 16);
                    { u32x4 w; w.x = cvt_pk_bf16(v0[0], v0[1]); w.y = cvt_pk_bf16(v0[2], v0[3]); w.z = cvt_pk_bf16(v1[0], v1[1]); w.w = cvt_pk_bf16(v1[2], v1[3]);
                        *(u32x4*)((u.g == 0 ? dec + r * (2 * DM) : (u.g == 1 ? asig + r * (2 * DM) : gg + r * DM)) + col) = w; }
                    asm volatile("" ::: "memory");
                }
        }
    }
};
struct EpiMla3 {
    bf16_t* qraw; bf16_t* Kb; bf16_t* Vb;
    __device__ __forceinline__ void operator()(EPI_ARGS) const {
        const int row0 = u.lm * BM + wr * 64 + fr;
        if (u.g == 0) {
#pragma unroll
            for (int bj = 0; bj < 2; ++bj) {
                const int col = u.ln * BM + bj * HALF + wc * 32 + 8 * fq;
#pragma unroll
                for (int ai = 0; ai < 2; ++ai)
#pragma unroll
                    for (int m = 0; m < 4; ++m) {
                        const f32x4 v0 = acc[ai][bj][m][0], v1 = acc[ai][bj][m][1];
                        u32x4 w; w.x = cvt_pk_bf16(v0[0], v0[1]); w.y = cvt_pk_bf16(v0[2], v0[3]); w.z = cvt_pk_bf16(v1[0], v1[1]); w.w = cvt_pk_bf16(v1[2], v1[3]);
                        *(u32x4*)(qraw + (size_t)(row0 + ai * HALF + m * 16) * 3072 + col) = w;
                    }
            }
        } else {
#pragma unroll
            for (int bj = 0; bj < 2; ++bj) {
                bf16_t* O = bj ? Vb : Kb; const int ld = bj ? 2048 : 3072; const int col = u.ln * (bj ? 128 : 192) + wc * 32 + 8 * fq;
#pragma unroll
                for (int ai = 0; ai < 2; ++ai)
#pragma unroll
                    for (int m = 0; m < 4; ++m) {
                        const f32x4 v0 = acc[ai][bj][m][0], v1 = acc[ai][bj][m][1];
                        u32x4 w; w.x = cvt_pk_bf16(v0[0], v0[1]); w.y = cvt_pk_bf16(v0[2], v0[3]); w.z = cvt_pk_bf16(v1[0], v1[1]); w.w = cvt_pk_bf16(v1[2], v1[3]);
                        *(u32x4*)(O + (size_t)(row0 + ai * HALF + m * 16) * ld + col) = w;
                    }
            }
        }
    }
};
#undef EPI_ARGS
}
namespace pg8 {
struct EpiHyF {
    float* hft_lat; float* hft_ctx;
    __device__ __forceinline__ void operator()(const f32x4 (&acc)[2][2][4][2], const Unit& u, int wr, int wc, int fr, int fq) const {
        const bool lat = u.lm < 16; const int L = lat ? 4096 : 256;
        float* base = (lat ? hft_lat : hft_ctx) + ((u.lm - (lat ? 0 : 16)) * BM + wr * 64 + fr);
#pragma unroll
        for (int bj = 0; bj < 2; ++bj)
#pragma unroll
            for (int n = 0; n < 2; ++n)
#pragma unroll
                for (int j = 0; j < 4; ++j) {
                    float* p = base + (size_t)(u.ln * BM + bj * HALF + wc * 32 + 8 * fq + 4 * n + j) * L;
#pragma unroll
                    for (int ai = 0; ai < 2; ++ai)
#pragma unroll
                        for (int m = 0; m < 4; ++m) p[ai * HALF + m * 16] = acc[ai][bj][m][n][j];
                    asm volatile("" ::: "memory");
                }
    }
};
}
namespace att {
constexpr int NW = 8, QBLK = 32, KVBLK = 64, DV = 128;
constexpr float THR = 8.f;
#define SBAR() __builtin_amdgcn_sched_barrier(0)
__device__ __forceinline__ int crow(int r, int hi) { return (r & 3) + 8 * (r >> 2) + 4 * hi; }
template <int SCALE_ID> struct ScaleOf;
template <> struct ScaleOf<128> { static constexpr float v = 0.088388347648318440f; };
template <> struct ScaleOf<192> { static constexpr float v = 0.072168783648703220f; };

template <int DQK>
__device__ __forceinline__ void partialSM(f32x16& p0, f32x16& p1, float& m_reg, float& mn, float& alpha) {
  constexpr float SCALE = ScaleOf<DQK>::v;
  constexpr float C = SCALE * 1.4426950408889634f;
  float pmax = p0[0];
#pragma unroll
  for (int r = 1; r < 16; ++r) pmax = fmaxf(pmax, p0[r]);
#pragma unroll
  for (int r = 0; r < 16; ++r) pmax = fmaxf(pmax, p1[r]);
  { auto rr = __builtin_amdgcn_permlane32_swap(__float_as_uint(pmax), __float_as_uint(pmax), false, false);
    pmax = fmaxf(__uint_as_float(rr[0]), __uint_as_float(rr[1])); }
  if (__builtin_expect(__all(pmax - m_reg <= THR / SCALE), 1)) { mn = m_reg; alpha = 1.f; }
  else { mn = fmaxf(m_reg, pmax); alpha = __builtin_amdgcn_exp2f((m_reg - mn) * C); m_reg = mn; }
  float mnC = -mn * C;
#pragma unroll
  for (int r = 0; r < 16; ++r) p0[r] = fmaf(p0[r], C, mnC);
#pragma unroll
  for (int r = 0; r < 16; ++r) p1[r] = fmaf(p1[r], C, mnC);
#pragma unroll
  for (int r = 0; r < 16; ++r) p0[r] = __builtin_amdgcn_exp2f(p0[r]);
}
__device__ __forceinline__ void finishSM(f32x16& p0, f32x16& p1, float alpha, float& l_reg, bf16x8& pa0, bf16x8& pa1, bf16x8& pa2, bf16x8& pa3) {
#pragma unroll
  for (int r = 0; r < 16; ++r) p1[r] = __builtin_amdgcn_exp2f(p1[r]);
  float ps = 0;
#pragma unroll
  for (int r = 0; r < 16; ++r) ps += p0[r];
#pragma unroll
  for (int r = 0; r < 16; ++r) ps += p1[r];
  { auto rr = __builtin_amdgcn_permlane32_swap(__float_as_uint(ps), __float_as_uint(ps), false, false);
    ps = __uint_as_float(rr[0]) + __uint_as_float(rr[1]); }
  l_reg = l_reg * alpha + ps;
#define PK4(P, BASE, OUT) do { unsigned a0 = cvt_pk_bf16(P[BASE + 0], P[BASE + 1]), a1 = cvt_pk_bf16(P[BASE + 2], P[BASE + 3]);   \
    unsigned b0 = cvt_pk_bf16(P[BASE + 4], P[BASE + 5]), b1 = cvt_pk_bf16(P[BASE + 6], P[BASE + 7]);                              \
    auto r0 = __builtin_amdgcn_permlane32_swap(a0, b0, false, false); auto r1 = __builtin_amdgcn_permlane32_swap(a1, b1, false, false); \
    u32x4 w = {r0[0], r1[0], r0[1], r1[1]}; OUT = *reinterpret_cast<bf16x8*>(&w); } while (0)
  PK4(p0, 0, pa0); PK4(p0, 8, pa1); PK4(p1, 0, pa2); PK4(p1, 8, pa3);
#undef PK4
}
template <int DQK>
__device__ __forceinline__ int kswz(int row, int colB) { return row * (DQK * 2) + (colB ^ ((row & 7) << 4)); }
template <int DQK>
__device__ __forceinline__ void qkt(f32x16& p0, f32x16& p1, const char* Ks, const bf16x8* qr, int r32, int hi) {
  p0 = f32x16{}; p1 = f32x16{};
#pragma unroll
  for (int d0 = 0; d0 < DQK / 16; ++d0) { int cb = (d0 * 16 + hi * 8) * 2;
    bf16x8 b0 = *reinterpret_cast<const bf16x8*>(Ks + kswz<DQK>(r32, cb));
    bf16x8 b1 = *reinterpret_cast<const bf16x8*>(Ks + kswz<DQK>(32 + r32, cb));
    p0 = __builtin_amdgcn_mfma_f32_32x32x16_bf16(b0, qr[d0], p0, 0, 0, 0);
    p1 = __builtin_amdgcn_mfma_f32_32x32x16_bf16(b1, qr[d0], p1, 0, 0, 0); }
}
template <int DQK, int NQL>
__device__ __forceinline__ void qkt_l(f32x16& p0, f32x16& p1, const char* Ks, const bf16x8* qr, const char* qls, int r32, int hi) {
  p0 = f32x16{}; p1 = f32x16{};
  constexpr int ND0 = DQK / 16;
#pragma unroll
  for (int d0 = 0; d0 < ND0; ++d0) { int cb = (d0 * 16 + hi * 8) * 2;
    bf16x8 b0 = *reinterpret_cast<const bf16x8*>(Ks + kswz<DQK>(r32, cb));
    bf16x8 b1 = *reinterpret_cast<const bf16x8*>(Ks + kswz<DQK>(32 + r32, cb));
    const bf16x8 q = (d0 < ND0 - NQL) ? qr[d0 < ND0 - NQL ? d0 : 0] : *reinterpret_cast<const bf16x8*>(qls + (d0 - (ND0 - NQL)) * 1024);
    p0 = __builtin_amdgcn_mfma_f32_32x32x16_bf16(b0, q, p0, 0, 0, 0);
    p1 = __builtin_amdgcn_mfma_f32_32x32x16_bf16(b1, q, p1, 0, 0, 0); }
}
__device__ __forceinline__ int v_st(int k, int c) { const int kk = (k & ~0xC) | ((k & 4) << 1) | ((k & 8) >> 1); return ((kk >> 3) * 4 + (c >> 5)) * 512 + ((kk & 7) * 32 + (c & 31)) * 2; }
__device__ __forceinline__ int v_rd_base(int lane) { return ((lane & 3) << 3) | (((lane >> 2) & 3) << 6) | (((lane >> 4) & 1) << 5) | (((lane >> 5) & 1) << 8); }
constexpr int v_rd_off(int d0, int ks, int half) { return d0 * 512 + ks * 4096 + half * 2048; }
template <int OFF> __device__ __forceinline__ s16x4 tr_read(int vb) {
  s16x4 r; asm volatile("ds_read_b64_tr_b16 %0, %1 offset:%2" : "=&v"(r) : "v"(vb), "i"(OFF) : "memory"); return r;
}
template <int D0> __device__ __forceinline__ void pv_one(f32x16& od, int vb, bf16x8 pa0, bf16x8 pa1, bf16x8 pa2, bf16x8 pa3) {
  const s16x4 l0 = tr_read<v_rd_off(D0, 0, 0)>(vb), h0 = tr_read<v_rd_off(D0, 0, 1)>(vb), l1 = tr_read<v_rd_off(D0, 1, 0)>(vb), h1 = tr_read<v_rd_off(D0, 1, 1)>(vb);
  const s16x4 l2 = tr_read<v_rd_off(D0, 2, 0)>(vb), h2 = tr_read<v_rd_off(D0, 2, 1)>(vb), l3 = tr_read<v_rd_off(D0, 3, 0)>(vb), h3 = tr_read<v_rd_off(D0, 3, 1)>(vb);
  asm volatile("s_waitcnt lgkmcnt(0)" ::: "memory"); SBAR();
#define PK(L, H) (bf16x8){L[0], L[1], L[2], L[3], H[0], H[1], H[2], H[3]}
  od = __builtin_amdgcn_mfma_f32_32x32x16_bf16(pa0, PK(l0, h0), od, 0, 0, 0);
  od = __builtin_amdgcn_mfma_f32_32x32x16_bf16(pa1, PK(l1, h1), od, 0, 0, 0);
  od = __builtin_amdgcn_mfma_f32_32x32x16_bf16(pa2, PK(l2, h2), od, 0, 0, 0);
  od = __builtin_amdgcn_mfma_f32_32x32x16_bf16(pa3, PK(l3, h3), od, 0, 0, 0);
#undef PK
}
__device__ __forceinline__ void pv_d0(f32x16* o, int vb, bf16x8 pa0, bf16x8 pa1, bf16x8 pa2, bf16x8 pa3) {
  pv_one<0>(o[0], vb, pa0, pa1, pa2, pa3); pv_one<1>(o[1], vb, pa0, pa1, pa2, pa3); pv_one<2>(o[2], vb, pa0, pa1, pa2, pa3); pv_one<3>(o[3], vb, pa0, pa1, pa2, pa3);
}

template <int DQK, int LDQ, int LDK, int LDV, int LDO>
__device__ __forceinline__ void attn_dense_body(const bf16_t* __restrict__ Qb, const bf16_t* __restrict__ Kh, const bf16_t* __restrict__ Vh,
                                                bf16_t* __restrict__ Ob, int seq, char* lds) {
  constexpr int SHM_V = KVBLK * DV * 2, SHM_K = KVBLK * DQK * 2, NCH = DQK / 8, KCH = NCH / 8  , ND0 = DQK / 16;
  const int tid = threadIdx.x, wid = tid >> 6, lane = tid & 63, r32 = lane & 31, hi = lane >> 5;
  char* V_lds = lds; char* K_lds = lds + 2 * SHM_V;
  float* ws = (float*)(lds + 2 * SHM_V + 2 * SHM_K) + wid * 64; float* li_l = ws; float* al_l = ws + 32;
  float m_reg = -1e30f, l_reg = 0; f32x16 o[4] = {}; bf16x8 qr[ND0];
  const bf16_t* Qw = Qb + (long)(wid * QBLK + r32) * LDQ + hi * 8;
#pragma unroll
  for (int d0 = 0; d0 < ND0; ++d0) qr[d0] = *reinterpret_cast<const bf16x8*>(Qw + d0 * 16);
  const int sr = tid >> 4, sc = (tid & 15) * 8, vst0 = v_st(sr, sc), vst1 = v_st(32 + sr, sc);
  const int vb0 = (int)(uintptr_t)V_lds + v_rd_base(lane);
  bf16x8 vs0, vs1, ks[KCH];
#define SLOAD(k0) do { vs0 = *reinterpret_cast<const bf16x8*>(&Vh[(long)((k0) + sr) * LDV + sc]); vs1 = *reinterpret_cast<const bf16x8*>(&Vh[(long)((k0) + 32 + sr) * LDV + sc]); \
    _Pragma("unroll") for (int c_ = 0; c_ < KCH; ++c_) { const int q_ = tid + 512 * c_; ks[c_] = *reinterpret_cast<const bf16x8*>(&Kh[(long)((k0) + q_ / NCH) * LDK + (q_ % NCH) * 8]); } } while (0)
#define SWRITE(b) do { *(bf16x8*)(V_lds + (b) * SHM_V + vst0) = vs0; *(bf16x8*)(V_lds + (b) * SHM_V + vst1) = vs1; \
    _Pragma("unroll") for (int c_ = 0; c_ < KCH; ++c_) { const int q_ = tid + 512 * c_; *(bf16x8*)(K_lds + (b) * SHM_K + kswz<DQK>(q_ / NCH, (q_ % NCH) * 16)) = ks[c_]; } } while (0)
  const int NT = seq / KVBLK;
  SLOAD(0); asm volatile("s_waitcnt vmcnt(0)" ::: "memory"); SWRITE(0);
  SLOAD(KVBLK);
#pragma unroll 1
  for (int j = 0; j < NT; ++j) {
    const int b = j & 1;
    __syncthreads();
    if (j + 1 < NT) { asm volatile("s_waitcnt vmcnt(0)" ::: "memory"); SWRITE(b ^ 1); if (j + 2 < NT) SLOAD((j + 2) * KVBLK); }
    f32x16 p0, p1; float mn, al; bf16x8 pa0, pa1, pa2, pa3;
    SBAR(); qkt<DQK>(p0, p1, K_lds + b * SHM_K, qr, r32, hi);
    partialSM<DQK>(p0, p1, m_reg, mn, al);
    if (__any(al < 1.f)) { if (hi == 0) al_l[r32] = al; asm volatile("s_waitcnt lgkmcnt(0)" ::: "memory");
#pragma unroll
      for (int d = 0; d < 4; ++d)
#pragma unroll
        for (int r = 0; r < 16; ++r) o[d][r] *= al_l[crow(r, hi)]; }
    finishSM(p0, p1, al, l_reg, pa0, pa1, pa2, pa3); SBAR();
    pv_d0(o, vb0 + b * (int)SHM_V, pa0, pa1, pa2, pa3);
  }
  if (hi == 0) li_l[r32] = l_reg; asm volatile("s_waitcnt lgkmcnt(0)" ::: "memory");
  __syncthreads();
  char* ot = lds + wid * 8192;
  { char* ob = ot + hi * 1024 + r32 * 2;
#pragma unroll
    for (int r = 0; r < 16; ++r) { const float rl = __builtin_amdgcn_rcpf(li_l[crow(r, hi)]);
#pragma unroll
      for (int d0 = 0; d0 < 4; ++d0) *(bf16_t*)(ob + ((r & 3) + 8 * (r >> 2)) * 256 + d0 * 64) = (bf16_t)(cvt_pk_bf16(o[d0][r] * rl, 0.f) & 0xffffu); } }
  asm volatile("s_waitcnt lgkmcnt(0)" ::: "memory");
  { bf16_t* Ow = Ob + (long)(wid * QBLK + (lane >> 4)) * LDO + (lane & 15) * 8; const char* ib = ot + (lane >> 4) * 256 + (lane & 15) * 16;
#pragma unroll
    for (int k = 0; k < 8; ++k) *(u32x4*)(Ow + (long)(k * 4) * LDO) = *(const u32x4*)(ib + k * 1024); }
  asm volatile("s_waitcnt lgkmcnt(0)" ::: "memory");
#undef SLOAD
#undef SWRITE
}

template <int DQK, int LDQ, int LDK, int LDV, int LDO, int NQL>
__device__ __forceinline__ void attn_dense_body2(const bf16_t* __restrict__ Qb, const bf16_t* __restrict__ Kh, const bf16_t* __restrict__ Vh,
                                                 bf16_t* __restrict__ Ob, int seq, char* lds) {
  constexpr int SHM_V = KVBLK * DV * 2, SHM_K = KVBLK * DQK * 2, NCH = DQK / 8, KCH = NCH / 8, ND0 = DQK / 16;
  int tid = threadIdx.x; asm volatile("" : "+v"(tid));
  const int wid = __builtin_amdgcn_readfirstlane(tid >> 6), lane = tid & 63, r32 = lane & 31, hi = lane >> 5;
  char* V_lds = lds; char* K_lds = lds + 2 * SHM_V;
  float* ws = (float*)(lds + 2 * SHM_V + 2 * SHM_K) + wid * 64; float* li_l = ws; float* al_l = ws + 32;
  float m_reg = -1e30f, l_reg = 0; f32x16 o[4] = {}; bf16x8 qr[ND0 - NQL];
  const bf16_t* Qw = Qb + (long)(wid * QBLK + r32) * LDQ + hi * 8;
  char* qls = lds + 2 * SHM_V + 2 * SHM_K + 2048 + wid * (NQL * 1024) + lane * 16;
#pragma unroll
  for (int d0 = 0; d0 < ND0; ++d0) { const bf16x8 q = *reinterpret_cast<const bf16x8*>(Qw + d0 * 16); if (d0 < ND0 - NQL) qr[d0 < ND0 - NQL ? d0 : 0] = q; else *reinterpret_cast<bf16x8*>(qls + (d0 - (ND0 - NQL)) * 1024) = q; }
  const int sr = tid >> 4, sc = (tid & 15) * 8, vst0 = v_st(sr, sc), vst1 = v_st(32 + sr, sc);
  const int vb0 = (int)(uintptr_t)V_lds + v_rd_base(lane);
  bf16x8 vs0, vs1, ks[KCH];
#define SLOAD(k0) do { vs0 = *reinterpret_cast<const bf16x8*>(&Vh[(long)((k0) + sr) * LDV + sc]); vs1 = *reinterpret_cast<const bf16x8*>(&Vh[(long)((k0) + 32 + sr) * LDV + sc]); \
    _Pragma("unroll") for (int c_ = 0; c_ < KCH; ++c_) { const int q_ = tid + 512 * c_; ks[c_] = *reinterpret_cast<const bf16x8*>(&Kh[(long)((k0) + q_ / NCH) * LDK + (q_ % NCH) * 8]); } } while (0)
#define SWRITE(b) do { *(bf16x8*)(V_lds + (b) * SHM_V + vst0) = vs0; *(bf16x8*)(V_lds + (b) * SHM_V + vst1) = vs1; \
    _Pragma("unroll") for (int c_ = 0; c_ < KCH; ++c_) { const int q_ = tid + 512 * c_; *(bf16x8*)(K_lds + (b) * SHM_K + kswz<DQK>(q_ / NCH, (q_ % NCH) * 16)) = ks[c_]; } } while (0)
#define SWAIT() asm volatile("s_waitcnt vmcnt(0)" ::: "memory")
#define RESC(a) do { if (__any((a) < 1.f)) { if (hi == 0) al_l[r32] = (a); asm volatile("s_waitcnt lgkmcnt(0)" ::: "memory"); \
    _Pragma("unroll") for (int d = 0; d < 4; ++d) _Pragma("unroll") for (int r = 0; r < 16; ++r) o[d][r] *= al_l[crow(r, hi)]; } } while (0)
  f32x16 pA0, pA1, pB0, pB1; float mnA, mnB, alA, alB; bf16x8 pa0, pa1, pa2, pa3; const int NT = seq / KVBLK;
  SLOAD(0); SWAIT(); SWRITE(0); __syncthreads();
  qkt_l<DQK, NQL>(pA0, pA1, K_lds, qr, qls, r32, hi); partialSM<DQK>(pA0, pA1, m_reg, mnA, alA);
  SLOAD(KVBLK); SWAIT(); SWRITE(1); __syncthreads();
  for (int j = 1; j + 1 < NT; j += 2) {
    SBAR(); qkt_l<DQK, NQL>(pB0, pB1, K_lds + SHM_K, qr, qls, r32, hi);
    finishSM(pA0, pA1, alA, l_reg, pa0, pa1, pa2, pa3); SBAR();
    SLOAD((j + 1) * KVBLK); SBAR();
    pv_d0(o, vb0, pa0, pa1, pa2, pa3); partialSM<DQK>(pB0, pB1, m_reg, mnB, alB);
    __syncthreads(); SWAIT(); SWRITE(0);
    RESC(alB); __syncthreads();
    SBAR(); qkt_l<DQK, NQL>(pA0, pA1, K_lds, qr, qls, r32, hi);
    finishSM(pB0, pB1, alB, l_reg, pa0, pa1, pa2, pa3); SBAR();
    SLOAD((j + 2) * KVBLK); SBAR();
    pv_d0(o, vb0 + (int)SHM_V, pa0, pa1, pa2, pa3); partialSM<DQK>(pA0, pA1, m_reg, mnA, alA);
    __syncthreads(); SWAIT(); SWRITE(1);
    RESC(alA); __syncthreads();
  }
  SBAR(); qkt_l<DQK, NQL>(pB0, pB1, K_lds + SHM_K, qr, qls, r32, hi);
  finishSM(pA0, pA1, alA, l_reg, pa0, pa1, pa2, pa3); SBAR();
  pv_d0(o, vb0, pa0, pa1, pa2, pa3); partialSM<DQK>(pB0, pB1, m_reg, mnB, alB);
  __syncthreads(); RESC(alB);
  finishSM(pB0, pB1, alB, l_reg, pa0, pa1, pa2, pa3); SBAR();
  pv_d0(o, vb0 + (int)SHM_V, pa0, pa1, pa2, pa3);
  if (hi == 0) li_l[r32] = l_reg; asm volatile("s_waitcnt lgkmcnt(0)" ::: "memory");
  __syncthreads();
  char* ot = lds + wid * 8192;
  { char* ob = ot + hi * 1024 + r32 * 2;
#pragma unroll
    for (int r = 0; r < 16; ++r) { const float rl = __builtin_amdgcn_rcpf(li_l[crow(r, hi)]);
#pragma unroll
      for (int d0 = 0; d0 < 4; ++d0) *(bf16_t*)(ob + ((r & 3) + 8 * (r >> 2)) * 256 + d0 * 64) = (bf16_t)(cvt_pk_bf16(o[d0][r] * rl, 0.f) & 0xffffu); } }
  asm volatile("s_waitcnt lgkmcnt(0)" ::: "memory");
  { bf16_t* Ow = Ob + (long)(wid * QBLK + (lane >> 4)) * LDO + (lane & 15) * 8; const char* ib = ot + (lane >> 4) * 256 + (lane & 15) * 16;
#pragma unroll
    for (int k = 0; k < 8; ++k) *(u32x4*)(Ow + (long)(k * 4) * LDO) = *(const u32x4*)(ib + k * 1024); }
  asm volatile("s_waitcnt lgkmcnt(0)" ::: "memory");
#undef SLOAD
#undef SWRITE
#undef SWAIT
#undef RESC
}
}
struct Ctx { LAS unsigned char* lds; int tid, lane, wave, bid, G, gw, NGW; };

template <class F>
__device__ __forceinline__ void conv_tile_load(F src4, int n0, int k0, int lane, f32x4 (&v)[8]) {
    const int kr = lane >> 3, n4 = (lane & 7) * 4;
#pragma unroll
    for (int i = 0; i < 8; ++i) v[i] = src4(n0 + n4, k0 + 8 * kr + i);
}
__device__ __forceinline__ void conv_tile_store(const f32x4 (&v)[8], bf16_t* dp  , int Kd, LAS float* scr, int lane) {
    const int kr = lane >> 3, n4 = (lane & 7) * 4; (void)scr;
#pragma unroll
    for (int j = 0; j < 4; ++j) { u32x4 o; o.x = cvt_pk_bf16(v[0][j], v[1][j]); o.y = cvt_pk_bf16(v[2][j], v[3][j]); o.z = cvt_pk_bf16(v[4][j], v[5][j]); o.w = cvt_pk_bf16(v[6][j], v[7][j]);
        *(u32x4*)(dp + (size_t)(n4 + j) * Kd + 8 * kr) = o; }
}
template <class F>
__device__ __forceinline__ void conv_tile(F src4, bf16_t* dst, int Kd, int n0, int k0, LAS float* scr, int lane) {
    f32x4 v[8];
    conv_tile_load(src4, n0, k0, lane, v);
    conv_tile_store(v, dst + (size_t)n0 * Kd + k0, Kd, scr, lane);
}
#define CONV_JOB(ND, KD, DST, ...) do { const int nbk_ = (ND) / 32, nit_ = nbk_ * ((KD) / 64); bf16_t* dst_ = (bf16_t*)(DST); \
    for (int it_ = F.gw; it_ < nit_; it_ += F.NGW) conv_tile(__VA_ARGS__, dst_, (KD), (it_ % nbk_) * 32, (it_ / nbk_) * 64, scr, F.lane); } while (0)
__device__ __forceinline__ float bf_hi(float w) { return __uint_as_float(cvt_pk_bf16(w, 0.f) << 16); }

__device__ __forceinline__ int row_type(int r) { const int b = r / TPB, t = r - b * TPB; return t < CTXL ? 2 : b; }

__device__ __forceinline__ void modnorm_row(bf16_t* X, const float* g, const float* mods_l, int s, int r, int lane, f32x4 (&y)[8], const bf16_t* part, int nsplit) {
    const int rt = row_type(r);
    bf16_t* xr = X + (size_t)r * DM + 8 * lane;
    const f32x4* gp = (const f32x4*)g + 2 * lane;
    const f32x4* sh = (const f32x4*)(mods_l + (size_t)(rt * NMOD + 3 * s) * DM) + 2 * lane;
    const f32x4* sc = (const f32x4*)(mods_l + (size_t)(rt * NMOD + 3 * s + 1) * DM) + 2 * lane;
#pragma unroll
    for (int j = 0; j < 4; ++j) ld8bf(xr + 512 * j, y[2 * j], y[2 * j + 1]);
    if (part != nullptr && rt == 2) {
        const int cr = (r / TPB) * CTXL + (r % TPB);
#pragma unroll
        for (int j = 0; j < 4; ++j) { f32x4 a = y[2 * j], b = y[2 * j + 1];
            for (int k = 0; k < nsplit; ++k) { f32x4 pa, pb; ld8bf(part + ((size_t)k * (NB * CTXL) + cr) * DM + 8 * lane + 512 * j, pa, pb); a += pa; b += pb; }
            st8bf(xr + 512 * j, a, b); ld8bf(xr + 512 * j, y[2 * j], y[2 * j + 1]); }
    }
    float ss = 0.f;
#pragma unroll
    for (int j = 0; j < 8; ++j) ss += (y[j].x * y[j].x + y[j].y * y[j].y) + (y[j].z * y[j].z + y[j].w * y[j].w);
    const float rinv = rsqrtf(wave_sum(ss) * (1.0f / DM) + 1e-6f);
#pragma unroll
    for (int j = 0; j < 4; ++j) { y[2 * j] = (y[2 * j] * rinv) * gp[128 * j] * (1.0f + sc[128 * j]) + sh[128 * j]; y[2 * j + 1] = (y[2 * j + 1] * rinv) * gp[128 * j + 1] * (1.0f + sc[128 * j + 1]) + sh[128 * j + 1]; }
}
__device__ __forceinline__ void store_row_bf16(bf16_t* dst, int lane, const f32x4 (&y)[8]) {
#pragma unroll
    for (int j = 0; j < 4; ++j) st8bf(dst + 8 * lane + 512 * j, y[2 * j], y[2 * j + 1]);
}
__device__ __forceinline__ float rope_invfreq(int j, int half) { return powf(10000.0f, -(float)j / (float)half); }
constexpr int FFT_TW = 2730;
__device__ __forceinline__ int fft_toff(int s) { return s == 0 ? 0 : (s == 1 ? 2048 : (s == 2 ? 2560 : (s == 3 ? 2688 : (s == 4 ? 2720 : 2728)))); }
__device__ __forceinline__ f32x2 cmul(f32x2 a, f32x2 b) { return (f32x2){a.x * b.x - a.y * b.y, a.x * b.y + a.y * b.x}; }
__device__ __forceinline__ f32x2 cmulc(f32x2 a, f32x2 b) { return (f32x2){a.x * b.x + a.y * b.y, a.y * b.x - a.x * b.y}; }
__device__ __forceinline__ int fpa(int e) { return e + ((e >> 5) << 1); }
#define R4F(a0, a1, a2, a3, W1, W2, W3) do { const f32x2 t0_ = a0 + a2, t1_ = a0 - a2, t2_ = a1 + a3, d_ = a1 - a3, t3_ = (f32x2){d_.y, -d_.x}; \
        a0 = t0_ + t2_; a1 = cmul(t1_ + t3_, W1); a2 = cmul(t0_ - t2_, W2); a3 = cmul(t1_ - t3_, W3); } while (0)
#define R4I(z0, z1, z2, z3, W1, W2, W3) do { const f32x2 y1_ = cmulc(z1, W1), y2_ = cmulc(z2, W2), y3_ = cmulc(z3, W3); \
        const f32x2 t0_ = z0 + y2_, t1_ = z0 - y2_, t2_ = y1_ + y3_, d_ = y1_ - y3_, t3_ = (f32x2){-d_.y, d_.x}; \
        z0 = t0_ + t2_; z1 = t1_ + t3_; z2 = t0_ - t2_; z3 = t1_ - t3_; } while (0)
#define FFT_SYNC() do { if (WAVE) asm volatile("s_waitcnt lgkmcnt(0)" ::: "memory"); else __syncthreads(); } while (0)
template <int LOGN, bool WAVE>
__device__ __forceinline__ void fft4_fwd(LAS f32x2* x, const LAS f32x2* twl, int tid) {
    constexpr int N = 1 << LOGN, NS = (LOGN - 1) / 2, S0 = 6 - NS;
#pragma unroll 1
    for (int s = 0; s < NS; s += 2) {
        if (tid < N / 16) {
            const int q1 = N >> (2 * s + 2), q2 = q1 >> 2, pos2 = tid & (q2 - 1), base = ((tid - pos2) << 4) + pos2;
            const LAS f32x2* twa = twl + fft_toff(S0 + s); const LAS f32x2* twb = twl + fft_toff(S0 + s + 1);
            f32x2 v[4][4];
#pragma unroll
            for (int k1 = 0; k1 < 4; ++k1)
#pragma unroll
                for (int k2 = 0; k2 < 4; ++k2) v[k1][k2] = x[fpa(base + k1 * q1 + k2 * q2)];
#pragma unroll
            for (int k2 = 0; k2 < 4; ++k2) { const int p1 = k2 * q2 + pos2; const f32x2 w1 = twa[p1], w2 = twa[FFT_TW + p1], w3 = twa[2 * FFT_TW + p1];
                R4F(v[0][k2], v[1][k2], v[2][k2], v[3][k2], w1, w2, w3); }
            { const f32x2 w1 = twb[pos2], w2 = twb[FFT_TW + pos2], w3 = twb[2 * FFT_TW + pos2];
#pragma unroll
              for (int k1 = 0; k1 < 4; ++k1) R4F(v[k1][0], v[k1][1], v[k1][2], v[k1][3], w1, w2, w3); }
#pragma unroll
            for (int k1 = 0; k1 < 4; ++k1)
#pragma unroll
                for (int k2 = 0; k2 < 4; ++k2) x[fpa(base + k1 * q1 + k2 * q2)] = v[k1][k2];
        }
        FFT_SYNC();
    }
}
template <int LOGN, bool WAVE>
__device__ __forceinline__ void fft4_inv(LAS f32x2* x, const LAS f32x2* twl, int tid) {
    constexpr int N = 1 << LOGN, NS = (LOGN - 1) / 2, S0 = 6 - NS;
#pragma unroll 1
    for (int s = NS - 2; s >= 0; s -= 2) {
        if (tid < N / 16) {
            const int q1 = N >> (2 * s + 2), q2 = q1 >> 2, pos2 = tid & (q2 - 1), base = ((tid - pos2) << 4) + pos2;
            const LAS f32x2* twa = twl + fft_toff(S0 + s); const LAS f32x2* twb = twl + fft_toff(S0 + s + 1);
            f32x2 v[4][4];
#pragma unroll
            for (int k1 = 0; k1 < 4; ++k1)
#pragma unroll
                for (int k2 = 0; k2 < 4; ++k2) v[k1][k2] = x[fpa(base + k1 * q1 + k2 * q2)];
            { const f32x2 w1 = twb[pos2], w2 = twb[FFT_TW + pos2], w3 = twb[2 * FFT_TW + pos2];
#pragma unroll
              for (int k1 = 0; k1 < 4; ++k1) R4I(v[k1][0], v[k1][1], v[k1][2], v[k1][3], w1, w2, w3); }
#pragma unroll
            for (int k2 = 0; k2 < 4; ++k2) { const int p1 = k2 * q2 + pos2; const f32x2 w1 = twa[p1], w2 = twa[FFT_TW + p1], w3 = twa[2 * FFT_TW + p1];
                R4I(v[0][k2], v[1][k2], v[2][k2], v[3][k2], w1, w2, w3); }
#pragma unroll
            for (int k1 = 0; k1 < 4; ++k1)
#pragma unroll
                for (int k2 = 0; k2 < 4; ++k2) x[fpa(base + k1 * q1 + k2 * q2)] = v[k1][k2];
        }
        FFT_SYNC();
    }
}
__device__ __forceinline__ float block_sum(float v, LAS float* red, int tid) {
    v = wave_sum(v);
    __syncthreads();
    if ((tid & 63) == 0) red[tid >> 6] = v;
    __syncthreads();
    float s = 0.f;
#pragma unroll
    for (int i = 0; i < 8; ++i) s += red[i];
    return s;
}
template <int LOGL, int NT, bool WAVE>
__device__ __forceinline__ void hyena_channel(LAS unsigned char* bufp, const LAS f32x2* twl, LAS float* red, int tid, int c, const float* VXT, const float* HFT, const float* skip, bf16_t* Z) {
    constexpr int L = 1 << LOGL, N = 2 * L, LOGN = LOGL + 1, NPT = (L + NT - 1) / NT, NPR = (N / 2 + NT - 1) / NT  , TOFF = (LOGL == 12) ? CTXL : 0;
    LAS f32x2* buf = (LAS f32x2*)bufp;
    constexpr int NTAP = N / NT;
    const float wdelta = fabsf(-15.350567286626973f + (float)c * ((-3.0701134573253946f + 15.350567286626973f) / (float)(DM - 1)));
    const float* v0p = VXT + ((size_t)(0 * 6144 + c)) * TPB + TOFF; const float* v1p = VXT + ((size_t)(1 * 6144 + c)) * TPB + TOFF;
    float zr[NPT], zi[NPT], gtc[2][NPT], tpc[NTAP];
#pragma unroll
    for (int i = 0; i < NPT; ++i) { const int t = tid + NT * i; zr[i] = (t < L) ? v0p[t] : 0.f; zi[i] = (t < L) ? v1p[t] : 0.f; }
#define HY_TAPS(o_) do { const float* kf_ = HFT + (size_t)(((o_) * 2 + 0) * DM + c) * L; const float* kb_ = HFT + (size_t)(((o_) * 2 + 1) * DM + c) * L; \
        _Pragma("unroll") for (int i = 0; i < NTAP; ++i) { const int tau = tid + NT * i, lag = (tau < L) ? tau : N - tau;     \
            tpc[i] = ((tau < L) ? kf_[tau] : ((tau > L) ? kb_[N - tau] : 0.f)) * __expf(-(float)lag * (1.0f / (float)(L - 1)) * wdelta); } } while (0)
#define HY_GATES(o_) do { _Pragma("unroll") for (int i = 0; i < NPT; ++i) { const int t = tid + NT * i; \
            gtc[0][i] = (t < L) ? VXT[((size_t)(0 * 6144 + ((o_) + 1) * DM + c)) * TPB + TOFF + t] : 0.f; gtc[1][i] = (t < L) ? VXT[((size_t)(1 * 6144 + ((o_) + 1) * DM + c)) * TPB + TOFF + t] : 0.f; } } while (0)
    HY_TAPS(0);
#pragma unroll
    for (int o = 0; o < 2; ++o) {
        HY_GATES(o);
        float ss = 0.f;
#pragma unroll
        for (int i = 0; i < NTAP; ++i) { const float g = tpc[i]; ss += g * g; buf[fpa(tid + NT * i)] = (f32x2){g, 0.f}; }
        float ssum; if (WAVE) { FFT_SYNC(); ssum = wave_sum(ss); } else ssum = block_sum(ss, red, tid);
        const float scale = rsqrtf(ssum + 1e-12f) * (1.0f / N);
        fft4_fwd<LOGN, WAVE>(buf, twl, tid);
        f32x4 G[NPR];
#pragma unroll
        for (int k = 0; k < NPR; ++k) { const int j = tid + NT * k; if (j < N / 2) { const f32x4 p = ((const LAS f32x4*)buf)[fpa(2 * j) >> 1]; G[k] = (f32x4){p.x + p.z, p.y + p.w, p.x - p.z, p.y - p.w}; } }
        FFT_SYNC();
        if (o == 0) HY_TAPS(1);
#pragma unroll
        for (int i = 0; i < NPT; ++i) { const int t = tid + NT * i; if (t < L) { buf[fpa(t)] = (f32x2){zr[i], zi[i]}; buf[fpa(t + L)] = (f32x2){0.f, 0.f}; } }
        FFT_SYNC();
        fft4_fwd<LOGN, WAVE>(buf, twl, tid);
#pragma unroll
        for (int k = 0; k < NPR; ++k) { const int j = tid + NT * k; if (j < N / 2) { const f32x4 p = ((const LAS f32x4*)buf)[fpa(2 * j) >> 1];
            const f32x2 a = (f32x2){p.x + p.z, p.y + p.w}, b = (f32x2){p.x - p.z, p.y - p.w};
            const f32x2 cc = cmul(a, (f32x2){G[k].x, G[k].y}), dd = cmul(b, (f32x2){G[k].z, G[k].w});
            ((LAS f32x4*)buf)[fpa(2 * j) >> 1] = (f32x4){cc.x + dd.x, cc.y + dd.y, cc.x - dd.x, cc.y - dd.y}; } }
        FFT_SYNC();
        fft4_inv<LOGN, WAVE>(buf, twl, tid);
        const float sk = skip[o * DM + c];
#pragma unroll
        for (int i = 0; i < NPT; ++i) { const int t = tid + NT * i; if (t < L) { const f32x2 y = buf[fpa(t)];
            zr[i] = gtc[0][i] * (y.x * scale + sk * zr[i]); zi[i] = gtc[1][i] * (y.y * scale + sk * zi[i]); } }
        FFT_SYNC();
    }
#undef HY_TAPS
#undef HY_GATES
#pragma unroll
    for (int i = 0; i < NPT; ++i) { const int t = tid + NT * i; if (t < L) {
        Z[(size_t)c * ROWS + 0 * TPB + TOFF + t] = (bf16_t)(cvt_pk_bf16(zr[i], 0.f) & 0xffffu);
        Z[(size_t)c * ROWS + 1 * TPB + TOFF + t] = (bf16_t)(cvt_pk_bf16(zi[i], 0.f) & 0xffffu); } }
}
__device__ __forceinline__ void hyena_conv3_unit(int unit, const bf16_t* U, const float* cw, const float* cb, float* VXT, LAS float* tile  , int lane) {
    const int cblk = unit % 96, tblk = (unit / 96) % 68, b = unit / (96 * 68);
    const int c0 = cblk * 64, t0 = tblk * 64;
    const int ch = c0 + lane;
    const float w0 = cw[ch], w1 = cw[6144 + ch], w2 = cw[2 * 6144 + ch], bb = cb[ch];
    const bf16_t* up_ = U + ((size_t)b * TPB + t0) * 6144 + ch;
    const bool first = (t0 == 0) || (t0 == CTXL), last = (t0 + 64 == CTXL) || (t0 + 64 == TPB);
    float v[66];
    v[0] = first ? 0.f : bf2f(up_[-6144]);
#pragma unroll
    for (int i = 0; i < 64; ++i) v[i + 1] = bf2f(up_[(size_t)i * 6144]);
    v[65] = last ? 0.f : bf2f(up_[(size_t)64 * 6144]);
#pragma unroll
    for (int i = 0; i < 64; ++i) tile[lane * 65 + i] = v[i] * w0 + v[i + 1] * w1 + v[i + 2] * w2 + bb;
    LDS_WAIT(); asm volatile("" ::: "memory");
    float* op = VXT + ((size_t)b * 6144 + c0) * TPB + t0 + lane;
#pragma unroll 16
    for (int c = 0; c < 64; ++c) op[(size_t)c * TPB] = tile[c * 65 + lane];
    LDS_WAIT(); asm volatile("" ::: "memory");
}

__device__ __forceinline__ float dpp_sum16(float v) {
    v += __int_as_float(__builtin_amdgcn_update_dpp(0, __float_as_int(v), 0xB1, 0xF, 0xF, false));
    v += __int_as_float(__builtin_amdgcn_update_dpp(0, __float_as_int(v), 0x4E, 0xF, 0xF, false));
    v += __int_as_float(__builtin_amdgcn_update_dpp(0, __float_as_int(v), 0x141, 0xF, 0xF, false));
    v += __int_as_float(__builtin_amdgcn_update_dpp(0, __float_as_int(v), 0x140, 0xF, 0xF, false));
    return v;
}
__device__ __forceinline__ float dpp_sum8(float v) {
    v += __int_as_float(__builtin_amdgcn_update_dpp(0, __float_as_int(v), 0xB1, 0xF, 0xF, false));
    v += __int_as_float(__builtin_amdgcn_update_dpp(0, __float_as_int(v), 0x4E, 0xF, 0xF, false));
    v += __int_as_float(__builtin_amdgcn_update_dpp(0, __float_as_int(v), 0x141, 0xF, 0xF, false));
    return v;
}
template <class BGF, class BG>
__device__ __forceinline__ void rwkv_scan_unit(const Ctx& F, int unit, const bf16_t* DEC, const bf16_t* ASIG, const float* k_k, const float* k_a, const bf16_t* RKV, float* Y, BGF bg_finish, BG bg) {
    constexpr int T = 32, NCHUNK = TPB / T;
    const int chain = unit >> 1, rh = unit & 1, d = chain >> 6, b = (chain >> 5) & 1, h = chain & 31;
    LAS float* buf = (LAS float*)F.lds;
    const int tid = F.tid, wave = F.wave, lane = F.lane;
    const int rl = wave * 8 + (lane >> 3), kq = lane & 7;
    float* Yd = Y + (size_t)d * ROWS * DM + h * 64 + rh * 32 + rl;
#define RW_ROW(sg) ((size_t)b * TPB + (d == 0 ? (sg) : ((sg) < CTXL ? (CTXL - 1 - (sg)) : (TPB + CTXL - 1 - (sg)))))
    const int st = (tid - 256) & 255, q4 = st & 15, s0 = st >> 4;
    const int hc = h * 64 + q4 * 4;
    const f32x4 ka4 = *(const f32x4*)(k_a + hc), kk4 = *(const f32x4*)(k_k + hc), omka4 = 1.0f - ka4;
    u32x2 R[2][5];
#define BF4_(w_) ((f32x4){__uint_as_float((w_).x << 16), __uint_as_float((w_).x & 0xffff0000u), __uint_as_float((w_).y << 16), __uint_as_float((w_).y & 0xffff0000u)})
#define ST_ISSUE(ck_) do { _Pragma("unroll") for (int j_ = 0; j_ < 2; ++j_) { const size_t row_ = RW_ROW((ck_) * T + s0 + 16 * j_); \
            R[j_][0] = *(const u32x2*)(DEC + row_ * (2 * DM) + (size_t)d * DM + hc); R[j_][1] = *(const u32x2*)(RKV + ((size_t)ROWS + row_) * DM + hc); \
            R[j_][2] = *(const u32x2*)(ASIG + row_ * (2 * DM) + (size_t)d * DM + hc); R[j_][3] = *(const u32x2*)(RKV + row_ * DM + hc); R[j_][4] = *(const u32x2*)(RKV + ((size_t)2 * ROWS + row_) * DM + hc); } } while (0)
#define ST_WRITE(p_) do { _Pragma("unroll") for (int j_ = 0; j_ < 2; ++j_) { LAS float* o_ = buf + (((p_) * T + s0 + 16 * j_) * 6) * 64 + q4 * 4; \
            const f32x4 a_ = BF4_(R[j_][2]), k_ = BF4_(R[j_][1]), e_ = BF4_(R[j_][0]); \
            f32x4 kk_ = k_ * kk4;      \
            const float ss_ = dpp_sum16((kk_.x * kk_.x + kk_.y * kk_.y) + (kk_.z * kk_.z + kk_.w * kk_.w)); \
            kk_ = kk_ * rsqrtf(ss_ + 1e-12f); \
            *(LAS f32x4*)(o_) = (f32x4){__builtin_amdgcn_exp2f(-e_.x), __builtin_amdgcn_exp2f(-e_.y), __builtin_amdgcn_exp2f(-e_.z), __builtin_amdgcn_exp2f(-e_.w)}; *(LAS f32x4*)(o_ + 64) = k_ * (a_ * ka4 + omka4); *(LAS f32x4*)(o_ + 128) = kk_; *(LAS f32x4*)(o_ + 192) = kk_ * a_; \
            *(LAS f32x4*)(o_ + 256) = BF4_(R[j_][3]); *(LAS f32x4*)(o_ + 320) = BF4_(R[j_][4]); } } while (0)
    f32x2 S0 = (f32x2){0.f, 0.f}, S1 = S0, S2 = S0, S3 = S0;
    if (wave < 4) __builtin_amdgcn_s_setprio(3);
    __syncthreads();
    if (wave >= 4) { ST_ISSUE(0); ST_WRITE(0); ST_ISSUE(1); }
    __syncthreads();
#define RW_LD(W0, W1, K0, K1, A0, A1, B0, B1, R0_, R1_, VT, s_) do { const LAS float* base_ = cb + (s_) * 6 * 64; \
                W0 = *(const LAS f32x4*)(base_); W1 = *(const LAS f32x4*)(base_ + 4); K0 = *(const LAS f32x4*)(base_ + 64); K1 = *(const LAS f32x4*)(base_ + 68); \
                A0 = *(const LAS f32x4*)(base_ + 128); A1 = *(const LAS f32x4*)(base_ + 132); B0 = *(const LAS f32x4*)(base_ + 192); B1 = *(const LAS f32x4*)(base_ + 196); \
                R0_ = *(const LAS f32x4*)(base_ + 256); R1_ = *(const LAS f32x4*)(base_ + 260); VT = vb[(s_) * 6 * 64]; } while (0)
    f32x4 rp0 = (f32x4){0.f, 0.f, 0.f, 0.f}, rp1 = rp0; float yk = 0.f;
    float* yp = Yd + ((size_t)b * TPB + (d == 0 ? kq : CTXL - 1 - kq)) * DM;
    const long ystep = d == 0 ? (long)8 * DM : -(long)8 * DM, yjump = d == 0 ? 0 : (long)TPB * DM;
#define RW_YKEEP(gv_, y_, chk_) do { yk = (kq == ((gv_) & 7)) ? (y_) : yk; \
        if (((gv_) & 7) == 7) { *yp = yk; yp += ystep; if ((chk_) && (gv_) == CTXL - 1) yp += yjump; } } while (0)
#pragma unroll 1
    for (int ck = 0; ck < NCHUNK; ++ck) {
        const int p = ck & 1;
        if (wave >= 4) { if (ck + 1 < NCHUNK) ST_WRITE(p ^ 1); __builtin_amdgcn_s_waitcnt(0x0F70);     bg_finish(ck, wave - 4); if (ck + 2 < NCHUNK) ST_ISSUE(ck + 2); bg(ck, wave - 4); }
        else {
            const LAS float* cb = buf + p * T * 6 * 64 + kq * 8;
            const LAS float* vb = buf + p * T * 6 * 64 + 5 * 64 + rh * 32 + rl;
            f32x4 w0, w1, k0, k1, a0, a1, b0, b1, r0, r1; float vt;
            f32x4 nw0, nw1, nk0, nk1, na0, na1, nb0, nb1, nr0, nr1; float nvt;
            RW_LD(w0, w1, k0, k1, a0, a1, b0, b1, r0, r1, vt, 0);
#pragma unroll
            for (int s = 0; s < T; ++s) {
#define FENCE_() __builtin_amdgcn_sched_barrier(0)
#define DPPADD_(x_, c_) x_ += __int_as_float(__builtin_amdgcn_update_dpp(0, __float_as_int(x_), c_, 0xF, 0xF, false))
                const bool nx = (s + 1 < T);
                const LAS float* nb_ = cb + (s + 1) * 6 * 64;
                FENCE_();
                if (nx) { na0 = *(const LAS f32x4*)(nb_ + 128); na1 = *(const LAS f32x4*)(nb_ + 132); }
                FENCE_();
                f32x2 da = S0 * (f32x2){a0.x, a0.y}, db = S2 * (f32x2){a1.x, a1.y};
                f32x2 ya = S0 * (f32x2){rp0.x, rp0.y};
                ya = S2 * (f32x2){rp1.x, rp1.y} + ya;
                FENCE_();
                if (nx) { nk0 = *(const LAS f32x4*)(nb_ + 64); nvt = vb[(s + 1) * 6 * 64]; }
                FENCE_();
                da = S1 * (f32x2){a0.z, a0.w} + da; db = S3 * (f32x2){a1.z, a1.w} + db;
                ya = S1 * (f32x2){rp0.z, rp0.w} + ya; ya = S3 * (f32x2){rp1.z, rp1.w} + ya;
                FENCE_();
                if (nx) { nk1 = *(const LAS f32x4*)(nb_ + 68); nb0 = *(const LAS f32x4*)(nb_ + 192); }
                FENCE_();
                da = da + db;
                float xs = da.x + da.y, ys = ya.x + ya.y;
                const f32x2 vt2 = (f32x2){vt, vt};
                f32x2 t0 = vt2 * (f32x2){k0.x, k0.y}, t1 = vt2 * (f32x2){k0.z, k0.w};
                asm volatile("" : "+v"(t0), "+v"(t1));
                DPPADD_(xs, 0xB1); DPPADD_(ys, 0xB1);
                FENCE_();
                if (nx) { nb1 = *(const LAS f32x4*)(nb_ + 196); nw0 = *(const LAS f32x4*)(nb_); }
                FENCE_();
                f32x2 t2 = vt2 * (f32x2){k1.x, k1.y}, t3 = vt2 * (f32x2){k1.z, k1.w};
                asm volatile("" : "+v"(t2), "+v"(t3));
                DPPADD_(xs, 0x4E); DPPADD_(ys, 0x4E);
                FENCE_();
                if (nx) { nw1 = *(const LAS f32x4*)(nb_ + 4); nr0 = *(const LAS f32x4*)(nb_ + 256); }
                FENCE_();
                f32x2 p0 = S0 * (f32x2){w0.x, w0.y} + t0, p1 = S1 * (f32x2){w0.z, w0.w} + t1, p2 = S2 * (f32x2){w1.x, w1.y} + t2, p3 = S3 * (f32x2){w1.z, w1.w} + t3;
                asm volatile("" : "+v"(p0), "+v"(p1), "+v"(p2), "+v"(p3));
                DPPADD_(xs, 0x141); DPPADD_(ys, 0x141);
                FENCE_();
                if (nx) { nr1 = *(const LAS f32x4*)(nb_ + 260); }
                FENCE_();
                const f32x2 sa2 = (f32x2){-xs, -xs};
                S0 = sa2 * (f32x2){b0.x, b0.y} + p0; S1 = sa2 * (f32x2){b0.z, b0.w} + p1; S2 = sa2 * (f32x2){b1.x, b1.y} + p2; S3 = sa2 * (f32x2){b1.z, b1.w} + p3;
                if (s > 0) { RW_YKEEP(ck * T + s - 1, ys, false); } else if (ck > 0) { RW_YKEEP(ck * T - 1, ys, true); }
                FENCE_();
#undef FENCE_
#undef DPPADD_
                rp0 = r0; rp1 = r1;
                w0 = nw0; w1 = nw1; k0 = nk0; k1 = nk1; a0 = na0; a1 = na1; b0 = nb0; b1 = nb1; r0 = nr0; r1 = nr1; vt = nvt;
            }
        }
        __syncthreads();
    }
    if (wave < 4) {
        f32x2 ya = S0 * (f32x2){rp0.x, rp0.y}, yb = S2 * (f32x2){rp1.x, rp1.y};
        ya = S1 * (f32x2){rp0.z, rp0.w} + ya; yb = S3 * (f32x2){rp1.z, rp1.w} + yb; ya = ya + yb;
        const float ys = dpp_sum8(ya.x + ya.y);
        RW_YKEEP(TPB - 1, ys, false);
    }
    __builtin_amdgcn_s_setprio(0);
#undef RW_YKEEP
#undef RW_LD
#undef ST_ISSUE
#undef BF4_
#undef ST_WRITE
#undef RW_ROW
}
__device__ __forceinline__ float head_sum16(float v) { v += __shfl_xor(v, 1); v += __shfl_xor(v, 2); v += __shfl_xor(v, 4); v += __shfl_xor(v, 8); return v; }
__device__ __forceinline__ void rwkv_shift_row(const bf16_t* HLF, const float* mix, bf16_t* XS, int r, int lane) {
    const int t = r % TPB;
    const bool hp = (t != 0) && (t != CTXL), hn = (t != CTXL - 1) && (t != TPB - 1);
    const bf16_t* h0 = HLF + (size_t)r * DM + 8 * lane;
    const f32x4 z4 = (f32x4){0.f, 0.f, 0.f, 0.f};
#pragma unroll 2
    for (int j = 0; j < 4; ++j) {
        f32x4 ha, hb, pa = z4, pb = z4, na = z4, nb = z4;
        ld8bf(h0 + 512 * j, ha, hb); if (hp) ld8bf(h0 + 512 * j - DM, pa, pb); if (hn) ld8bf(h0 + 512 * j + DM, na, nb);
        const f32x4 dpa = pa - ha, dpb = pb - hb, dna = na - ha, dnb = nb - hb;
#pragma unroll
        for (int k = 0; k < 6; ++k) {
            const f32x4* m0 = (const f32x4*)(mix + (size_t)k * DM) + 2 * lane + 128 * j; const f32x4* m1 = (const f32x4*)(mix + (size_t)(6 + k) * DM) + 2 * lane + 128 * j;
            st8bf(XS + ((size_t)k * ROWS + r) * DM + 8 * lane + 512 * j, ha + dpa * m0[0] + dna * m1[0], hb + dpb * m0[1] + dnb * m1[1]);
        }
    }
}
__device__ __forceinline__ void rwkv_prep_row(const float* Kf, const float* k_k, float* KK, int r, int lane) {
#pragma unroll 2
    for (int j = 0; j < 8; ++j) {
        const int q = lane + 64 * j;
        const f32x4 k = ((const f32x4*)(Kf + (size_t)r * DM))[q], kkw = ((const f32x4*)k_k)[q];
        f32x4 kk = k * kkw;
        const float ss = head_sum16((kk.x * kk.x + kk.y * kk.y) + (kk.z * kk.z + kk.w * kk.w));
        ((f32x4*)(KK + (size_t)r * DM))[q] = kk * rsqrtf(ss + 1e-12f);
    }
}
__device__ __forceinline__ void rwkv_readout_row(const float* Y, const bf16_t* RKV, const bf16_t* ASIG, const float* k_a, const bf16_t* Gf, const float* r_k, const float* ln_w, const float* ln_b, bf16_t* out, int r, int lane) {
#pragma unroll 2
    for (int j = 0; j < 4; ++j) {
        const int c8 = 8 * lane + 512 * j, q = 2 * lane + 128 * j;
        const f32x4* y0 = (const f32x4*)(Y + (size_t)r * DM) + q; const f32x4* y1 = (const f32x4*)(Y + ((size_t)ROWS + r) * DM) + q;
        const f32x4 ya = y0[0] + y1[0], yb = y0[1] + y1[1];
        const float mu = dpp_sum8(((ya.x + ya.y) + (ya.z + ya.w)) + ((yb.x + yb.y) + (yb.z + yb.w))) * (1.0f / 64.0f);
        const f32x4 da = ya - mu, db = yb - mu;
        const float var = dpp_sum8(((da.x * da.x + da.y * da.y) + (da.z * da.z + da.w * da.w)) + ((db.x * db.x + db.y * db.y) + (db.z * db.z + db.w * db.w))) * (1.0f / 64.0f);
        const float rs = rsqrtf(var + 64e-5f);
        f32x4 na = da * rs * ((const f32x4*)ln_w)[q] + ((const f32x4*)ln_b)[q], nb = db * rs * ((const f32x4*)ln_w)[q + 1] + ((const f32x4*)ln_b)[q + 1];
        f32x4 ra, rb, va, vb, ka, kb, a0a, a0b, a1a, a1b, ga, gb;
        ld8bf(RKV + (size_t)r * DM + c8, ra, rb); ld8bf(RKV + ((size_t)2 * ROWS + r) * DM + c8, va, vb); ld8bf(RKV + ((size_t)ROWS + r) * DM + c8, ka, kb);
        ld8bf(ASIG + (size_t)r * 2 * DM + c8, a0a, a0b); ld8bf(ASIG + (size_t)r * 2 * DM + DM + c8, a1a, a1b); ld8bf(Gf + (size_t)r * DM + c8, ga, gb);
        const f32x4 ksa = ka * (2.0f + ((a0a + a1a) - 2.0f) * ((const f32x4*)k_a)[q]), ksb = kb * (2.0f + ((a0b + a1b) - 2.0f) * ((const f32x4*)k_a)[q + 1]);
        const f32x4 pa = ra * ((const f32x4*)r_k)[q] * ksa, pb = rb * ((const f32x4*)r_k)[q + 1] * ksb;
        const float bs = dpp_sum8(((pa.x + pa.y) + (pa.z + pa.w)) + ((pb.x + pb.y) + (pb.z + pb.w)));
        na = (na + bs * va) * ga; nb = (nb + bs * vb) * gb;
        st8bf(out + (size_t)r * DM + c8, na, nb);
    }
}

template <int HALF> __device__ __forceinline__ void rope_sincos(float pos, int lane, float& sn, float& cs) { sincosf(pos * rope_invfreq(lane & (HALF - 1), HALF), &sn, &cs); }
template <int HALF> __device__ __forceinline__ float rope_apply(float u, float sn, float cs, int lane) {
    const float up = __shfl_xor(u, HALF);
    return (lane & HALF) ? (up * sn + u * cs) : (u * cs - up * sn);
}
__device__ __forceinline__ void mla_row_a(const bf16_t* RAW, const float* qg, const float* kvg, bf16_t* CQN, bf16_t* CKVN, bf16_t* Kb, const LAS f32x2* rope_t, int r, int lane) {
    const bf16_t* raw = RAW + (size_t)r * 1280;
    const int t = r % TPB;
#pragma unroll
    for (int part = 0; part < 2; ++part) {
        f32x4 a, b; ld8bf(raw + part * 512 + 8 * lane, a, b);
        const float ss = wave_sum((a.x * a.x + a.y * a.y) + (a.z * a.z + a.w * a.w) + (b.x * b.x + b.y * b.y) + (b.z * b.z + b.w * b.w));
        const float rinv = rsqrtf(ss * (1.0f / 512.0f) + 1e-6f);
        const float* g = part ? kvg : qg;
        st8bf((part ? CKVN : CQN) + (size_t)r * 512 + 8 * lane, a * rinv * ((const f32x4*)g)[2 * lane], b * rinv * ((const f32x4*)g)[2 * lane + 1]);
    }
    float kp = bf2f(raw[1024 + lane]);
    if (t >= CTXL) { const int l = t - CTXL, pos = (lane < 32) ? (l >> 6) : (l & 63); const f32x2 cs = rope_t[pos * 16 + (lane & 15)];
        const float up = __shfl_xor(kp, 16); kp = (lane & 16) ? (up * cs.y + kp * cs.x) : (kp * cs.x - up * cs.y); }
    float kv[8];
#pragma unroll
    for (int e = 0; e < 8; ++e) kv[e] = __shfl(kp, (lane & 7) * 8 + e);
    const f32x4 ka = (f32x4){kv[0], kv[1], kv[2], kv[3]}, kb = (f32x4){kv[4], kv[5], kv[6], kv[7]};
#pragma unroll
    for (int p = 0; p < 2; ++p) st8bf(Kb + (size_t)r * 3072 + (8 * p + (lane >> 3)) * 192 + 128 + (lane & 7) * 8, ka, kb);
}
__device__ __forceinline__ void mla_row_q(const bf16_t* QRAW, bf16_t* Qb, const LAS f32x2* rope_t, int r, int lane) {
    const bf16_t* q = QRAW + (size_t)r * 3072; bf16_t* o = Qb + (size_t)r * 3072;
    const int l = (r % TPB) - CTXL; const bool lat = l >= 0;
#pragma unroll
    for (int p = 0; p < 4; ++p) { const int gi = p * 64 + lane, off = (gi >> 4) * 192 + (gi & 15) * 8; *(u32x4*)(o + off) = *(const u32x4*)(q + off); }
    const int e8 = (lane & 7) * 8; const bool second = (lane & 2) != 0;
    f32x2 cssn[8];
    if (lat) { const int pos = (e8 < 32) ? (l >> 6) : (l & 63); const LAS f32x2* tp = rope_t + pos * 16 + (e8 & 15);
#pragma unroll
        for (int e = 0; e < 8; ++e) cssn[e] = tp[e]; }
#pragma unroll
    for (int p = 0; p < 2; ++p) { const int off = (8 * p + (lane >> 3)) * 192 + 128 + e8;
        if (!lat) { *(u32x4*)(o + off) = *(const u32x4*)(q + off); continue; }
        f32x4 xa, xb; ld8bf(q + off, xa, xb);
        float y[8] = {xa.x, xa.y, xa.z, xa.w, xb.x, xb.y, xb.z, xb.w};
#pragma unroll
        for (int e = 0; e < 8; ++e) { const float yp = __shfl_xor(y[e], 2); y[e] = second ? (yp * cssn[e].y + y[e] * cssn[e].x) : (y[e] * cssn[e].x - yp * cssn[e].y); }
        st8bf(o + off, (f32x4){y[0], y[1], y[2], y[3]}, (f32x4){y[4], y[5], y[6], y[7]}); }
}
__device__ __forceinline__ void gqa_row(const bf16_t* RAW, const float* qg, const float* kg, bf16_t* Qb, bf16_t* Kb, bf16_t* Vb, const LAS f32x2* rope_t, int r, int lane) {
    const bf16_t* raw = RAW + (size_t)r * 4096;
    const int l = (r % TPB) - CTXL;
    const int d8 = (lane & 15) * 8, hl = lane >> 4;
    const bool lat = l >= 0, second = (lane & 4) != 0;
    f32x2 cssn[8];
    if (lat) { const int pos = (d8 < 64) ? (l >> 6) : (l & 63); const LAS f32x2* tp = rope_t + pos * 32 + (d8 & 31);
#pragma unroll
        for (int e = 0; e < 8; ++e) cssn[e] = tp[e]; }
#pragma unroll 1
    for (int p = lat ? 0 : 4; p < 6; ++p) {
        const int hh = 4 * p + hl;
        f32x4 xa, xb; ld8bf(raw + hh * 128 + d8, xa, xb);
        const float ss = dpp_sum16((xa.x * xa.x + xa.y * xa.y) + (xa.z * xa.z + xa.w * xa.w) + (xb.x * xb.x + xb.y * xb.y) + (xb.z * xb.z + xb.w * xb.w));
        const float rinv = rsqrtf(ss * (1.0f / 128.0f) + 1e-6f);
        const float* g = (p < 4) ? qg : kg;
        xa = xa * rinv * *(const f32x4*)(g + d8); xb = xb * rinv * *(const f32x4*)(g + d8 + 4);
        if (lat) {
            float y[8] = {xa.x, xa.y, xa.z, xa.w, xb.x, xb.y, xb.z, xb.w};
#pragma unroll
            for (int e = 0; e < 8; ++e) { const float yp = __shfl_xor(y[e], 4); y[e] = second ? (yp * cssn[e].y + y[e] * cssn[e].x) : (y[e] * cssn[e].x - yp * cssn[e].y); }
            xa = (f32x4){y[0], y[1], y[2], y[3]}; xb = (f32x4){y[4], y[5], y[6], y[7]};
        }
        st8bf((p < 4) ? (Qb + (size_t)r * 2048 + hh * 128 + d8) : (Kb + (size_t)r * 1024 + (hh - 16) * 128 + d8), xa, xb);
    }
#pragma unroll
    for (int j = 0; j < 2; ++j) ((u32x4*)(Vb + (size_t)r * 1024))[lane + 64 * j] = ((const u32x4*)(raw + 3072))[lane + 64 * j];
}
struct Args { const float* in[49]; float* out; unsigned char* ws; int ph_lo, ph_hi, li, pad; };
constexpr int N_PHASES = 52;

#ifndef WGM_DN
#define WGM_DN 2
#endif
#define RUN_GEMM(EPI_T, epi, A_, Bt_, K_, ...) RUN_GEMM_W(2, EPI_T, epi, A_, Bt_, K_, __VA_ARGS__)
#define RUN_GEMM_W(W_, EPI_T, epi, A_, Bt_, K_, ...) do { typedef pg8::TSched<W_, __VA_ARGS__> Sch_; Sch_ S_; S_.init(F.G, F.bid); pg8::gemm_phase<EPI_T, Sch_>(F.lds, pg8::Gemm{(const bf16_t*)(A_), (const bf16_t*)(Bt_), (K_)}, S_, (epi)); } while (0)

#define FFN_PHASES(p0, l, s, lat_only, nsp) do { \
    const float* mods_l_ = MODS + (size_t)(l) * 3 * NMOD * DM; const int h_ = (s) ? 1 : 0; \
    PHASE((p0)) { const float* g_ = AIN(6) + (size_t)((l) * 3 + (s)) * DM; \
        for (int r = F.gw; r < ROWS; r += F.NGW) { if ((lat_only) && (r % TPB) < CTXL) continue; f32x4 y[8]; modnorm_row(X, g_, mods_l_, (s), r, F.lane, y, (nsp) ? PART : nullptr, (nsp)); store_row_bf16(NBF + (size_t)r * DM, F.lane, y); } \
        if (BOTH((p0))) GRID_BAR(); } \
    PHASE((p0) + 1) { pg8::EpiSwiglu E{ACT}; \
        RUN_GEMM(pg8::EpiSwiglu, E, NBF, ws + WS_W + W_GU((l), h_), DM, (lat_only) ? 32 : NPAN, 44, 0, 0, 1, (lat_only) ? 1 : 0); if (BOTH((p0) + 1)) GRID_BAR(); } \
    PHASE((p0) + 2) { pg8::EpiResid E{X, mods_l_, 3 * (s) + 2, A.pad ? 0.f : 0.5f, nullptr}; \
        RUN_GEMM_W(WGM_DN, pg8::EpiResid, E, ACT, ws + WS_W + W_DN((l), h_), FF, 32, 8, 0, 0, 1, 1, (lat_only) ? 0 : 2, 8, 0, 0, 11, 2);     if (BOTH((p0) + 2)) GRID_BAR(); } \
} while (0)

__device__ __forceinline__ const float* ain_(const Args& A, int i) { asm volatile("" : "+s"(i)); return A.in[i]; }
constexpr int BG_NFFN = 5 * 16896, BG_NSLOTS = BG_NFFN + 2048 + 1280 + 1792 + 2048 + 4096 + 2048;
template <bool ISSUE_ONLY>
__device__ __forceinline__ bool bg_convert_slot(const Args& A, int slot, LAS float* scr, int lane, f32x4 (&v)[8], bf16_t*& dstp, int& Kd) {
    if (slot >= BG_NSLOTS) return false;
    unsigned char* W = A.ws + WS_W;
    int idx, stride, KD, n0, k0, kind = 0; size_t soff = 0, doff;
#define TILE_(ND_, it_) do { n0 = ((it_) % ((ND_) / 32)) * 32; k0 = ((it_) / ((ND_) / 32)) * 64; } while (0)
    if (slot < BG_NFFN) {
        const int lh = 3 + slot / 16896, r = slot % 16896;
        if (r < 11264) { idx = 7; soff = (size_t)lh * DM * (2 * FF); stride = 2 * FF; KD = DM; doff = W_GU(lh >> 1, lh & 1); TILE_(2 * FF, r); kind = 1; }
        else { idx = 8; soff = (size_t)lh * FF * DM; stride = DM; KD = FF; doff = W_DN(lh >> 1, lh & 1); TILE_(DM, r - 11264); }
    } else {
        int r = slot - BG_NFFN;
        if (r < 2048) { idx = 37; stride = DM; KD = DM; doff = W_RW_WO; TILE_(DM, r); }
        else if ((r -= 2048) < 1280) { idx = 38; stride = 1088; KD = DM; doff = W_ML_WD; TILE_(1280, r); kind = 2; }
        else if ((r -= 1280) < 1792) { idx = 40; stride = 3072; KD = 512; doff = W_ML_BT3; TILE_(7168, r); kind = 3; }
        else if ((r -= 1792) < 2048) { idx = 43; stride = DM; KD = DM; doff = W_ML_WO; TILE_(DM, r); }
        else if ((r -= 2048) < 4096) { idx = 44; stride = 2 * DM; KD = DM; doff = W_GQ_QKV; TILE_(2 * DM, r); }
        else { r -= 4096; idx = 47; stride = DM; KD = DM; doff = W_GQ_WO; TILE_(DM, r); }
    }
#undef TILE_
    bf16_t* dp = (bf16_t*)(W + doff) + (size_t)n0 * KD + k0;
    const int kr = lane >> 3, n = n0 + (lane & 7) * 4;
    int col = n;
    if (kind == 1) col = ((n >> 7) & 1) * FF + (n >> 8) * 128 + (n & 127);
    if (kind == 2 && n0 >= 1088) {
        const u32x4 z = (u32x4){0u, 0u, 0u, 0u};
#pragma unroll
        for (int j = 0; j < 4; ++j) *(u32x4*)(dp + (size_t)((lane >> 3) + 8 * j) * KD + 8 * (lane & 7)) = z;
        return false; }
    if (kind == 3 && n0 >= 3072) { idx = 42; stride = 4096; col = n - 3072; }
    const float* sp = ain_(A, idx) + soff + (size_t)(k0 + 8 * kr) * stride + col;
#pragma unroll
    for (int i = 0; i < 8; ++i) v[i] = *(const f32x4*)(sp + (size_t)i * stride);
    if (ISSUE_ONLY) { dstp = dp; Kd = KD; return true; }
    conv_tile_store(v, dp, KD, scr, lane); return false;
}
__global__ void __launch_bounds__(NTHR, 2) fwd_kernel(Args A) {
    extern __shared__ __attribute__((aligned(16))) unsigned char lds_raw[];
    Ctx F;
    F.lds = (LAS unsigned char*)lds_raw;
    F.tid = threadIdx.x; F.lane = F.tid & 63; F.wave = __builtin_amdgcn_readfirstlane(F.tid >> 6);
    F.bid = blockIdx.x; F.G = gridDim.x; F.gw = F.bid * NWAVES + F.wave; F.NGW = F.G * NWAVES;
    volatile LAS unsigned* MISC = (volatile LAS unsigned*)(F.lds + MISC_OFF);
    if (F.tid < 32) MISC[F.tid] = 0u;
    __syncthreads();
    const int lo = A.ph_lo, hi = A.ph_hi;
#ifdef STAMP_PH
    if (F.bid == 0 && F.tid == 0) { const unsigned long long t_ = wall_clock64(); MISC[16] = (unsigned)t_; MISC[17] = (unsigned)(t_ >> 32); }
#endif
    XcdBarrier bar; bar.bar = (unsigned*)(A.ws + WS_CTL) + CW_BAR + A.li * XCD_BAR_WORDS; bar.x = 0; bar.st = MISC + 8;
    if (hi - lo > 1) bar = xcd_barrier_post((unsigned*)(A.ws + WS_CTL) + CW_BAR + A.li * XCD_BAR_WORDS, MISC + 8);
#ifndef PH_MIN
#define PH_MIN 0
#define PH_MAX 1000
#endif
#define IN(k) ((k) >= PH_MIN && (k) <= PH_MAX && lo <= (k) && (k) < hi)
#define BOTH(k) (IN(k) && IN((k) + 1))
#ifdef STAMP_PH
#define PHASE(k) if ((k) == STAMP_PH + 1) { if (F.bid == 0 && F.tid == 0) { const unsigned long long t_ = wall_clock64(); MISC[18] = (unsigned)t_; MISC[19] = (unsigned)(t_ >> 32); } } if (IN(k))
#else
#define PHASE(k) if (IN(k))
#endif
#define GRID_BAR() xcd_barrier(bar)
#define ws (A.ws)
#define AIN(i) ain_(A, (i))
#define MODS ((float*)(ws + WS_MODS))
#define TW ((f32x2*)(ws + WS_TW))
#define HIDA ((bf16_t*)(ws + WS_HIDA))
#define ADAP ((float*)(ws + WS_ADAP))
#define X ((bf16_t*)(ws + WS_X))
#define NBF ((bf16_t*)(ws + WS_NB))
#define ACT ((bf16_t*)(ws + WS_ACT))
#define mix (ws + WS_MIX)
#define PART ((bf16_t*)(ws + WS_PART))

    PHASE(0) {
        { const float* xin = AIN(0); const float* cin = AIN(2);
          for (size_t i = (size_t)F.bid * NTHR + F.tid; i < (size_t)ROWS * (DM / 4); i += (size_t)F.G * NTHR) {
              const int r = (int)(i / (DM / 4)), c4 = (int)(i % (DM / 4)), b = r / TPB, t = r % TPB;
              const float* src = (t < CTXL) ? cin + ((size_t)b * CTXL + t) * DM : xin + ((size_t)b * SEQ + (t - CTXL)) * DM;
              const f32x4 v_ = ((const f32x4*)src)[c4]; u32x2 w_; w_.x = cvt_pk_bf16(v_.x, v_.y); w_.y = cvt_pk_bf16(v_.z, v_.w); ((u32x2*)(X + (size_t)r * DM))[c4] = w_; } }
        for (int k = F.bid * NTHR + F.tid; k < 8192; k += F.G * NTHR) { float sn, cs; sincospif((float)k * (1.0f / 4096.0f), &sn, &cs); TW[k] = (f32x2){cs, -sn}; }
        { LAS float* sl = (LAS float*)(F.lds + 73728);
          for (int i = F.tid; i < 3 * DM; i += NTHR) { const float v = (i < 2 * DM) ? AIN(1)[i] : AIN(3)[i - 2 * DM]; sl[i] = v / (1.0f + expf(-v)); }
          __syncthreads(); }
        { LAS float* scr = (LAS float*)(F.lds + F.wave * 8448);
          unsigned char* W = ws + WS_W;
#define LD4(p_) (*(const f32x4*)(p_))
          const f32x4 z4 = (f32x4){0.f, 0.f, 0.f, 0.f};
#pragma unroll 1
          for (int lh = 0; lh < 3; ++lh) {
              const float* sg = AIN(7) + (size_t)lh * DM * (2 * FF); const float* sd = AIN(8) + (size_t)lh * FF * DM;
              CONV_JOB(2 * FF, DM, W + W_GU(lh >> 1, lh & 1), [=](int n, int k) { const int sn = ((n >> 7) & 1) * FF + (n >> 8) * 128 + (n & 127); return LD4(sg + (size_t)k * (2 * FF) + sn); });
              CONV_JOB(DM, FF, W + W_DN(lh >> 1, lh & 1), [=](int n, int k) { return LD4(sd + (size_t)k * DM + n); });
          }
          { const float* s = AIN(9);  CONV_JOB(3 * DM, DM, W + W_HY_IN, [=](int n, int k) { return LD4(s + (size_t)k * (3 * DM) + n); }); }
          { const float* s = AIN(20); CONV_JOB(DM, DM, W + W_HY_OUT, [=](int n, int k) { return LD4(s + (size_t)k * DM + n); }); }
          { const float* s = AIN(17); CONV_JOB(4 * DM, 256, W + W_HY_F3, [=](int n, int k) { const int seg = k >> 6; if (seg == 3) return z4; const f32x4 w = LD4(s + (size_t)(k & 63) * (4 * DM) + n);
                const f32x4 h = (f32x4){bf_hi(w.x), bf_hi(w.y), bf_hi(w.z), bf_hi(w.w)}; return seg == 2 ? w - h : h; }); }
          { const float* s = AIN(23); const float* w1 = AIN(25); const float* a1 = AIN(28); const float* g1 = AIN(30);
            CONV_JOB(6912, DM, W + W_RW_BT1, [=](int n, int k) { if (n < 3 * DM) return LD4(s + ((size_t)(n >> 11) * DM + k) * DM + (n & (DM - 1)));
                const int j = n - 3 * DM, blk = j >> 8, jj = j & 255; if (blk == 2) return LD4(g1 + (size_t)k * 256 + jj); if (jj >= 192) return z4;
                const int d = jj / 96, e = jj - d * 96; return LD4((blk ? a1 : w1) + ((size_t)d * DM + k) * 96 + e); }); }
          { const float* w2 = AIN(26); const float* a2 = AIN(29); const float* g2 = AIN(31);
            CONV_JOB(10240, 256, W + W_RW_BT2, [=](int n, int k) { if (n >= 4 * DM) return LD4(g2 + (size_t)k * DM + (n - 4 * DM));
                const int blk = n >> 12, nn = n & 4095, d = nn >> 11, c = nn & (DM - 1), kk = k - 96 * d; if (kk < 0 || kk >= 96) return z4;
                return LD4((blk ? a2 : w2) + ((size_t)d * 96 + kk) * DM + c); }); }
#undef LD4
        }
        {
        const float* fw1 = AIN(13); const float* fb1 = AIN(14); const float* fw2 = AIN(15); const float* fb2 = AIN(16); const float* sf = AIN(18);
        for (int m = F.gw; m < 4352; m += F.NGW) {
            const int L = (m < 4096) ? 4096 : 256, mm = (m < 4096) ? m : m - 4096, j = F.lane;
            const float wv = (float)(6.283185307179586 / (double)L) * (float)mm;
            float z = 0.f;
            if (j == 0) z = (float)mm / (float)(L - 1);
            else if (j <= 16) z = cosf((1e-4f + (float)(j - 1) * ((15.0f - 1e-4f) / 15.0f)) * wv);
            else if (j <= 32) z = -sinf((1e-4f + (float)(j - 17) * ((15.0f - 1e-4f) / 15.0f)) * wv);
            float acc = fb1[j];
#pragma unroll
            for (int i = 0; i < 33; ++i) acc += __shfl(z, i) * fw1[i * 64 + j];
            const float h1 = sinf(sf[j] * acc);
            acc = fb2[j];
#pragma unroll
            for (int i = 0; i < 64; ++i) acc += __shfl(h1, i) * fw2[i * 64 + j];
            const float h2 = sinf(sf[64 + j] * acc);
            const float hh = bf_hi(h2);
            bf16_t* o = HIDA + (size_t)m * 256;
            const bf16_t bh = (bf16_t)(cvt_pk_bf16(hh, 0.f) & 0xffffu), bl = (bf16_t)(cvt_pk_bf16(h2 - hh, 0.f) & 0xffffu);
            o[j] = bh; o[64 + j] = bl; o[128 + j] = bh; o[192 + j] = 0; }
        }
        {
          LAS float* sl = (LAS float*)(F.lds + 73728);
          const float* aw = AIN(4); unsigned* qctr = (unsigned*)(ws + WS_CTL) + 200000;
          for (;;) {
              if (F.tid == 0) MISC[24] = __hip_atomic_fetch_add(qctr, 1u, __ATOMIC_RELAXED, __HIP_MEMORY_SCOPE_AGENT);
              __syncthreads(); const int unit = (int)MISC[24]; __syncthreads();
              if (unit >= 4 * 9 * 16) break;
              const int l = unit / 144, rem = unit % 144, cc = rem / 16, kc = rem % 16, col = cc * 2048 + F.tid * 4;
              f32x4 a0 = (f32x4){0.f, 0.f, 0.f, 0.f}, a1 = a0, a2 = a0;
              const float* wp = aw + ((size_t)l * DM + kc * 128) * NADA + col;
#pragma unroll 8
              for (int k = 0; k < 128; ++k) { const f32x4 w = *(const f32x4*)(wp + (size_t)k * NADA); const int kk = kc * 128 + k;
                  a0 += w * sl[kk]; a1 += w * sl[DM + kk]; a2 += w * sl[2 * DM + kk]; }
              float* op = ADAP + ((size_t)(kc * 4 + l) * 3) * NADA + col;
              *(f32x4*)op = a0; *(f32x4*)(op + NADA) = a1; *(f32x4*)(op + 2 * NADA) = a2; }
        }
        if (BOTH(0)) GRID_BAR();
    }
    PHASE(1) {
        const float* ab = AIN(5);
        for (int i = F.bid * NTHR + F.tid; i < 4 * 3 * NADA; i += F.G * NTHR) {
            const int l = i / (3 * NADA), n = i % NADA; float s = ab[(size_t)l * NADA + n];
#pragma unroll
            for (int kc = 0; kc < 16; ++kc) s += ADAP[(size_t)kc * 12 * NADA + i];
            MODS[i] = s; }
        if (BOTH(1)) GRID_BAR();
    }
    FFN_PHASES(2, 0, 0, 0, 0);
    { const float* mods_l = MODS;
      bf16_t* U = (bf16_t*)(mix + HY_U); float* VXT = (float*)(mix + HY_VXT); float* HFT = (float*)(mix + HY_HFT); bf16_t* ZT = (bf16_t*)(mix + HY_U);
      PHASE(5) { const float* g = AIN(6) + (size_t)(0 * 3 + 1) * DM;
          for (int r = F.gw; r < ROWS; r += F.NGW) { f32x4 y[8]; modnorm_row(X, g, mods_l, 1, r, F.lane, y, PART, 11); store_row_bf16(NBF + (size_t)r * DM, F.lane, y); }
          { pg8::EpiHyF E{HFT, HFT + (size_t)8192 * 4096}; RUN_GEMM(pg8::EpiHyF, E, HIDA, ws + WS_W + W_HY_F3, 256, 17, 32, 0, 0, 1, 0); }
          if (BOTH(5)) GRID_BAR(); }
      PHASE(6) { pg8::EpiBf16B E{U, 3 * DM, AIN(10)};
          RUN_GEMM(pg8::EpiBf16B, E, NBF, ws + WS_W + W_HY_IN, DM, NPAN, 24, 0, 0, 1, 0); if (BOTH(6)) GRID_BAR(); }
      PHASE(7) { __syncthreads(); for (int unit = F.gw; unit < 2 * 68 * 96; unit += F.NGW) hyena_conv3_unit(unit, U, AIN(11), AIN(12), VXT, (LAS float*)(F.lds + F.wave * 16640), F.lane); if (BOTH(7)) GRID_BAR(); }
      PHASE(8) { __syncthreads();
          { LAS f32x2* twl = (LAS f32x2*)(F.lds + 69632);
            for (int e = F.tid; e < FFT_TW; e += NTHR) { const int s = e < 2048 ? 0 : (e < 2560 ? 1 : (e < 2688 ? 2 : (e < 2720 ? 3 : (e < 2728 ? 4 : 5)))); const int ix = (e - fft_toff(s)) << (2 * s);
                twl[e] = TW[ix]; twl[FFT_TW + e] = TW[2 * ix]; twl[2 * FFT_TW + e] = TW[3 * ix]; }
            __syncthreads(); }
          { const LAS f32x2* twl = (const LAS f32x2*)(F.lds + 69632);
            for (int c = F.bid; c < DM; c += F.G) hyena_channel<12, NTHR, false>(F.lds, twl, (LAS float*)(F.lds + 135168), F.tid, c, VXT, HFT, AIN(19), ZT);
            __syncthreads();
            for (int c = F.gw; c < DM; c += F.NGW) hyena_channel<8, 64, true>(F.lds + F.wave * 4352, twl, nullptr, F.lane, c, VXT, HFT + (size_t)8192 * 4096, AIN(19), ZT); }
          if (BOTH(8)) GRID_BAR(); }
      PHASE(9) { __syncthreads();
          LAS bf16_t* tile = (LAS bf16_t*)F.lds;
          for (int unit = F.bid; unit < 136 * 32; unit += F.G) { const int r0 = (unit % 136) * 64, c0 = (unit / 136) * 64;
#pragma unroll
              for (int k = 0; k < 8; ++k) { const int cl = 8 * k + (F.tid >> 6); tile[cl * 66 + F.lane] = ZT[(size_t)(c0 + cl) * ROWS + r0 + F.lane]; }
              __syncthreads();
              { const int rl = F.tid >> 3, cs = (F.tid & 7) * 8; unsigned w[4];
#pragma unroll
                for (int e = 0; e < 4; ++e) w[e] = (unsigned)tile[(cs + 2 * e) * 66 + rl] | ((unsigned)tile[(cs + 2 * e + 1) * 66 + rl] << 16);
                *(u32x4*)(NBF + (size_t)(r0 + rl) * DM + c0 + cs) = (u32x4){w[0], w[1], w[2], w[3]}; }
              __syncthreads(); }
          if (BOTH(9)) GRID_BAR(); }
      PHASE(10) { pg8::EpiResid E{X, mods_l, 5, A.pad ? 0.f : 1.0f, AIN(21)};
          RUN_GEMM(pg8::EpiResid, E, NBF, ws + WS_W + W_HY_OUT, DM, 32, 8, 0, 0, 1, 1, 2, 8, 0, 0, 4, 2); if (BOTH(10)) GRID_BAR(); }
    }
    FFN_PHASES(11, 0, 2, 0, 4);
    FFN_PHASES(14, 1, 0, 0, 11);
    { const float* mods_l = MODS + (size_t)1 * 3 * NMOD * DM;
      bf16_t* XS = (bf16_t*)(mix + RW_XS); bf16_t* HLF = (bf16_t*)(mix + RW_HLF);
      bf16_t* RKV = (bf16_t*)(mix + RW_RKV); bf16_t* LM = (bf16_t*)(mix + RW_LM); bf16_t* DEC = (bf16_t*)(mix + RW_DEC); bf16_t* ASIG = (bf16_t*)(mix + RW_ASIG); float* Y = (float*)(mix + RW_Y);
      bf16_t* Gf = (bf16_t*)(mix + RW_G);
      PHASE(17) { const float* g = AIN(6) + (size_t)(1 * 3 + 1) * DM;
          for (int r = F.gw; r < ROWS; r += F.NGW) { f32x4 y[8]; modnorm_row(X, g, mods_l, 1, r, F.lane, y, PART, 11); store_row_bf16(HLF + (size_t)r * DM, F.lane, y); }
          if (BOTH(17)) GRID_BAR(); }
      PHASE(18) { for (int r = F.gw; r < ROWS; r += F.NGW) rwkv_shift_row(HLF, AIN(22), XS, r, F.lane); if (BOTH(18)) GRID_BAR(); }
      PHASE(19) {
          pg8::EpiRw1 E{RKV, LM}; RUN_GEMM(pg8::EpiRw1, E, XS, ws + WS_W + W_RW_BT1, DM, NPAN, 8, 0 * NPAN, 0, 1, 0, NPAN, 8, 2 * NPAN, 8, 1, 0, NPAN, 8, 3 * NPAN, 16, 1, 0, NPAN, 1, 1 * NPAN, 24, 1, 0, NPAN, 1, 4 * NPAN, 25, 1, 0, NPAN, 1, 5 * NPAN, 26, 1, 0);
          if (BOTH(19)) GRID_BAR(); }
      PHASE(20) { pg8::EpiRw2 E{DEC, ASIG, Gf, AIN(24), AIN(27)};
          RUN_GEMM(pg8::EpiRw2, E, LM, ws + WS_W + W_RW_BT2, 256, NPAN, 16, 0 * NPAN, 0, 1, 0, NPAN, 16, 1 * NPAN, 16, 1, 0, NPAN, 8, 2 * NPAN, 32, 1, 0); if (BOTH(20)) GRID_BAR(); }
      PHASE(21) {
          int nslot_done = 0;
          f32x4 bv[8]; bf16_t* bdst = nullptr; int bKd = 0; bool bpend = false;
          for (int unit = F.bid; unit < 256; unit += F.G) {
              const int first = (unit == F.bid);
              auto bgf = [&](int ck, int w4) { if (!first) return; LAS float* scr = (LAS float*)(F.lds + 98304 + w4 * 8448);
                  if (bpend) { conv_tile_store(bv, bdst, bKd, scr, F.lane); bpend = false; } };
              auto bg = [&](int ck, int w4) { if (!first) return; LAS float* scr = (LAS float*)(F.lds + 98304 + w4 * 8448);
                  const int slot = ck * (F.G * 4) + F.bid * 4 + w4;
                  bpend = bg_convert_slot<true>(A, slot, scr, F.lane, bv, bdst, bKd); };
              rwkv_scan_unit(F, unit, DEC, ASIG, AIN(32), AIN(33), RKV, Y, bgf, bg);
              if (first) nslot_done = (TPB / 32) * F.G * 4; }
          if (F.wave >= 4 && bpend) conv_tile_store(bv, bdst, bKd, (LAS float*)(F.lds + 98304 + (F.wave - 4) * 8448), F.lane);
          __syncthreads();
          { f32x4 tv[8]; bf16_t* td = nullptr; int tk = 0;
            for (int slot = nslot_done + F.gw; slot < BG_NSLOTS; slot += F.NGW) bg_convert_slot<false>(A, slot, (LAS float*)(F.lds + F.wave * 8448), F.lane, tv, td, tk); }
          if (BOTH(21)) GRID_BAR(); }
      PHASE(22) { for (int r = F.gw; r < ROWS; r += F.NGW) rwkv_readout_row(Y, RKV, ASIG, AIN(33), Gf, AIN(34), AIN(35), AIN(36), NBF, r, F.lane); if (BOTH(22)) GRID_BAR(); }
      PHASE(23) { pg8::EpiResid E{X, mods_l, 5, A.pad ? 0.f : 1.0f, nullptr};
          RUN_GEMM(pg8::EpiResid, E, NBF, ws + WS_W + W_RW_WO, DM, 32, 8, 0, 0, 1, 1, 2, 8, 0, 0, 4, 2); if (BOTH(23)) GRID_BAR(); }
    }
    FFN_PHASES(24, 1, 2, 0, 4);
    FFN_PHASES(27, 2, 0, 0, 11);
    { const float* mods_l = MODS + (size_t)2 * 3 * NMOD * DM;
      bf16_t* RAW = (bf16_t*)(mix + ML_RAW); bf16_t* CN = (bf16_t*)(mix + ML_CN); bf16_t* QRAW = (bf16_t*)(mix + ML_QRAW);
      bf16_t* Qb = (bf16_t*)(mix + ML_Q); bf16_t* Kb = (bf16_t*)(mix + ML_K); bf16_t* Vb = (bf16_t*)(mix + ML_V);
      PHASE(30) { const float* g = AIN(6) + (size_t)(2 * 3 + 1) * DM;
          for (int r = F.gw; r < ROWS; r += F.NGW) { f32x4 y[8]; modnorm_row(X, g, mods_l, 1, r, F.lane, y, PART, 11); store_row_bf16(NBF + (size_t)r * DM, F.lane, y); }
          if (BOTH(30)) GRID_BAR(); }
      PHASE(31) { pg8::EpiBf16B E{RAW, 1280, nullptr};
          RUN_GEMM(pg8::EpiBf16B, E, NBF, ws + WS_W + W_ML_WD, DM, NPAN, 5, 0, 0, 1, 0); if (BOTH(31)) GRID_BAR(); }
#define MLA_ROPE_TABLE() do { __syncthreads(); LAS f32x2* rt_ = (LAS f32x2*)F.lds;     \
          for (int e_ = F.tid; e_ < 64 * 16; e_ += NTHR) { float sn_, cs_; sincosf((float)(e_ >> 4) * rope_invfreq(e_ & 15, 16), &sn_, &cs_); rt_[e_] = (f32x2){cs_, sn_}; } __syncthreads(); } while (0)
      PHASE(32) { MLA_ROPE_TABLE(); for (int r = F.gw; r < ROWS; r += F.NGW) mla_row_a(RAW, AIN(39), AIN(41), CN, CN + (size_t)ROWS * 512, Kb, (const LAS f32x2*)F.lds, r, F.lane); if (BOTH(32)) GRID_BAR(); }
      PHASE(33) { pg8::EpiMla3 E{QRAW, Kb, Vb};
          RUN_GEMM(pg8::EpiMla3, E, CN, ws + WS_W + W_ML_BT3, 512, NPAN, 12, 0, 0, 1, 0, NPAN, 16, NPAN, 12, 1, 0); if (BOTH(33)) GRID_BAR(); }
      PHASE(34) { MLA_ROPE_TABLE(); for (int r = F.gw; r < ROWS; r += F.NGW) mla_row_q(QRAW, Qb, (const LAS f32x2*)F.lds, r, F.lane); if (BOTH(34)) GRID_BAR(); }
#undef MLA_ROPE_TABLE
      PHASE(35) { const int vc = (F.G % 8 == 0) ? (F.bid % 8) * (F.G / 8) + F.bid / 8 : F.bid;
          for (int i = 0;; ++i) { const int L = i * F.G + vc; if (L >= 544) break;
              int b, h, q0, seq; if (L < 512) { b = L >> 8; h = (L & 255) >> 4; q0 = b * TPB + CTXL + (L & 15) * 256; seq = TPB; } else { const int u = L - 512; b = u >> 4; h = u & 15; q0 = b * TPB; seq = CTXL; }
              __syncthreads();
              att::attn_dense_body<192, 3072, 3072, 2048, 2048>(Qb + (size_t)q0 * 3072 + h * 192, Kb + (size_t)b * TPB * 3072 + h * 192, Vb + (size_t)b * TPB * 2048 + h * 128, NBF + (size_t)q0 * DM + h * 128, seq, (char*)lds_raw); }
          if (BOTH(35)) GRID_BAR(); }
      PHASE(36) { pg8::EpiResid E{X, mods_l, 5, A.pad ? 0.f : 1.0f, nullptr};
          RUN_GEMM(pg8::EpiResid, E, NBF, ws + WS_W + W_ML_WO, DM, 32, 8, 0, 0, 1, 1, 2, 8, 0, 0, 4, 2); if (BOTH(36)) GRID_BAR(); }
    }
    FFN_PHASES(37, 2, 2, 0, 4);
    FFN_PHASES(40, 3, 0, 0, 11);
    { const float* mods_l = MODS + (size_t)3 * 3 * NMOD * DM;
      bf16_t* RAW = (bf16_t*)(mix + GQ_RAW); bf16_t* Qb = (bf16_t*)(mix + GQ_Q); bf16_t* Kb = (bf16_t*)(mix + GQ_K); bf16_t* Vb = (bf16_t*)(mix + GQ_V);
      PHASE(43) { const float* g = AIN(6) + (size_t)(3 * 3 + 1) * DM;
          for (int r = F.gw; r < ROWS; r += F.NGW) { f32x4 y[8]; modnorm_row(X, g, mods_l, 1, r, F.lane, y, PART, 11); store_row_bf16(NBF + (size_t)r * DM, F.lane, y); }
          if (BOTH(43)) GRID_BAR(); }
      PHASE(44) { pg8::EpiBf16B E{RAW, 4096, nullptr};
          RUN_GEMM(pg8::EpiBf16B, E, NBF, ws + WS_W + W_GQ_QKV, DM, NPAN, 16, 0, 0, 1, 0); if (BOTH(44)) GRID_BAR(); }
      PHASE(45) { __syncthreads();
          { LAS f32x2* rt = (LAS f32x2*)F.lds;
            for (int e = F.tid; e < 64 * 32; e += NTHR) { float sn, cs; sincosf((float)(e >> 5) * rope_invfreq(e & 31, 32), &sn, &cs); rt[e] = (f32x2){cs, sn}; }
            __syncthreads(); }
          for (int r = F.gw; r < ROWS; r += F.NGW) gqa_row(RAW, AIN(45), AIN(46), Qb, Kb, Vb, (const LAS f32x2*)F.lds, r, F.lane);
          if (BOTH(45)) GRID_BAR(); }
      PHASE(46) { const int vc = (F.G % 8 == 0) ? (F.bid % 8) * (F.G / 8) + F.bid / 8 : F.bid;
          for (int i = 0;; ++i) { const int L = i * F.G + vc; if (L >= 512) break;
              const int b = L >> 8, h = (L & 255) >> 4, q0 = b * TPB + CTXL + (L & 15) * 256;
              __syncthreads();
#ifdef STAMP_PH
              att::attn_dense_body<128, 2048, 1024, 1024, 2048>(
#else
              att::attn_dense_body2<128, 2048, 1024, 1024, 2048, 2>(
#endif
                  Qb + (size_t)q0 * 2048 + h * 128, Kb + (size_t)b * TPB * 1024 + (h >> 1) * 128, Vb + (size_t)b * TPB * 1024 + (h >> 1) * 128, NBF + (size_t)q0 * DM + h * 128, TPB, (char*)lds_raw); }
          if (BOTH(46)) GRID_BAR(); }
      PHASE(47) { pg8::EpiResid E{X, mods_l, 5, A.pad ? 0.f : 1.0f, nullptr};
          RUN_GEMM(pg8::EpiResid, E, NBF, ws + WS_W + W_GQ_WO, DM, 32, 8, 0, 0, 1, 1); if (BOTH(47)) GRID_BAR(); }
    }
    FFN_PHASES(48, 3, 2, 1, 0);
#ifdef EXTRA_BARS
    if (IN(51) && hi - lo > 1) { for (int eb = 0; eb < EXTRA_BARS; ++eb) GRID_BAR(); }
#endif
    PHASE(51) {
        const f32x4* fg = (const f32x4*)AIN(48) + F.lane;
        for (int i = F.gw; i < NB * SEQ; i += F.NGW) {
            const int b = i / SEQ, t = i % SEQ; const bf16_t* xr = X + ((size_t)b * TPB + CTXL + t) * DM + 4 * F.lane;
            f32x4 y[8]; float ss = 0.f;
#pragma unroll
            for (int j = 0; j < 8; ++j) { y[j] = ld4bf(xr + 256 * j); ss += (y[j].x * y[j].x + y[j].y * y[j].y) + (y[j].z * y[j].z + y[j].w * y[j].w); }
            const float rinv = rsqrtf(wave_sum(ss) * (1.0f / DM) + 1e-6f);
            f32x4* o = (f32x4*)(A.out + (size_t)i * DM) + F.lane;
#pragma unroll
            for (int j = 0; j < 8; ++j) o[64 * j] = y[j] * rinv * fg[64 * j];
        }
    }
#ifdef STAMP_PH
    __syncthreads(); if (F.bid == 0 && F.tid == 0) { const unsigned long long t0_ = ((unsigned long long)MISC[17] << 32) | MISC[16], t1_ = ((unsigned long long)MISC[19] << 32) | MISC[18]; int z_ = 0; asm volatile("" : "+s"(z_)); float* o_ = *(float* const*)((const char*)&A.out + z_); o_[0] = (float)(t1_ - t0_) * 0.01f; }
#endif
#undef IN
#undef BOTH
#undef GRID_BAR
#undef AIN
#undef ws
#undef MODS
#undef TW
#undef HIDA
#undef ADAP
#undef X
#undef NBF
#undef ACT
#undef mix
#undef PART
}

#ifndef MK_PER_PHASE
#define MK_PER_PHASE 0
#endif
extern "C" void kernel_launch(void* const* d_in, const int* in_sizes, int n_in, void* d_out, int out_size, void* d_ws, size_t ws_size, hipStream_t stream) {
    static int grid = 0;
    if (grid == 0) {
        if (n_in != 49 || ws_size < WS_END) { fprintf(stderr, "kernel_launch: expected 49 inputs and >= %zu bytes of workspace; got %d, %zu\n", (size_t)WS_END, n_in, ws_size); grid = -1; return; }
        int dev = 0, cus = 0;
        if (hipGetDevice(&dev) != hipSuccess || hipDeviceGetAttribute(&cus, hipDeviceAttributeMultiprocessorCount, dev) != hipSuccess) { grid = -1; return; }
        if (hipFuncSetAttribute((const void*)fwd_kernel, hipFuncAttributeMaxDynamicSharedMemorySize, LDS_BYTES) != hipSuccess) { fprintf(stderr, "kernel_launch: hipFuncSetAttribute failed\n"); grid = -1; return; }
        int per_cu = 0;
        if (hipOccupancyMaxActiveBlocksPerMultiprocessor(&per_cu, (const void*)fwd_kernel, NTHR, LDS_BYTES) != hipSuccess || per_cu < 1) fprintf(stderr, "kernel_launch: occupancy query reports %d\n", per_cu);
        (void)hipGetLastError();
        grid = cus;
    }
    if (grid < 0) return;
    (void)hipMemsetAsync((char*)d_ws + WS_CTL, 0, CTL_ZERO_BYTES, stream);
    Args a{};
    for (int i = 0; i < 49; ++i) a.in[i] = (const float*)d_in[i];
    a.out = (float*)d_out; a.ws = (unsigned char*)d_ws;
#if MK_PER_PHASE
    for (int p = 0; p < N_PHASES; ++p) { a.ph_lo = p; a.ph_hi = p + 1; hipLaunchKernelGGL(fwd_kernel, dim3(grid), dim3(NTHR), LDS_BYTES, stream, a); }
#elif defined(PROBE_PHASES)
    { const int pp[] = {PROBE_PHASES}; const int np = (int)(sizeof(pp) / sizeof(int)); int cur = 0, li = 0;
      for (int i = 0; i < np; ++i) { if (pp[i] > cur) { a.ph_lo = cur; a.ph_hi = pp[i]; a.li = li++; a.pad = 0; hipLaunchKernelGGL(fwd_kernel, dim3(grid), dim3(NTHR), LDS_BYTES, stream, a); }
          a.ph_lo = pp[i]; a.ph_hi = pp[i] + 1; a.li = li++; a.pad = 1; hipLaunchKernelGGL(fwd_kernel, dim3(grid), dim3(NTHR), LDS_BYTES, stream, a); cur = pp[i]; }
      a.ph_lo = cur; a.ph_hi = N_PHASES; a.li = li++; a.pad = 0; hipLaunchKernelGGL(fwd_kernel, dim3(grid), dim3(NTHR), LDS_BYTES, stream, a); }
#else
    a.ph_lo = 0; a.ph_hi = N_PHASES; a.li = 0; hipLaunchKernelGGL(fwd_kernel, dim3(grid), dim3(NTHR), LDS_BYTES, stream, a);
#endif
}
```

```cpp
#include <hip/hip_runtime.h>
#include <stdint.h>
#include <stdio.h>

#define LAS __attribute__((address_space(3)))
typedef unsigned short bf16_t;
typedef short bf16x8 __attribute__((ext_vector_type(8)));
typedef short s16x4 __attribute__((ext_vector_type(4)));
typedef float f32x2 __attribute__((ext_vector_type(2)));
typedef float f32x4 __attribute__((ext_vector_type(4)));
typedef float f32x16 __attribute__((ext_vector_type(16)));
typedef unsigned u32x2 __attribute__((ext_vector_type(2)));
typedef unsigned u32x4 __attribute__((ext_vector_type(4)));

constexpr int DM = 2048, NB = 2, SEQ = 4096, CTXL = 256, TPB = SEQ + CTXL  , ROWS = NB * TPB  ;
constexpr int NPAN = ROWS / 256  , PPB = TPB / 256  ;
constexpr int FF = 5632, NMOD = 9, NADA = NMOD * DM  ;
constexpr int NWAVES = 8, NTHR = 512;

__device__ __forceinline__ unsigned cvt_pk_bf16(float lo, float hi) { unsigned r; asm("v_cvt_pk_bf16_f32 %0, %1, %2" : "=v"(r) : "v"(lo), "v"(hi)); return r; }
__device__ __forceinline__ float bf2f(unsigned short b) { return __uint_as_float(((unsigned)b) << 16); }
__device__ __forceinline__ f32x4 ld4bf(const bf16_t* p) {
    const u32x2 w = *(const u32x2*)p; return (f32x4){__uint_as_float(w.x << 16), __uint_as_float(w.x & 0xffff0000u), __uint_as_float(w.y << 16), __uint_as_float(w.y & 0xffff0000u)}; }
__device__ __forceinline__ void ld8bf(const bf16_t* p, f32x4& a, f32x4& b) {
    const u32x4 w = *(const u32x4*)p;
    a = (f32x4){__uint_as_float(w.x << 16), __uint_as_float(w.x & 0xffff0000u), __uint_as_float(w.y << 16), __uint_as_float(w.y & 0xffff0000u)};
    b = (f32x4){__uint_as_float(w.z << 16), __uint_as_float(w.z & 0xffff0000u), __uint_as_float(w.w << 16), __uint_as_float(w.w & 0xffff0000u)}; }
__device__ __forceinline__ void st8bf(bf16_t* p, f32x4 a, f32x4 b) { u32x4 w; w.x = cvt_pk_bf16(a.x, a.y); w.y = cvt_pk_bf16(a.z, a.w); w.z = cvt_pk_bf16(b.x, b.y); w.w = cvt_pk_bf16(b.z, b.w); *(u32x4*)p = w; }
__device__ __forceinline__ float wave_sum(float v) {
#pragma unroll
    for (int o = 1; o < 64; o <<= 1) v += __shfl_xor(v, o);
    return v;
}
__device__ __forceinline__ float fast_sigmoid(float x) { return __builtin_amdgcn_rcpf(1.0f + __expf(-x)); }
#define LDS_WAIT() asm volatile("s_waitcnt lgkmcnt(0)" ::: "memory")
#define VM_WAIT() asm volatile("s_waitcnt vmcnt(0)" ::: "memory")

#define XB_TMO      128
#define XB_XCNT(j)  (256  + 64 * (j))
#define XB_XSUB(j)  (1280 + 64 * (j))
#define XB_XGEN(j)  (2304 + 64 * (j))
#define XB_TOP      3328
#define XB_TOPGEN   3392
#define XCD_BAR_WORDS 3456
#define XB_SPIN_CAP (1u << 18)
__device__ __forceinline__ unsigned xb_ld(unsigned* p)              { return __hip_atomic_load(p, __ATOMIC_RELAXED, __HIP_MEMORY_SCOPE_AGENT); }
__device__ __forceinline__ unsigned xb_add(unsigned* p, unsigned v) { return __hip_atomic_fetch_add(p, v, __ATOMIC_RELAXED, __HIP_MEMORY_SCOPE_AGENT); }
__device__ __forceinline__ unsigned xb_xcc_id() { return (unsigned)__builtin_amdgcn_s_getreg((3 << 11) | 20) & 0xFu; }
#define XB_SPIN(cond, bar) do { unsigned _sp = 0; while (cond) { __builtin_amdgcn_s_sleep(1); \
    if ((++_sp & 255u) == 0u) { if (xb_ld(&(bar)[XB_TMO])) break; if (_sp > XB_SPIN_CAP) { atomicAdd(&(bar)[XB_TMO], 1u); break; } } } } while (0)
struct XcdBarrier { unsigned* bar; unsigned x; volatile LAS unsigned* st; };
__device__ __forceinline__ XcdBarrier xcd_barrier_post(unsigned* bar, volatile LAS unsigned* st) {
    XcdBarrier b; b.bar = bar; b.x = xb_xcc_id(); b.st = st;
    if (threadIdx.x == 0) (void)xb_add(&bar[XB_XCNT(b.x)], 1u);
    return b;
}
__device__ __forceinline__ void xcd_barrier_complete(unsigned* bar, unsigned x, unsigned& nloc, unsigned& nx) {
    const unsigned G = gridDim.x * gridDim.y * gridDim.z;
    unsigned sum, cnt, mine, sp = 0u;
    for (;;) {
        sum = 0u; cnt = 0u; mine = 0u;
#pragma unroll
        for (unsigned j = 0; j < 16; ++j) { const unsigned c = xb_ld(&bar[XB_XCNT(j)]); sum += c; cnt += (c > 0u) ? 1u : 0u; mine = (j == x) ? c : mine; }
        if (sum == G) break;
        __builtin_amdgcn_s_sleep(1);
        if ((++sp & 255u) == 0u) { if (xb_ld(&bar[XB_TMO])) break; if (sp > XB_SPIN_CAP) { atomicAdd(&bar[XB_TMO], 1u); break; } }
    }
    nloc = mine > 0u ? mine : 1u; nx = cnt > 0u ? cnt : 1u;
}
__device__ __forceinline__ void xcd_barrier(const XcdBarrier& b) {
    asm volatile("s_waitcnt vmcnt(0)" ::: "memory");
    __syncthreads();
    if (threadIdx.x == 0) {
        unsigned* bar = b.bar;
        __builtin_amdgcn_s_waitcnt(0);
        unsigned nloc = b.st[0], nx = b.st[1];
        if (nloc == 0u) { xcd_barrier_complete(bar, b.x, nloc, nx); b.st[0] = nloc; b.st[1] = nx; }
        const unsigned old = xb_add(&bar[XB_XSUB(b.x)], 1u);
        const unsigned gen = old / nloc;
        if (old + 1u == (gen + 1u) * nloc) {
            __builtin_amdgcn_fence(__ATOMIC_RELEASE, "agent");
            asm volatile("s_waitcnt vmcnt(0)" ::: "memory");
            const unsigned og = xb_add(&bar[XB_TOP], 1u);
            const unsigned tg = og / nx;
            if (og + 1u == (tg + 1u) * nx) xb_add(&bar[XB_TOPGEN], 1u);
            else XB_SPIN(xb_ld(&bar[XB_TOPGEN]) == tg, bar);
            __builtin_amdgcn_fence(__ATOMIC_ACQUIRE, "agent");
            xb_add(&bar[XB_XGEN(b.x)], 1u);
            asm volatile("s_waitcnt vmcnt(0)" ::: "memory");
        } else {
            XB_SPIN(xb_ld(&bar[XB_XGEN(b.x)]) == gen, bar);
            __builtin_amdgcn_fence(__ATOMIC_ACQUIRE, "agent");
            asm volatile("s_waitcnt vmcnt(0)" ::: "memory");
        }
    }
    __syncthreads();
}

namespace pg8 {
constexpr int BM = 256, BK = 64, HALF = 128, HTB = HALF * BK * 2, STAGE_BYTES = 8 * HTB, NXCD = 8;
__host__ __device__ __forceinline__ int lds_byte(int r, int c) { const int st = (r >> 4) * 2 + (c >> 5), rr = r & 15, cc = c & 31, ob = rr * 64 + cc * 2; return st * 1024 + (ob ^ (((ob >> 9) & 1) << 5)); }
__host__ __device__ __forceinline__ void stage_rc(int b, int& R, int& C) { const int st = b / 1024, sb = b % 1024, swz = sb ^ (((sb >> 9) & 1) << 5); R = (st >> 1) * 16 + swz / 64; C = (st & 1) * 32 + (swz % 64) / 2; }
__host__ __device__ __forceinline__ int perm32(int rho) { const int n = rho >> 4, i = rho & 15; return 8 * (i >> 2) + 4 * n + (i & 3); }

struct Unit { int pm, pn, g, lm, ln, ks, ksub; };
struct Gemm { const bf16_t* A; const bf16_t* Bt; int K; };

template <int WGM_, int... V>
struct TSched {
    static constexpr int NG = sizeof...(V) / 6, WGM = WGM_;
    int G, c;
    __device__ __forceinline__ void init(int G_, int c_) { G = G_; c = c_; }
    __device__ __forceinline__ bool next(int i, Unit& u) const {
        constexpr int v[sizeof...(V)] = {V...};
        const int L = i * G + c;
        int g = 0, b = 0, nM = 1, nN = 1, pm0 = 0, pn0 = 0, ks = 1, rm = 0, base = 0;
#pragma unroll
        for (int k = 0; k < NG; ++k) { if (L >= base) { g = k; b = base; nM = v[6 * k]; nN = v[6 * k + 1]; pm0 = v[6 * k + 2]; pn0 = v[6 * k + 3]; ks = v[6 * k + 4]; rm = v[6 * k + 5]; } base += v[6 * k] * v[6 * k + 1] * v[6 * k + 4]; }
        if (L >= base) return false;
        const int nwg = nM * nN; const int lloc = L - b; int wgid = lloc / ks; const int ksub = lloc - wgid * ks;
        { const int q = nwg / NXCD, r = nwg % NXCD, xcd = wgid % NXCD, off = wgid / NXCD; wgid = (xcd < r ? xcd * (q + 1) : r * (q + 1) + (xcd - r) * q) + off; }
        const int nig = WGM * nN, gid = wgid / nig, fm = gid * WGM, gsz = (nM - fm) < WGM ? (nM - fm) : WGM;
        int lm = fm + ((wgid % nig) % gsz); const int ln = (wgid % nig) / gsz;
        if (rm == 1) lm = lm + 1 + (lm >= 16 ? 1 : 0);
        if (rm == 2) lm = lm * PPB;
        u.g = g; u.lm = lm; u.ln = ln; u.pm = pm0 + lm; u.pn = pn0 + ln; u.ks = ks; u.ksub = ksub; return true;
    }
};

template <class Epi, class Sched>
__device__ __forceinline__ void gemm_phase(LAS unsigned char* lds, const Gemm g, const Sched& S, const Epi& E) {
    const int tid = threadIdx.x, wid = __builtin_amdgcn_readfirstlane(tid >> 6), lane = tid & 63, wr = wid >> 2, wc = wid & 3, fr = lane & 15, fq = lane >> 4;
    const int K = g.K, ntf = K / BK;
    unsigned voffA[2], voffB[2];
#pragma unroll
    for (int i = 0; i < 2; ++i) { int R, C; stage_rc(tid * 16 + i * 8192, R, C); const int Rb = (R & ~31) + perm32(R & 31);
        voffA[i] = (unsigned)(R * K + C) * 2u; voffB[i] = (unsigned)(Rb * K + C) * 2u; }
    const size_t kstep = (size_t)(BK * 2);
    const size_t hstep = (size_t)HALF * K * 2;
    const size_t tstep = 2 * hstep;
    const unsigned ldsw = (unsigned)wid * 1024u;
    const int aoff = lds_byte(wr * 64 + fr, fq * 8), boff = lds_byte(wc * 32 + fr, fq * 8);
#define PG8_SA(b, h) (((b) * 2 + (h)) * HTB)
#define PG8_SB(b, h) ((4 + (b) * 2 + (h)) * HTB)
#define PG8_STAGE(bufoff, gbase, voff) do { _Pragma("unroll") for (int _i = 0; _i < 2; ++_i) \
        __builtin_amdgcn_global_load_lds((const unsigned*)((const char*)(gbase) + (voff)[_i]), (LAS unsigned*)(lds + (bufoff) + ldsw + _i * 8192), 16, 0, 0); } while (0)
#define PG8_LDA(dst, b, h) do { _Pragma("unroll") for (int m = 0; m < 4; ++m) _Pragma("unroll") for (int k = 0; k < 2; ++k) dst[m][k] = *(const LAS bf16x8*)(lds + PG8_SA(b, h) + aoff + m * 2048 + k * 1024); } while (0)
#define PG8_LDB(dst, b, h) do { _Pragma("unroll") for (int n = 0; n < 2; ++n) _Pragma("unroll") for (int k = 0; k < 2; ++k) dst[n][k] = *(const LAS bf16x8*)(lds + PG8_SB(b, h) + boff + n * 2048 + k * 1024); } while (0)
#define PG8_MMA(ai, bj, At, Bt) do { __builtin_amdgcn_s_setprio(1); _Pragma("unroll") for (int m = 0; m < 4; ++m) _Pragma("unroll") for (int n = 0; n < 2; ++n) _Pragma("unroll") for (int k = 0; k < 2; ++k) \
        acc[ai][bj][m][n] = __builtin_amdgcn_mfma_f32_16x16x32_bf16(Bt[n][k], At[m][k], acc[ai][bj][m][n], 0, 0, 0); __builtin_amdgcn_s_setprio(0); } while (0)
#define PG8_WAIT_V(n) asm volatile("s_waitcnt vmcnt(" #n ")" ::: "memory")
#define PG8_WAIT_L(n) asm volatile("s_waitcnt lgkmcnt(" #n ")" ::: "memory")
#define PG8_BAR __builtin_amdgcn_s_barrier()
#define PG8_SCHED __builtin_amdgcn_sched_barrier(0)
    Unit cur, nxt; int ui = 0;
    if (!S.next(0, cur)) return;
    f32x4 acc[2][2][4][2];
#pragma unroll
    for (int a = 0; a < 2; ++a)
#pragma unroll
        for (int b = 0; b < 2; ++b)
#pragma unroll
            for (int m = 0; m < 4; ++m)
#pragma unroll
                for (int n = 0; n < 2; ++n) acc[a][b][m][n] = (f32x4){0.f, 0.f, 0.f, 0.f};
    bf16x8 At[4][2], B0[2][2], B1[2][2];
    int nt = ntf / cur.ks;
    const char* cA = (const char*)g.A + (size_t)cur.pm * tstep + (size_t)(cur.ksub * nt) * kstep; const char* cB = (const char*)g.Bt + (size_t)cur.pn * tstep + (size_t)(cur.ksub * nt) * kstep;
    PG8_STAGE(PG8_SB(0, 0), cB, voffB); PG8_STAGE(PG8_SA(0, 0), cA, voffA); PG8_STAGE(PG8_SB(0, 1), cB + hstep, voffB); PG8_STAGE(PG8_SA(0, 1), cA + hstep, voffA);
    if (wr == 1) PG8_BAR;
    PG8_WAIT_V(4); PG8_BAR;
    PG8_STAGE(PG8_SB(1, 0), cB + kstep, voffB); PG8_STAGE(PG8_SA(1, 0), cA + kstep, voffA); PG8_STAGE(PG8_SB(1, 1), cB + hstep + kstep, voffB);
    PG8_WAIT_V(6); PG8_BAR;
    for (;;) {
        const bool has_next = S.next(ui + 1, nxt);
        const int nnt = has_next ? ntf / nxt.ks : nt; const size_t nko = has_next ? (size_t)(nxt.ksub * nnt) * kstep : 0;
        const char* nA = has_next ? (const char*)g.A + (size_t)nxt.pm * tstep + nko : cA; const char* nB = has_next ? (const char*)g.Bt + (size_t)nxt.pn * tstep + nko : cB;
        for (int t = 0; t < nt; t += 2) {
            const bool last = (t == nt - 2);
            const char* a1 = cA + (size_t)(t + 1) * kstep;
            const char* a2 = last ? nA : cA + (size_t)(t + 2) * kstep; const char* b2 = last ? nB : cB + (size_t)(t + 2) * kstep;
            const char* a3 = a2 + kstep; const char* b3 = b2 + kstep;
            PG8_LDB(B0, 0, 0); PG8_SCHED; PG8_LDA(At, 0, 0); PG8_STAGE(PG8_SA(1, 1), a1 + hstep, voffA);
            PG8_WAIT_L(8); PG8_BAR; PG8_WAIT_L(0); PG8_MMA(0, 0, At, B0); PG8_BAR; PG8_SCHED;
            PG8_LDB(B1, 0, 1); PG8_STAGE(PG8_SB(0, 0), b2, voffB);
            PG8_BAR; PG8_WAIT_L(0); PG8_MMA(0, 1, At, B1); PG8_BAR;
            PG8_LDA(At, 0, 1); PG8_STAGE(PG8_SA(0, 0), a2, voffA);
            PG8_BAR; PG8_WAIT_L(0); PG8_MMA(1, 0, At, B0); PG8_BAR; PG8_SCHED;
            PG8_STAGE(PG8_SB(0, 1), b2 + hstep, voffB);
            PG8_WAIT_V(6); PG8_BAR; PG8_MMA(1, 1, At, B1); PG8_BAR;
            PG8_LDB(B0, 1, 0); PG8_SCHED; PG8_LDA(At, 1, 0); PG8_STAGE(PG8_SA(0, 1), a2 + hstep, voffA);
            PG8_WAIT_L(8); PG8_BAR; PG8_WAIT_L(0); PG8_MMA(0, 0, At, B0); PG8_BAR; PG8_SCHED;
            PG8_LDB(B1, 1, 1); PG8_STAGE(PG8_SB(1, 0), b3, voffB);
            PG8_BAR; PG8_WAIT_L(0); PG8_MMA(0, 1, At, B1); PG8_BAR;
            PG8_LDA(At, 1, 1); PG8_STAGE(PG8_SA(1, 0), a3, voffA);
            PG8_BAR; PG8_WAIT_L(0); PG8_MMA(1, 0, At, B0); PG8_BAR; PG8_SCHED;
            PG8_STAGE(PG8_SB(1, 1), b3 + hstep, voffB);
            PG8_WAIT_V(6); PG8_BAR; PG8_MMA(1, 1, At, B1); PG8_BAR;
        }
        E(acc, cur, wr, wc, fr, fq);
        if (!has_next) break;
#pragma unroll
        for (int a = 0; a < 2; ++a)
#pragma unroll
            for (int b = 0; b < 2; ++b)
#pragma unroll
                for (int m = 0; m < 4; ++m)
#pragma unroll
                    for (int n = 0; n < 2; ++n) acc[a][b][m][n] = (f32x4){0.f, 0.f, 0.f, 0.f};
        cur = nxt; cA = nA; cB = nB; nt = nnt; ++ui;
    }
    PG8_WAIT_V(0);
    if (wr == 0) PG8_BAR;
    PG8_BAR;
#undef PG8_SA
#undef PG8_SB
#undef PG8_STAGE
#undef PG8_LDA
#undef PG8_LDB
#undef PG8_MMA
#undef PG8_WAIT_V
#undef PG8_WAIT_L
#undef PG8_BAR
#undef PG8_SCHED
}
}
constexpr size_t MiB = 1u << 20;
constexpr size_t WS_CTL = 0, CTL_ZERO_BYTES = 1 * MiB;
constexpr int CW_BAR = 4096;
constexpr size_t WS_MODS = 1 * MiB;
constexpr size_t WS_TW = 2 * MiB;
constexpr size_t WS_HIDA = 3 * MiB;
constexpr size_t WS_ADAP = 6 * MiB;
constexpr size_t WS_X = 22 * MiB;
constexpr size_t WS_NB = 90 * MiB;
constexpr size_t WS_ACT = 124 * MiB;
constexpr size_t WS_W = 218 * MiB;
constexpr size_t WS_MIX = WS_W + 648 * MiB;
constexpr size_t WS_PART = WS_MIX + 900 * MiB;
constexpr size_t WS_END = WS_PART + 52 * MiB;
__host__ __device__ constexpr size_t W_GU(int l, int h) { return (size_t)(l * 132 + h * 44) * MiB; }
__host__ __device__ constexpr size_t W_DN(int l, int h) { return (size_t)(l * 132 + 88 + h * 22) * MiB; }
constexpr size_t W_HY_IN = 528 * MiB, W_HY_OUT = 552 * MiB, W_HY_F3 = 560 * MiB, W_RW_BT1 = 564 * MiB, W_RW_BT2 = 591 * MiB, W_RW_WO = 596 * MiB,
                 W_ML_WD = 604 * MiB, W_ML_BT3 = 609 * MiB, W_ML_WO = 616 * MiB, W_GQ_QKV = 624 * MiB, W_GQ_WO = 640 * MiB;
constexpr size_t HY_U = 0, HY_VXT = 204 * MiB, HY_HFT = 408 * MiB  ;
constexpr size_t RW_XS = 0, RW_Y = 0  , RW_KK = 136 * MiB, RW_HLF = 204 * MiB, RW_RKV = 272 * MiB, RW_LM = 476 * MiB, RW_DEC = 492 * MiB,
                 RW_ASIG = 628 * MiB, RW_G = 764 * MiB;
constexpr size_t ML_RAW = 0, ML_CN = 43 * MiB, ML_QRAW = 60 * MiB, ML_Q = 162 * MiB, ML_K = 213 * MiB, ML_V = 264 * MiB;
constexpr size_t GQ_RAW = 0, GQ_Q = 136 * MiB, GQ_K = 170 * MiB, GQ_V = 187 * MiB;
constexpr int LDS_BYTES = 147456, MISC_OFF = 131072 + 8192;

namespace pg8 {
#define EPI_ARGS const f32x4 (&acc)[2][2][4][2], const Unit& u, int wr, int wc, int fr, int fq
struct EpiSwiglu {
    bf16_t* act;
    __device__ __forceinline__ void operator()(EPI_ARGS) const {
        const int row0 = u.lm * BM + wr * 64 + fr, col0 = u.ln * 128 + wc * 32 + 8 * fq;
#pragma unroll
        for (int ai = 0; ai < 2; ++ai)
#pragma unroll
            for (int m = 0; m < 4; ++m) {
                float v[8];
#pragma unroll
                for (int n = 0; n < 2; ++n)
#pragma unroll
                    for (int j = 0; j < 4; ++j) { const float a = acc[ai][0][m][n][j], b = acc[ai][1][m][n][j]; v[n * 4 + j] = a * fast_sigmoid(a) * b; }
                u32x4 w; w.x = cvt_pk_bf16(v[0], v[1]); w.y = cvt_pk_bf16(v[2], v[3]); w.z = cvt_pk_bf16(v[4], v[5]); w.w = cvt_pk_bf16(v[6], v[7]);
                __builtin_nontemporal_store(w, (u32x4*)(act + (size_t)(row0 + ai * HALF + m * 16) * FF + col0));
            }
    }
};
struct EpiResid {
    bf16_t* X; const float* mods_l; int gidx; float sc; const float* bias; static constexpr size_t PART_OFF = WS_PART - WS_X;
    __device__ __forceinline__ void operator()(EPI_ARGS) const {
        const int row0 = u.lm * BM + wr * 64 + fr;
        const int rt = (u.lm % PPB == 0) ? 2 : u.lm / PPB;
        const float* gate = mods_l + (size_t)(rt * NMOD + gidx) * DM;
#pragma unroll
        for (int bj = 0; bj < 2; ++bj) {
            const int col = u.ln * BM + bj * HALF + wc * 32 + 8 * fq;
            f32x4 g0 = *(const f32x4*)(gate + col) * sc, g1 = *(const f32x4*)(gate + col + 4) * sc;
            f32x4 b0 = (f32x4){0.f, 0.f, 0.f, 0.f}, b1 = b0;
            if (bias && u.ksub == 0) { b0 = *(const f32x4*)(bias + col); b1 = *(const f32x4*)(bias + col + 4); }
#pragma unroll
            for (int ai = 0; ai < 2; ++ai) {
#pragma unroll
                for (int m = 0; m < 4; ++m) {
                    if (u.ks == 1) {
                        bf16_t* p = X + (size_t)(row0 + ai * HALF + m * 16) * DM + col;
                        f32x4 x0, x1; ld8bf(p, x0, x1);
                        x0 += g0 * (acc[ai][bj][m][0] + b0); x1 += g1 * (acc[ai][bj][m][1] + b1);
                        st8bf(p, x0, x1);
                    } else {
                        const int cr = (u.lm / PPB) * CTXL + wr * 64 + fr + ai * HALF + m * 16;
                        bf16_t* q = (bf16_t*)((char*)X + PART_OFF) + ((size_t)u.ksub * (NB * CTXL) + cr) * DM + col;
                        st8bf(q, g0 * (acc[ai][bj][m][0] + b0), g1 * (acc[ai][bj][m][1] + b1));
                    }
                }
                asm volatile("" ::: "memory");
            }
        }
    }
};
struct EpiF32 {
    float* C; int ldc; const float* bias;
    __device__ __forceinline__ void operator()(EPI_ARGS) const {
        const int row0 = u.lm * BM + wr * 64 + fr;
#pragma unroll
        for (int bj = 0; bj < 2; ++bj) {
            const int col = u.ln * BM + bj * HALF + wc * 32 + 8 * fq;
            f32x4 b0 = (f32x4){0.f, 0.f, 0.f, 0.f}, b1 = b0;
            if (bias) { b0 = *(const f32x4*)(bias + col); b1 = *(const f32x4*)(bias + col + 4); }
#pragma unroll
            for (int ai = 0; ai < 2; ++ai)
#pragma unroll
                for (int m = 0; m < 4; ++m) {
                    float* p = C + (size_t)(row0 + ai * HALF + m * 16) * ldc + col;
                    *(f32x4*)p = acc[ai][bj][m][0] + b0; *(f32x4*)(p + 4) = acc[ai][bj][m][1] + b1;
                }
        }
    }
};
template <long SL_OFF, int SL_LD, int SL_COL0>
struct EpiF32S {
    float* C; int ldc; const float* bias;
    __device__ __forceinline__ void operator()(EPI_ARGS) const {
        const int row0 = u.lm * BM + wr * 64 + fr;
#pragma unroll
        for (int bj = 0; bj < 2; ++bj) {
            const int col = u.ln * BM + bj * HALF + wc * 32 + 8 * fq;
            f32x4 b0 = (f32x4){0.f, 0.f, 0.f, 0.f}, b1 = b0;
            if (bias && u.ksub == 0) { b0 = *(const f32x4*)(bias + col); b1 = *(const f32x4*)(bias + col + 4); }
#pragma unroll
            for (int ai = 0; ai < 2; ++ai)
#pragma unroll
                for (int m = 0; m < 4; ++m) {
                    float* p;
                    if (u.ks == 1) p = C + (size_t)(row0 + ai * HALF + m * 16) * ldc + col;
                    else { const int cr = (u.lm / PPB) * CTXL + wr * 64 + fr + ai * HALF + m * 16; p = C + SL_OFF + ((size_t)u.ksub * (NB * CTXL) + cr) * SL_LD + (col - SL_COL0); }
                    *(f32x4*)p = acc[ai][bj][m][0] + b0; *(f32x4*)(p + 4) = acc[ai][bj][m][1] + b1;
                }
        }
    }
};
struct EpiBf16B {
    bf16_t* C; int ldc; const float* bias;
    __device__ __forceinline__ void operator()(EPI_ARGS) const {
        const int row0 = u.lm * BM + wr * 64 + fr;
#pragma unroll
        for (int bj = 0; bj < 2; ++bj) {
            const int col = u.ln * BM + bj * HALF + wc * 32 + 8 * fq;
            f32x4 b0 = (f32x4){0.f, 0.f, 0.f, 0.f}, b1 = b0;
            if (bias) { b0 = *(const f32x4*)(bias + col); b1 = *(const f32x4*)(bias + col + 4); }
#pragma unroll
            for (int ai = 0; ai < 2; ++ai)
#pragma unroll
                for (int m = 0; m < 4; ++m) {
                    const f32x4 v0 = acc[ai][bj][m][0] + b0, v1 = acc[ai][bj][m][1] + b1;
                    u32x4 w; w.x = cvt_pk_bf16(v0[0], v0[1]); w.y = cvt_pk_bf16(v0[2], v0[3]); w.z = cvt_pk_bf16(v1[0], v1[1]); w.w = cvt_pk_bf16(v1[2], v1[3]);
                    *(u32x4*)(C + (size_t)(row0 + ai * HALF + m * 16) * ldc + col) = w;
                }
        }
    }
};
struct EpiRw1 {
    bf16_t* rkv; bf16_t* lm;
    __device__ __forceinline__ void operator()(EPI_ARGS) const {
        const int row0 = u.lm * BM + wr * 64 + fr;
        if (u.g < 3) {
            bf16_t* C = rkv + (size_t)u.g * ROWS * DM;
#pragma unroll
            for (int bj = 0; bj < 2; ++bj) {
                const int col = u.ln * BM + bj * HALF + wc * 32 + 8 * fq;
#pragma unroll
                for (int ai = 0; ai < 2; ++ai)
#pragma unroll
                    for (int m = 0; m < 4; ++m) {
                        const f32x4 v0 = acc[ai][bj][m][0], v1 = acc[ai][bj][m][1];
                        u32x4 w; w.x = cvt_pk_bf16(v0[0], v0[1]); w.y = cvt_pk_bf16(v0[2], v0[3]); w.z = cvt_pk_bf16(v1[0], v1[1]); w.w = cvt_pk_bf16(v1[2], v1[3]);
                        *(u32x4*)(C + (size_t)(row0 + ai * HALF + m * 16) * DM + col) = w;
                    }
            }
        } else {
            bf16_t* O = lm + (size_t)(u.g - 3) * ROWS * 256;
            const int mode = u.g - 3;
#pragma unroll
            for (int bj = 0; bj < 2; ++bj) {
                const int col = bj * HALF + wc * 32 + 8 * fq;
#pragma unroll
                for (int ai = 0; ai < 2; ++ai)
#pragma unroll
                    for (int m = 0; m < 4; ++m) {
                        float v[8];
#pragma unroll
                        for (int n = 0; n < 2; ++n)
#pragma unroll
                            for (int j = 0; j < 4; ++j) { const float a = acc[ai][bj][m][n][j]; v[n * 4 + j] = (mode == 0) ? (1.0f - 2.0f * __builtin_amdgcn_rcpf(1.0f + __expf(2.0f * a))) : ((mode == 1) ? a : fast_sigmoid(a)); }
                        u32x4 w; w.x = cvt_pk_bf16(v[0], v[1]); w.y = cvt_pk_bf16(v[2], v[3]); w.z = cvt_pk_bf16(v[4], v[5]); w.w = cvt_pk_bf16(v[6], v[7]);
                        *(u32x4*)(O + (size_t)(row0 + ai * HALF + m * 16) * 256 + col) = w;
                    }
            }
        }
    }
};
struct EpiRw2 {
    bf16_t* dec; bf16_t* asig; bf16_t* gg; const float* w0; const float* a0;
    __device__ __forceinline__ void operator()(EPI_ARGS) const {
        const int row0 = u.lm * BM + wr * 64 + fr;
        const float* addv = (u.g == 0) ? w0 : a0;
#pragma unroll
        for (int bj = 0; bj < 2; ++bj) {
            const int col = u.ln * BM + bj * HALF + wc * 32 + 8 * fq;
            f32x4 b0 = (f32x4){0.f, 0.f, 0.f, 0.f}, b1 = b0;
            if (u.g < 2) { b0 = *(const f32x4*)(addv + col); b1 = *(const f32x4*)(addv + col + 4); }
#pragma unroll
            for (int ai = 0; ai < 2; ++ai)
#pragma unroll
                for (int m = 0; m < 4; ++m) {
                    f32x4 v0 = acc[ai][bj][m][0] + b0, v1 = acc[ai][bj][m][1] + b1;
                    if (u.g < 2) {
#pragma unroll
                        for (int j = 0; j < 4; ++j) {
                            float s0 = fast_sigmoid(v0[j]), s1 = fast_sigmoid(v1[j]);
                            if (u.g == 0) { s0 = s0 * 0.8750387749145276f; s1 = s1 * 0.8750387749145276f; }
                            v0[j] = s0; v1[j] = s1;
                        }
                    }
                    const size_t r = (size_t)(row0 + ai * HALF + m * 16);
                    { u32x4 w; w.x = cvt_pk_bf16(v0[0], v0[1]); w.y = cvt_pk_bf16(v0[2], v0[3]); w.z = cvt_pk_bf16(v1[0], v1[1]); w.w = cvt_pk_bf16(v1[2], v1[3]);
                        *(u32x4*)((u.g == 0 ? dec + r * (2 * DM) : (u.g == 1 ? asig + r * (2 * DM) : gg + r * DM)) + col) = w; }
                    asm volatile("" ::: "memory");
                }
        }
    }
};
struct EpiMla3 {
    bf16_t* qraw; bf16_t* Kb; bf16_t* Vb;
    __device__ __forceinline__ void operator()(EPI_ARGS) const {
        const int row0 = u.lm * BM + wr * 64 + fr;
        if (u.g == 0) {
#pragma unroll
            for (int bj = 0; bj < 2; ++bj) {
                const int col = u.ln * BM + bj * HALF + wc * 32 + 8 * fq;
#pragma unroll
                for (int ai = 0; ai < 2; ++ai)
#pragma unroll
                    for (int m = 0; m < 4; ++m) {
                        const f32x4 v0 = acc[ai][bj][m][0], v1 = acc[ai][bj][m][1];
                        u32x4 w; w.x = cvt_pk_bf16(v0[0], v0[1]); w.y = cvt_pk_bf16(v0[2], v0[3]); w.z = cvt_pk_bf16(v1[0], v1[1]); w.w = cvt_pk_bf16(v1[2], v1[3]);
                        *(u32x4*)(qraw + (size_t)(row0 + ai * HALF + m * 16) * 3072 + col) = w;
                    }
            }
        } else {
#pragma unroll
            for (int bj = 0; bj < 2; ++bj) {
                bf16_t* O = bj ? Vb : Kb; const int ld = bj ? 2048 : 3072; const int col = u.ln * (bj ? 128 : 192) + wc * 32 + 8 * fq;
#pragma unroll
                for (int ai = 0; ai < 2; ++ai)
#pragma unroll
                    for (int m = 0; m < 4; ++m) {
                        const f32x4 v0 = acc[ai][bj][m][0], v1 = acc[ai][bj][m][1];
                        u32x4 w; w.x = cvt_pk_bf16(v0[0], v0[1]); w.y = cvt_pk_bf16(v0[2], v0[3]); w.z = cvt_pk_bf16(v1[0], v1[1]); w.w = cvt_pk_bf16(v1[2], v1[3]);
                        *(u32x4*)(O + (size_t)(row0 + ai * HALF + m * 16) * ld + col) = w;
                    }
            }
        }
    }
};
#undef EPI_ARGS
}
namespace pg8 {
struct EpiHyF {
    float* hft_lat; float* hft_ctx;
    __device__ __forceinline__ void operator()(const f32x4 (&acc)[2][2][4][2], const Unit& u, int wr, int wc, int fr, int fq) const {
        const bool lat = u.lm < 16; const int L = lat ? 4096 : 256;
        float* base = (lat ? hft_lat : hft_ctx) + ((u.lm - (lat ? 0 : 16)) * BM + wr * 64 + fr);
#pragma unroll
        for (int bj = 0; bj < 2; ++bj)
#pragma unroll
            for (int n = 0; n < 2; ++n)
#pragma unroll
                for (int j = 0; j < 4; ++j) {
                    float* p = base + (size_t)(u.ln * BM + bj * HALF + wc * 32 + 8 * fq + 4 * n + j) * L;
#pragma unroll
                    for (int ai = 0; ai < 2; ++ai)
#pragma unroll
                        for (int m = 0; m < 4; ++m) p[ai * HALF + m * 16] = acc[ai][bj][m][n][j];
                    asm volatile("" ::: "memory");
                }
    }
};
}
namespace att {
constexpr int NW = 8, QBLK = 32, KVBLK = 64, DV = 128;
constexpr float THR = 8.f;
#define SBAR() __builtin_amdgcn_sched_barrier(0)
__device__ __forceinline__ int crow(int r, int hi) { return (r & 3) + 8 * (r >> 2) + 4 * hi; }
template <int SCALE_ID> struct ScaleOf;
template <> struct ScaleOf<128> { static constexpr float v = 0.088388347648318440f; };
template <> struct ScaleOf<192> { static constexpr float v = 0.072168783648703220f; };

template <int DQK>
__device__ __forceinline__ void partialSM(f32x16& p0, f32x16& p1, float& m_reg, float& mn, float& alpha) {
  constexpr float SCALE = ScaleOf<DQK>::v;
  constexpr float C = SCALE * 1.4426950408889634f;
  float pmax = p0[0];
#pragma unroll
  for (int r = 1; r < 16; ++r) pmax = fmaxf(pmax, p0[r]);
#pragma unroll
  for (int r = 0; r < 16; ++r) pmax = fmaxf(pmax, p1[r]);
  { auto rr = __builtin_amdgcn_permlane32_swap(__float_as_uint(pmax), __float_as_uint(pmax), false, false);
    pmax = fmaxf(__uint_as_float(rr[0]), __uint_as_float(rr[1])); }
  if (__builtin_expect(__all(pmax - m_reg <= THR / SCALE), 1)) { mn = m_reg; alpha = 1.f; }
  else { mn = fmaxf(m_reg, pmax); alpha = __builtin_amdgcn_exp2f((m_reg - mn) * C); m_reg = mn; }
  float mnC = -mn * C;
#pragma unroll
  for (int r = 0; r < 16; ++r) p0[r] = fmaf(p0[r], C, mnC);
#pragma unroll
  for (int r = 0; r < 16; ++r) p1[r] = fmaf(p1[r], C, mnC);
#pragma unroll
  for (int r = 0; r < 16; ++r) p0[r] = __builtin_amdgcn_exp2f(p0[r]);
}
__device__ __forceinline__ void finishSM(f32x16& p0, f32x16& p1, float alpha, float& l_reg, bf16x8& pa0, bf16x8& pa1, bf16x8& pa2, bf16x8& pa3) {
#pragma unroll
  for (int r = 0; r < 16; ++r) p1[r] = __builtin_amdgcn_exp2f(p1[r]);
  float ps = 0;
#pragma unroll
  for (int r = 0; r < 16; ++r) ps += p0[r];
#pragma unroll
  for (int r = 0; r < 16; ++r) ps += p1[r];
  { auto rr = __builtin_amdgcn_permlane32_swap(__float_as_uint(ps), __float_as_uint(ps), false, false);
    ps = __uint_as_float(rr[0]) + __uint_as_float(rr[1]); }
  l_reg = l_reg * alpha + ps;
#define PK4(P, BASE, OUT) do { unsigned a0 = cvt_pk_bf16(P[BASE + 0], P[BASE + 1]), a1 = cvt_pk_bf16(P[BASE + 2], P[BASE + 3]);   \
    unsigned b0 = cvt_pk_bf16(P[BASE + 4], P[BASE + 5]), b1 = cvt_pk_bf16(P[BASE + 6], P[BASE + 7]);                              \
    auto r0 = __builtin_amdgcn_permlane32_swap(a0, b0, false, false); auto r1 = __builtin_amdgcn_permlane32_swap(a1, b1, false, false); \
    u32x4 w = {r0[0], r1[0], r0[1], r1[1]}; OUT = *reinterpret_cast<bf16x8*>(&w); } while (0)
  PK4(p0, 0, pa0); PK4(p0, 8, pa1); PK4(p1, 0, pa2); PK4(p1, 8, pa3);
#undef PK4
}
template <int DQK>
__device__ __forceinline__ int kswz(int row, int colB) { return row * (DQK * 2) + (colB ^ ((row & 7) << 4)); }
template <int DQK>
__device__ __forceinline__ void qkt(f32x16& p0, f32x16& p1, const char* Ks, const bf16x8* qr, int r32, int hi) {
  p0 = f32x16{}; p1 = f32x16{};
#pragma unroll
  for (int d0 = 0; d0 < DQK / 16; ++d0) { int cb = (d0 * 16 + hi * 8) * 2;
    bf16x8 b0 = *reinterpret_cast<const bf16x8*>(Ks + kswz<DQK>(r32, cb));
    bf16x8 b1 = *reinterpret_cast<const bf16x8*>(Ks + kswz<DQK>(32 + r32, cb));
    p0 = __builtin_amdgcn_mfma_f32_32x32x16_bf16(b0, qr[d0], p0, 0, 0, 0);
    p1 = __builtin_amdgcn_mfma_f32_32x32x16_bf16(b1, qr[d0], p1, 0, 0, 0); }
}
template <int DQK, int NQL>
__device__ __forceinline__ void qkt_l(f32x16& p0, f32x16& p1, const char* Ks, const bf16x8* qr, const char* qls, int r32, int hi) {
  p0 = f32x16{}; p1 = f32x16{};
  constexpr int ND0 = DQK / 16;
#pragma unroll
  for (int d0 = 0; d0 < ND0; ++d0) { int cb = (d0 * 16 + hi * 8) * 2;
    bf16x8 b0 = *reinterpret_cast<const bf16x8*>(Ks + kswz<DQK>(r32, cb));
    bf16x8 b1 = *reinterpret_cast<const bf16x8*>(Ks + kswz<DQK>(32 + r32, cb));
    const bf16x8 q = (d0 < ND0 - NQL) ? qr[d0 < ND0 - NQL ? d0 : 0] : *reinterpret_cast<const bf16x8*>(qls + (d0 - (ND0 - NQL)) * 1024);
    p0 = __builtin_amdgcn_mfma_f32_32x32x16_bf16(b0, q, p0, 0, 0, 0);
    p1 = __builtin_amdgcn_mfma_f32_32x32x16_bf16(b1, q, p1, 0, 0, 0); }
}
__device__ __forceinline__ int v_st(int k, int c) { const int kk = (k & ~0xC) | ((k & 4) << 1) | ((k & 8) >> 1); return ((kk >> 3) * 4 + (c >> 5)) * 512 + ((kk & 7) * 32 + (c & 31)) * 2; }
__device__ __forceinline__ int v_rd_base(int lane) { return ((lane & 3) << 3) | (((lane >> 2) & 3) << 6) | (((lane >> 4) & 1) << 5) | (((lane >> 5) & 1) << 8); }
constexpr int v_rd_off(int d0, int ks, int half) { return d0 * 512 + ks * 4096 + half * 2048; }
template <int OFF> __device__ __forceinline__ s16x4 tr_read(int vb) {
  s16x4 r; asm volatile("ds_read_b64_tr_b16 %0, %1 offset:%2" : "=&v"(r) : "v"(vb), "i"(OFF) : "memory"); return r;
}
template <int D0> __device__ __forceinline__ void pv_one(f32x16& od, int vb, bf16x8 pa0, bf16x8 pa1, bf16x8 pa2, bf16x8 pa3) {
  const s16x4 l0 = tr_read<v_rd_off(D0, 0, 0)>(vb), h0 = tr_read<v_rd_off(D0, 0, 1)>(vb), l1 = tr_read<v_rd_off(D0, 1, 0)>(vb), h1 = tr_read<v_rd_off(D0, 1, 1)>(vb);
  const s16x4 l2 = tr_read<v_rd_off(D0, 2, 0)>(vb), h2 = tr_read<v_rd_off(D0, 2, 1)>(vb), l3 = tr_read<v_rd_off(D0, 3, 0)>(vb), h3 = tr_read<v_rd_off(D0, 3, 1)>(vb);
  asm volatile("s_waitcnt lgkmcnt(0)" ::: "memory"); SBAR();
#define PK(L, H) (bf16x8){L[0], L[1], L[2], L[3], H[0], H[1], H[2], H[3]}
  od = __builtin_amdgcn_mfma_f32_32x32x16_bf16(pa0, PK(l0, h0), od, 0, 0, 0);
  od = __builtin_amdgcn_mfma_f32_32x32x16_bf16(pa1, PK(l1, h1), od, 0, 0, 0);
  od = __builtin_amdgcn_mfma_f32_32x32x16_bf16(pa2, PK(l2, h2), od, 0, 0, 0);
  od = __builtin_amdgcn_mfma_f32_32x32x16_bf16(pa3, PK(l3, h3), od, 0, 0, 0);
#undef PK
}
__device__ __forceinline__ void pv_d0(f32x16* o, int vb, bf16x8 pa0, bf16x8 pa1, bf16x8 pa2, bf16x8 pa3) {
  pv_one<0>(o[0], vb, pa0, pa1, pa2, pa3); pv_one<1>(o[1], vb, pa0, pa1, pa2, pa3); pv_one<2>(o[2], vb, pa0, pa1, pa2, pa3); pv_one<3>(o[3], vb, pa0, pa1, pa2, pa3);
}

template <int DQK, int LDQ, int LDK, int LDV, int LDO>
__device__ __forceinline__ void attn_dense_body(const bf16_t* __restrict__ Qb, const bf16_t* __restrict__ Kh, const bf16_t* __restrict__ Vh,
                                                bf16_t* __restrict__ Ob, int seq, char* lds) {
  constexpr int SHM_V = KVBLK * DV * 2, SHM_K = KVBLK * DQK * 2, NCH = DQK / 8, KCH = NCH / 8  , ND0 = DQK / 16;
  const int tid = threadIdx.x, wid = tid >> 6, lane = tid & 63, r32 = lane & 31, hi = lane >> 5;
  char* V_lds = lds; char* K_lds = lds + 2 * SHM_V;
  float* ws = (float*)(lds + 2 * SHM_V + 2 * SHM_K) + wid * 64; float* li_l = ws; float* al_l = ws + 32;
  float m_reg = -1e30f, l_reg = 0; f32x16 o[4] = {}; bf16x8 qr[ND0];
  const bf16_t* Qw = Qb + (long)(wid * QBLK + r32) * LDQ + hi * 8;
#pragma unroll
  for (int d0 = 0; d0 < ND0; ++d0) qr[d0] = *reinterpret_cast<const bf16x8*>(Qw + d0 * 16);
  const int sr = tid >> 4, sc = (tid & 15) * 8, vst0 = v_st(sr, sc), vst1 = v_st(32 + sr, sc);
  const int vb0 = (int)(uintptr_t)V_lds + v_rd_base(lane);
  bf16x8 vs0, vs1, ks[KCH];
#define SLOAD(k0) do { vs0 = *reinterpret_cast<const bf16x8*>(&Vh[(long)((k0) + sr) * LDV + sc]); vs1 = *reinterpret_cast<const bf16x8*>(&Vh[(long)((k0) + 32 + sr) * LDV + sc]); \
    _Pragma("unroll") for (int c_ = 0; c_ < KCH; ++c_) { const int q_ = tid + 512 * c_; ks[c_] = *reinterpret_cast<const bf16x8*>(&Kh[(long)((k0) + q_ / NCH) * LDK + (q_ % NCH) * 8]); } } while (0)
#define SWRITE(b) do { *(bf16x8*)(V_lds + (b) * SHM_V + vst0) = vs0; *(bf16x8*)(V_lds + (b) * SHM_V + vst1) = vs1; \
    _Pragma("unroll") for (int c_ = 0; c_ < KCH; ++c_) { const int q_ = tid + 512 * c_; *(bf16x8*)(K_lds + (b) * SHM_K + kswz<DQK>(q_ / NCH, (q_ % NCH) * 16)) = ks[c_]; } } while (0)
  const int NT = seq / KVBLK;
  SLOAD(0); asm volatile("s_waitcnt vmcnt(0)" ::: "memory"); SWRITE(0);
  SLOAD(KVBLK);
#pragma unroll 1
  for (int j = 0; j < NT; ++j) {
    const int b = j & 1;
    __syncthreads();
    if (j + 1 < NT) { asm volatile("s_waitcnt vmcnt(0)" ::: "memory"); SWRITE(b ^ 1); if (j + 2 < NT) SLOAD((j + 2) * KVBLK); }
    f32x16 p0, p1; float mn, al; bf16x8 pa0, pa1, pa2, pa3;
    SBAR(); qkt<DQK>(p0, p1, K_lds + b * SHM_K, qr, r32, hi);
    partialSM<DQK>(p0, p1, m_reg, mn, al);
    if (__any(al < 1.f)) { if (hi == 0) al_l[r32] = al; asm volatile("s_waitcnt lgkmcnt(0)" ::: "memory");
#pragma unroll
      for (int d = 0; d < 4; ++d)
#pragma unroll
        for (int r = 0; r < 16; ++r) o[d][r] *= al_l[crow(r, hi)]; }
    finishSM(p0, p1, al, l_reg, pa0, pa1, pa2, pa3); SBAR();
    pv_d0(o, vb0 + b * (int)SHM_V, pa0, pa1, pa2, pa3);
  }
  if (hi == 0) li_l[r32] = l_reg; asm volatile("s_waitcnt lgkmcnt(0)" ::: "memory");
  __syncthreads();
  char* ot = lds + wid * 8192;
  { char* ob = ot + hi * 1024 + r32 * 2;
#pragma unroll
    for (int r = 0; r < 16; ++r) { const float rl = __builtin_amdgcn_rcpf(li_l[crow(r, hi)]);
#pragma unroll
      for (int d0 = 0; d0 < 4; ++d0) *(bf16_t*)(ob + ((r & 3) + 8 * (r >> 2)) * 256 + d0 * 64) = (bf16_t)(cvt_pk_bf16(o[d0][r] * rl, 0.f) & 0xffffu); } }
  asm volatile("s_waitcnt lgkmcnt(0)" ::: "memory");
  { bf16_t* Ow = Ob + (long)(wid * QBLK + (lane >> 4)) * LDO + (lane & 15) * 8; const char* ib = ot + (lane >> 4) * 256 + (lane & 15) * 16;
#pragma unroll
    for (int k = 0; k < 8; ++k) *(u32x4*)(Ow + (long)(k * 4) * LDO) = *(const u32x4*)(ib + k * 1024); }
  asm volatile("s_waitcnt lgkmcnt(0)" ::: "memory");
#undef SLOAD
#undef SWRITE
}

template <int DQK, int LDQ, int LDK, int LDV, int LDO, int NQL>
__device__ __forceinline__ void attn_dense_body2(const bf16_t* __restrict__ Qb, const bf16_t* __restrict__ Kh, const bf16_t* __restrict__ Vh,
                                                 bf16_t* __restrict__ Ob, int seq, char* lds) {
  constexpr int SHM_V = KVBLK * DV * 2, SHM_K = KVBLK * DQK * 2, NCH = DQK / 8, KCH = NCH / 8, ND0 = DQK / 16;
  int tid = threadIdx.x; asm volatile("" : "+v"(tid));
  const int wid = __builtin_amdgcn_readfirstlane(tid >> 6), lane = tid & 63, r32 = lane & 31, hi = lane >> 5;
  char* V_lds = lds; char* K_lds = lds + 2 * SHM_V;
  float* ws = (float*)(lds + 2 * SHM_V + 2 * SHM_K) + wid * 64; float* li_l = ws; float* al_l = ws + 32;
  float m_reg = -1e30f, l_reg = 0; f32x16 o[4] = {}; bf16x8 qr[ND0 - NQL];
  const bf16_t* Qw = Qb + (long)(wid * QBLK + r32) * LDQ + hi * 8;
  char* qls = lds + 2 * SHM_V + 2 * SHM_K + 2048 + wid * (NQL * 1024) + lane * 16;
#pragma unroll
  for (int d0 = 0; d0 < ND0; ++d0) { const bf16x8 q = *reinterpret_cast<const bf16x8*>(Qw + d0 * 16); if (d0 < ND0 - NQL) qr[d0 < ND0 - NQL ? d0 : 0] = q; else *reinterpret_cast<bf16x8*>(qls + (d0 - (ND0 - NQL)) * 1024) = q; }
  const int sr = tid >> 4, sc = (tid & 15) * 8, vst0 = v_st(sr, sc), vst1 = v_st(32 + sr, sc);
  const int vb0 = (int)(uintptr_t)V_lds + v_rd_base(lane);
  bf16x8 vs0, vs1, ks[KCH];
#define SLOAD(k0) do { vs0 = *reinterpret_cast<const bf16x8*>(&Vh[(long)((k0) + sr) * LDV + sc]); vs1 = *reinterpret_cast<const bf16x8*>(&Vh[(long)((k0) + 32 + sr) * LDV + sc]); \
    _Pragma("unroll") for (int c_ = 0; c_ < KCH; ++c_) { const int q_ = tid + 512 * c_; ks[c_] = *reinterpret_cast<const bf16x8*>(&Kh[(long)((k0) + q_ / NCH) * LDK + (q_ % NCH) * 8]); } } while (0)
#define SWRITE(b) do { *(bf16x8*)(V_lds + (b) * SHM_V + vst0) = vs0; *(bf16x8*)(V_lds + (b) * SHM_V + vst1) = vs1; \
    _Pragma("unroll") for (int c_ = 0; c_ < KCH; ++c_) { const int q_ = tid + 512 * c_; *(bf16x8*)(K_lds + (b) * SHM_K + kswz<DQK>(q_ / NCH, (q_ % NCH) * 16)) = ks[c_]; } } while (0)
#define SWAIT() asm volatile("s_waitcnt vmcnt(0)" ::: "memory")
#define RESC(a) do { if (__any((a) < 1.f)) { if (hi == 0) al_l[r32] = (a); asm volatile("s_waitcnt lgkmcnt(0)" ::: "memory"); \
    _Pragma("unroll") for (int d = 0; d < 4; ++d) _Pragma("unroll") for (int r = 0; r < 16; ++r) o[d][r] *= al_l[crow(r, hi)]; } } while (0)
  f32x16 pA0, pA1, pB0, pB1; float mnA, mnB, alA, alB; bf16x8 pa0, pa1, pa2, pa3; const int NT = seq / KVBLK;
  SLOAD(0); SWAIT(); SWRITE(0); __syncthreads();
  qkt_l<DQK, NQL>(pA0, pA1, K_lds, qr, qls, r32, hi); partialSM<DQK>(pA0, pA1, m_reg, mnA, alA);
  SLOAD(KVBLK); SWAIT(); SWRITE(1); __syncthreads();
  for (int j = 1; j + 1 < NT; j += 2) {
    SBAR(); qkt_l<DQK, NQL>(pB0, pB1, K_lds + SHM_K, qr, qls, r32, hi);
    finishSM(pA0, pA1, alA, l_reg, pa0, pa1, pa2, pa3); SBAR();
    SLOAD((j + 1) * KVBLK); SBAR();
    pv_d0(o, vb0, pa0, pa1, pa2, pa3); partialSM<DQK>(pB0, pB1, m_reg, mnB, alB);
    __syncthreads(); SWAIT(); SWRITE(0);
    RESC(alB); __syncthreads();
    SBAR(); qkt_l<DQK, NQL>(pA0, pA1, K_lds, qr, qls, r32, hi);
    finishSM(pB0, pB1, alB, l_reg, pa0, pa1, pa2, pa3); SBAR();
    SLOAD((j + 2) * KVBLK); SBAR();
    pv_d0(o, vb0 + (int)SHM_V, pa0, pa1, pa2, pa3); partialSM<DQK>(pA0, pA1, m_reg, mnA, alA);
    __syncthreads(); SWAIT(); SWRITE(1);
    RESC(alA); __syncthreads();
  }
  SBAR(); qkt_l<DQK, NQL>(pB0, pB1, K_lds + SHM_K, qr, qls, r32, hi);
  finishSM(pA0, pA1, alA, l_reg, pa0, pa1, pa2, pa3); SBAR();
  pv_d0(o, vb0, pa0, pa1, pa2, pa3); partialSM<DQK>(pB0, pB1, m_reg, mnB, alB);
  __syncthreads(); RESC(alB);
  finishSM(pB0, pB1, alB, l_reg, pa0, pa1, pa2, pa3); SBAR();
  pv_d0(o, vb0 + (int)SHM_V, pa0, pa1, pa2, pa3);
  if (hi == 0) li_l[r32] = l_reg; asm volatile("s_waitcnt lgkmcnt(0)" ::: "memory");
  __syncthreads();
  char* ot = lds + wid * 8192;
  { char* ob = ot + hi * 1024 + r32 * 2;
#pragma unroll
    for (int r = 0; r < 16; ++r) { const float rl = __builtin_amdgcn_rcpf(li_l[crow(r, hi)]);
#pragma unroll
      for (int d0 = 0; d0 < 4; ++d0) *(bf16_t*)(ob + ((r & 3) + 8 * (r >> 2)) * 256 + d0 * 64) = (bf16_t)(cvt_pk_bf16(o[d0][r] * rl, 0.f) & 0xffffu); } }
  asm volatile("s_waitcnt lgkmcnt(0)" ::: "memory");
  { bf16_t* Ow = Ob + (long)(wid * QBLK + (lane >> 4)) * LDO + (lane & 15) * 8; const char* ib = ot + (lane >> 4) * 256 + (lane & 15) * 16;
#pragma unroll
    for (int k = 0; k < 8; ++k) *(u32x4*)(Ow + (long)(k * 4) * LDO) = *(const u32x4*)(ib + k * 1024); }
  asm volatile("s_waitcnt lgkmcnt(0)" ::: "memory");
#undef SLOAD
#undef SWRITE
#undef SWAIT
#undef RESC
}
}
struct Ctx { LAS unsigned char* lds; int tid, lane, wave, bid, G, gw, NGW; };

template <class F>
__device__ __forceinline__ void conv_tile_load(F src4, int n0, int k0, int lane, f32x4 (&v)[8]) {
    const int kr = lane >> 3, n4 = (lane & 7) * 4;
#pragma unroll
    for (int i = 0; i < 8; ++i) v[i] = src4(n0 + n4, k0 + 8 * kr + i);
}
__device__ __forceinline__ void conv_tile_store(const f32x4 (&v)[8], bf16_t* dp  , int Kd, LAS float* scr, int lane) {
    const int kr = lane >> 3, n4 = (lane & 7) * 4; (void)scr;
#pragma unroll
    for (int j = 0; j < 4; ++j) { u32x4 o; o.x = cvt_pk_bf16(v[0][j], v[1][j]); o.y = cvt_pk_bf16(v[2][j], v[3][j]); o.z = cvt_pk_bf16(v[4][j], v[5][j]); o.w = cvt_pk_bf16(v[6][j], v[7][j]);
        *(u32x4*)(dp + (size_t)(n4 + j) * Kd + 8 * kr) = o; }
}
template <class F>
__device__ __forceinline__ void conv_tile(F src4, bf16_t* dst, int Kd, int n0, int k0, LAS float* scr, int lane) {
    f32x4 v[8];
    conv_tile_load(src4, n0, k0, lane, v);
    conv_tile_store(v, dst + (size_t)n0 * Kd + k0, Kd, scr, lane);
}
#define CONV_JOB(ND, KD, DST, ...) do { const int nbk_ = (ND) / 32, nit_ = nbk_ * ((KD) / 64); bf16_t* dst_ = (bf16_t*)(DST); \
    for (int it_ = F.gw; it_ < nit_; it_ += F.NGW) conv_tile(__VA_ARGS__, dst_, (KD), (it_ % nbk_) * 32, (it_ / nbk_) * 64, scr, F.lane); } while (0)
__device__ __forceinline__ float bf_hi(float w) { return __uint_as_float(cvt_pk_bf16(w, 0.f) << 16); }

__device__ __forceinline__ int row_type(int r) { const int b = r / TPB, t = r - b * TPB; return t < CTXL ? 2 : b; }

__device__ __forceinline__ void modnorm_row(bf16_t* X, const float* g, const float* mods_l, int s, int r, int lane, f32x4 (&y)[8], const bf16_t* part, int nsplit) {
    const int rt = row_type(r);
    bf16_t* xr = X + (size_t)r * DM + 8 * lane;
    const f32x4* gp = (const f32x4*)g + 2 * lane;
    const f32x4* sh = (const f32x4*)(mods_l + (size_t)(rt * NMOD + 3 * s) * DM) + 2 * lane;
    const f32x4* sc = (const f32x4*)(mods_l + (size_t)(rt * NMOD + 3 * s + 1) * DM) + 2 * lane;
#pragma unroll
    for (int j = 0; j < 4; ++j) ld8bf(xr + 512 * j, y[2 * j], y[2 * j + 1]);
    if (part != nullptr && rt == 2) {
        const int cr = (r / TPB) * CTXL + (r % TPB);
#pragma unroll
        for (int j = 0; j < 4; ++j) { f32x4 a = y[2 * j], b = y[2 * j + 1];
            for (int k = 0; k < nsplit; ++k) { f32x4 pa, pb; ld8bf(part + ((size_t)k * (NB * CTXL) + cr) * DM + 8 * lane + 512 * j, pa, pb); a += pa; b += pb; }
            st8bf(xr + 512 * j, a, b); ld8bf(xr + 512 * j, y[2 * j], y[2 * j + 1]); }
    }
    float ss = 0.f;
#pragma unroll
    for (int j = 0; j < 8; ++j) ss += (y[j].x * y[j].x + y[j].y * y[j].y) + (y[j].z * y[j].z + y[j].w * y[j].w);
    const float rinv = rsqrtf(wave_sum(ss) * (1.0f / DM) + 1e-6f);
#pragma unroll
    for (int j = 0; j < 4; ++j) { y[2 * j] = (y[2 * j] * rinv) * gp[128 * j] * (1.0f + sc[128 * j]) + sh[128 * j]; y[2 * j + 1] = (y[2 * j + 1] * rinv) * gp[128 * j + 1] * (1.0f + sc[128 * j + 1]) + sh[128 * j + 1]; }
}
__device__ __forceinline__ void store_row_bf16(bf16_t* dst, int lane, const f32x4 (&y)[8]) {
#pragma unroll
    for (int j = 0; j < 4; ++j) st8bf(dst + 8 * lane + 512 * j, y[2 * j], y[2 * j + 1]);
}
__device__ __forceinline__ float rope_invfreq(int j, int half) { return powf(10000.0f, -(float)j / (float)half); }
constexpr int FFT_TW = 2730;
__device__ __forceinline__ int fft_toff(int s) { return s == 0 ? 0 : (s == 1 ? 2048 : (s == 2 ? 2560 : (s == 3 ? 2688 : (s == 4 ? 2720 : 2728)))); }
__device__ __forceinline__ f32x2 cmul(f32x2 a, f32x2 b) { return (f32x2){a.x * b.x - a.y * b.y, a.x * b.y + a.y * b.x}; }
__device__ __forceinline__ f32x2 cmulc(f32x2 a, f32x2 b) { return (f32x2){a.x * b.x + a.y * b.y, a.y * b.x - a.x * b.y}; }
__device__ __forceinline__ int fpa(int e) { return e + ((e >> 5) << 1); }
#define R4F(a0, a1, a2, a3, W1, W2, W3) do { const f32x2 t0_ = a0 + a2, t1_ = a0 - a2, t2_ = a1 + a3, d_ = a1 - a3, t3_ = (f32x2){d_.y, -d_.x}; \
        a0 = t0_ + t2_; a1 = cmul(t1_ + t3_, W1); a2 = cmul(t0_ - t2_, W2); a3 = cmul(t1_ - t3_, W3); } while (0)
#define R4I(z0, z1, z2, z3, W1, W2, W3) do { const f32x2 y1_ = cmulc(z1, W1), y2_ = cmulc(z2, W2), y3_ = cmulc(z3, W3); \
        const f32x2 t0_ = z0 + y2_, t1_ = z0 - y2_, t2_ = y1_ + y3_, d_ = y1_ - y3_, t3_ = (f32x2){-d_.y, d_.x}; \
        z0 = t0_ + t2_; z1 = t1_ + t3_; z2 = t0_ - t2_; z3 = t1_ - t3_; } while (0)
#define FFT_SYNC() do { if (WAVE) asm volatile("s_waitcnt lgkmcnt(0)" ::: "memory"); else __syncthreads(); } while (0)
template <int LOGN, bool WAVE>
__device__ __forceinline__ void fft4_fwd(LAS f32x2* x, const LAS f32x2* twl, int tid) {
    constexpr int N = 1 << LOGN, NS = (LOGN - 1) / 2, S0 = 6 - NS;
#pragma unroll 1
    for (int s = 0; s < NS; s += 2) {
        if (tid < N / 16) {
            const int q1 = N >> (2 * s + 2), q2 = q1 >> 2, pos2 = tid & (q2 - 1), base = ((tid - pos2) << 4) + pos2;
            const LAS f32x2* twa = twl + fft_toff(S0 + s); const LAS f32x2* twb = twl + fft_toff(S0 + s + 1);
            f32x2 v[4][4];
#pragma unroll
            for (int k1 = 0; k1 < 4; ++k1)
#pragma unroll
                for (int k2 = 0; k2 < 4; ++k2) v[k1][k2] = x[fpa(base + k1 * q1 + k2 * q2)];
#pragma unroll
            for (int k2 = 0; k2 < 4; ++k2) { const int p1 = k2 * q2 + pos2; const f32x2 w1 = twa[p1], w2 = twa[FFT_TW + p1], w3 = twa[2 * FFT_TW + p1];
                R4F(v[0][k2], v[1][k2], v[2][k2], v[3][k2], w1, w2, w3); }
            { const f32x2 w1 = twb[pos2], w2 = twb[FFT_TW + pos2], w3 = twb[2 * FFT_TW + pos2];
#pragma unroll
              for (int k1 = 0; k1 < 4; ++k1) R4F(v[k1][0], v[k1][1], v[k1][2], v[k1][3], w1, w2, w3); }
#pragma unroll
            for (int k1 = 0; k1 < 4; ++k1)
#pragma unroll
                for (int k2 = 0; k2 < 4; ++k2) x[fpa(base + k1 * q1 + k2 * q2)] = v[k1][k2];
        }
        FFT_SYNC();
    }
}
template <int LOGN, bool WAVE>
__device__ __forceinline__ void fft4_inv(LAS f32x2* x, const LAS f32x2* twl, int tid) {
    constexpr int N = 1 << LOGN, NS = (LOGN - 1) / 2, S0 = 6 - NS;
#pragma unroll 1
    for (int s = NS - 2; s >= 0; s -= 2) {
        if (tid < N / 16) {
            const int q1 = N >> (2 * s + 2), q2 = q1 >> 2, pos2 = tid & (q2 - 1), base = ((tid - pos2) << 4) + pos2;
            const LAS f32x2* twa = twl + fft_toff(S0 + s); const LAS f32x2* twb = twl + fft_toff(S0 + s + 1);
            f32x2 v[4][4];
#pragma unroll
            for (int k1 = 0; k1 < 4; ++k1)
#pragma unroll
                for (int k2 = 0; k2 < 4; ++k2) v[k1][k2] = x[fpa(base + k1 * q1 + k2 * q2)];
            { const f32x2 w1 = twb[pos2], w2 = twb[FFT_TW + pos2], w3 = twb[2 * FFT_TW + pos2];
#pragma unroll
              for (int k1 = 0; k1 < 4; ++k1) R4I(v[k1][0], v[k1][1], v[k1][2], v[k1][3], w1, w2, w3); }
#pragma unroll
            for (int k2 = 0; k2 < 4; ++k2) { const int p1 = k2 * q2 + pos2; const f32x2 w1 = twa[p1], w2 = twa[FFT_TW + p1], w3 = twa[2 * FFT_TW + p1];
                R4I(v[0][k2], v[1][k2], v[2][k2], v[3][k2], w1, w2, w3); }
#pragma unroll
            for (int k1 = 0; k1 < 4; ++k1)
#pragma unroll
                for (int k2 = 0; k2 < 4; ++k2) x[fpa(base + k1 * q1 + k2 * q2)] = v[k1][k2];
        }
        FFT_SYNC();
    }
}
__device__ __forceinline__ float block_sum(float v, LAS float* red, int tid) {
    v = wave_sum(v);
    __syncthreads();
    if ((tid & 63) == 0) red[tid >> 6] = v;
    __syncthreads();
    float s = 0.f;
#pragma unroll
    for (int i = 0; i < 8; ++i) s += red[i];
    return s;
}
template <int LOGL, int NT, bool WAVE>
__device__ __forceinline__ void hyena_channel(LAS unsigned char* bufp, const LAS f32x2* twl, LAS float* red, int tid, int c, const float* VXT, const float* HFT, const float* skip, bf16_t* Z) {
    constexpr int L = 1 << LOGL, N = 2 * L, LOGN = LOGL + 1, NPT = (L + NT - 1) / NT, NPR = (N / 2 + NT - 1) / NT  , TOFF = (LOGL == 12) ? CTXL : 0;
    LAS f32x2* buf = (LAS f32x2*)bufp;
    constexpr int NTAP = N / NT;
    const float wdelta = fabsf(-15.350567286626973f + (float)c * ((-3.0701134573253946f + 15.350567286626973f) / (float)(DM - 1)));
    const float* v0p = VXT + ((size_t)(0 * 6144 + c)) * TPB + TOFF; const float* v1p = VXT + ((size_t)(1 * 6144 + c)) * TPB + TOFF;
    float zr[NPT], zi[NPT], gtc[2][NPT], tpc[NTAP];
#pragma unroll
    for (int i = 0; i < NPT; ++i) { const int t = tid + NT * i; zr[i] = (t < L) ? v0p[t] : 0.f; zi[i] = (t < L) ? v1p[t] : 0.f; }
#define HY_TAPS(o_) do { const float* kf_ = HFT + (size_t)(((o_) * 2 + 0) * DM + c) * L; const float* kb_ = HFT + (size_t)(((o_) * 2 + 1) * DM + c) * L; \
        _Pragma("unroll") for (int i = 0; i < NTAP; ++i) { const int tau = tid + NT * i, lag = (tau < L) ? tau : N - tau;     \
            tpc[i] = ((tau < L) ? kf_[tau] : ((tau > L) ? kb_[N - tau] : 0.f)) * __expf(-(float)lag * (1.0f / (float)(L - 1)) * wdelta); } } while (0)
#define HY_GATES(o_) do { _Pragma("unroll") for (int i = 0; i < NPT; ++i) { const int t = tid + NT * i; \
            gtc[0][i] = (t < L) ? VXT[((size_t)(0 * 6144 + ((o_) + 1) * DM + c)) * TPB + TOFF + t] : 0.f; gtc[1][i] = (t < L) ? VXT[((size_t)(1 * 6144 + ((o_) + 1) * DM + c)) * TPB + TOFF + t] : 0.f; } } while (0)
    HY_TAPS(0);
#pragma unroll
    for (int o = 0; o < 2; ++o) {
        HY_GATES(o);
        float ss = 0.f;
#pragma unroll
        for (int i = 0; i < NTAP; ++i) { const float g = tpc[i]; ss += g * g; buf[fpa(tid + NT * i)] = (f32x2){g, 0.f}; }
        float ssum; if (WAVE) { FFT_SYNC(); ssum = wave_sum(ss); } else ssum = block_sum(ss, red, tid);
        const float scale = rsqrtf(ssum + 1e-12f) * (1.0f / N);
        fft4_fwd<LOGN, WAVE>(buf, twl, tid);
        f32x4 G[NPR];
#pragma unroll
        for (int k = 0; k < NPR; ++k) { const int j = tid + NT * k; if (j < N / 2) { const f32x4 p = ((const LAS f32x4*)buf)[fpa(2 * j) >> 1]; G[k] = (f32x4){p.x + p.z, p.y + p.w, p.x - p.z, p.y - p.w}; } }
        FFT_SYNC();
        if (o == 0) HY_TAPS(1);
#pragma unroll
        for (int i = 0; i < NPT; ++i) { const int t = tid + NT * i; if (t < L) { buf[fpa(t)] = (f32x2){zr[i], zi[i]}; buf[fpa(t + L)] = (f32x2){0.f, 0.f}; } }
        FFT_SYNC();
        fft4_fwd<LOGN, WAVE>(buf, twl, tid);
#pragma unroll
        for (int k = 0; k < NPR; ++k) { const int j = tid + NT * k; if (j < N / 2) { const f32x4 p = ((const LAS f32x4*)buf)[fpa(2 * j) >> 1];
            const f32x2 a = (f32x2){p.x + p.z, p.y + p.w}, b = (f32x2){p.x - p.z, p.y - p.w};
            const f32x2 cc = cmul(a, (f32x2){G[k].x, G[k].y}), dd = cmul(b, (f32x2){G[k].z, G[k].w});
            ((LAS f32x4*)buf)[fpa(2 * j) >> 1] = (f32x4){cc.x + dd.x, cc.y + dd.y, cc.x - dd.x, cc.y - dd.y}; } }
        FFT_SYNC();
        fft4_inv<LOGN, WAVE>(buf, twl, tid);
        const float sk = skip[o * DM + c];
#pragma unroll
        for (int i = 0; i < NPT; ++i) { const int t = tid + NT * i; if (t < L) { const f32x2 y = buf[fpa(t)];
            zr[i] = gtc[0][i] * (y.x * scale + sk * zr[i]); zi[i] = gtc[1][i] * (y.y * scale + sk * zi[i]); } }
        FFT_SYNC();
    }
#undef HY_TAPS
#undef HY_GATES
#pragma unroll
    for (int i = 0; i < NPT; ++i) { const int t = tid + NT * i; if (t < L) {
        Z[(size_t)c * ROWS + 0 * TPB + TOFF + t] = (bf16_t)(cvt_pk_bf16(zr[i], 0.f) & 0xffffu);
        Z[(size_t)c * ROWS + 1 * TPB + TOFF + t] = (bf16_t)(cvt_pk_bf16(zi[i], 0.f) & 0xffffu); } }
}
__device__ __forceinline__ void hyena_conv3_unit(int unit, const bf16_t* U, const float* cw, const float* cb, float* VXT, LAS float* tile  , int lane) {
    const int cblk = unit % 96, tblk = (unit / 96) % 68, b = unit / (96 * 68);
    const int c0 = cblk * 64, t0 = tblk * 64;
    const int ch = c0 + lane;
    const float w0 = cw[ch], w1 = cw[6144 + ch], w2 = cw[2 * 6144 + ch], bb = cb[ch];
    const bf16_t* up_ = U + ((size_t)b * TPB + t0) * 6144 + ch;
    const bool first = (t0 == 0) || (t0 == CTXL), last = (t0 + 64 == CTXL) || (t0 + 64 == TPB);
    float v[66];
    v[0] = first ? 0.f : bf2f(up_[-6144]);
#pragma unroll
    for (int i = 0; i < 64; ++i) v[i + 1] = bf2f(up_[(size_t)i * 6144]);
    v[65] = last ? 0.f : bf2f(up_[(size_t)64 * 6144]);
#pragma unroll
    for (int i = 0; i < 64; ++i) tile[lane * 65 + i] = v[i] * w0 + v[i + 1] * w1 + v[i + 2] * w2 + bb;
    LDS_WAIT(); asm volatile("" ::: "memory");
    float* op = VXT + ((size_t)b * 6144 + c0) * TPB + t0 + lane;
#pragma unroll 16
    for (int c = 0; c < 64; ++c) op[(size_t)c * TPB] = tile[c * 65 + lane];
    LDS_WAIT(); asm volatile("" ::: "memory");
}

__device__ __forceinline__ float dpp_sum16(float v) {
    v += __int_as_float(__builtin_amdgcn_update_dpp(0, __float_as_int(v), 0xB1, 0xF, 0xF, false));
    v += __int_as_float(__builtin_amdgcn_update_dpp(0, __float_as_int(v), 0x4E, 0xF, 0xF, false));
    v += __int_as_float(__builtin_amdgcn_update_dpp(0, __float_as_int(v), 0x141, 0xF, 0xF, false));
    v += __int_as_float(__builtin_amdgcn_update_dpp(0, __float_as_int(v), 0x140, 0xF, 0xF, false));
    return v;
}
__device__ __forceinline__ float dpp_sum8(float v) {
    v += __int_as_float(__builtin_amdgcn_update_dpp(0, __float_as_int(v), 0xB1, 0xF, 0xF, false));
    v += __int_as_float(__builtin_amdgcn_update_dpp(0, __float_as_int(v), 0x4E, 0xF, 0xF, false));
    v += __int_as_float(__builtin_amdgcn_update_dpp(0, __float_as_int(v), 0x141, 0xF, 0xF, false));
    return v;
}
template <class BGF, class BG>
__device__ __forceinline__ void rwkv_scan_unit(const Ctx& F, int unit, const bf16_t* DEC, const bf16_t* ASIG, const float* k_k, const float* k_a, const bf16_t* RKV, float* Y, BGF bg_finish, BG bg) {
    constexpr int T = 32, NCHUNK = TPB / T;
    const int chain = unit >> 1, rh = unit & 1, d = chain >> 6, b = (chain >> 5) & 1, h = chain & 31;
    LAS float* buf = (LAS float*)F.lds;
    const int tid = F.tid, wave = F.wave, lane = F.lane;
    const int rl = wave * 8 + (lane >> 3), kq = lane & 7;
    float* Yd = Y + (size_t)d * ROWS * DM + h * 64 + rh * 32 + rl;
#define RW_ROW(sg) ((size_t)b * TPB + (d == 0 ? (sg) : ((sg) < CTXL ? (CTXL - 1 - (sg)) : (TPB + CTXL - 1 - (sg)))))
    const int st = (tid - 256) & 255, q4 = st & 15, s0 = st >> 4;
    const int hc = h * 64 + q4 * 4;
    const f32x4 ka4 = *(const f32x4*)(k_a + hc), kk4 = *(const f32x4*)(k_k + hc), omka4 = 1.0f - ka4;
    u32x2 R[2][5];
#define BF4_(w_) ((f32x4){__uint_as_float((w_).x << 16), __uint_as_float((w_).x & 0xffff0000u), __uint_as_float((w_).y << 16), __uint_as_float((w_).y & 0xffff0000u)})
#define ST_ISSUE(ck_) do { _Pragma("unroll") for (int j_ = 0; j_ < 2; ++j_) { const size_t row_ = RW_ROW((ck_) * T + s0 + 16 * j_); \
            R[j_][0] = *(const u32x2*)(DEC + row_ * (2 * DM) + (size_t)d * DM + hc); R[j_][1] = *(const u32x2*)(RKV + ((size_t)ROWS + row_) * DM + hc); \
            R[j_][2] = *(const u32x2*)(ASIG + row_ * (2 * DM) + (size_t)d * DM + hc); R[j_][3] = *(const u32x2*)(RKV + row_ * DM + hc); R[j_][4] = *(const u32x2*)(RKV + ((size_t)2 * ROWS + row_) * DM + hc); } } while (0)
#define ST_WRITE(p_) do { _Pragma("unroll") for (int j_ = 0; j_ < 2; ++j_) { LAS float* o_ = buf + (((p_) * T + s0 + 16 * j_) * 6) * 64 + q4 * 4; \
            const f32x4 a_ = BF4_(R[j_][2]), k_ = BF4_(R[j_][1]), e_ = BF4_(R[j_][0]); \
            f32x4 kk_ = k_ * kk4;      \
            const float ss_ = dpp_sum16((kk_.x * kk_.x + kk_.y * kk_.y) + (kk_.z * kk_.z + kk_.w * kk_.w)); \
            kk_ = kk_ * rsqrtf(ss_ + 1e-12f); \
            *(LAS f32x4*)(o_) = (f32x4){__builtin_amdgcn_exp2f(-e_.x), __builtin_amdgcn_exp2f(-e_.y), __builtin_amdgcn_exp2f(-e_.z), __builtin_amdgcn_exp2f(-e_.w)}; *(LAS f32x4*)(o_ + 64) = k_ * (a_ * ka4 + omka4); *(LAS f32x4*)(o_ + 128) = kk_; *(LAS f32x4*)(o_ + 192) = kk_ * a_; \
            *(LAS f32x4*)(o_ + 256) = BF4_(R[j_][3]); *(LAS f32x4*)(o_ + 320) = BF4_(R[j_][4]); } } while (0)
    f32x2 S0 = (f32x2){0.f, 0.f}, S1 = S0, S2 = S0, S3 = S0;
    if (wave < 4) __builtin_amdgcn_s_setprio(3);
    __syncthreads();
    if (wave >= 4) { ST_ISSUE(0); ST_WRITE(0); ST_ISSUE(1); }
    __syncthreads();
#define RW_LD(W0, W1, K0, K1, A0, A1, B0, B1, R0_, R1_, VT, s_) do { const LAS float* base_ = cb + (s_) * 6 * 64; \
                W0 = *(const LAS f32x4*)(base_); W1 = *(const LAS f32x4*)(base_ + 4); K0 = *(const LAS f32x4*)(base_ + 64); K1 = *(const LAS f32x4*)(base_ + 68); \
                A0 = *(const LAS f32x4*)(base_ + 128); A1 = *(const LAS f32x4*)(base_ + 132); B0 = *(const LAS f32x4*)(base_ + 192); B1 = *(const LAS f32x4*)(base_ + 196); \
                R0_ = *(const LAS f32x4*)(base_ + 256); R1_ = *(const LAS f32x4*)(base_ + 260); VT = vb[(s_) * 6 * 64]; } while (0)
    f32x4 rp0 = (f32x4){0.f, 0.f, 0.f, 0.f}, rp1 = rp0; float yk = 0.f;
    float* yp = Yd + ((size_t)b * TPB + (d == 0 ? kq : CTXL - 1 - kq)) * DM;
    const long ystep = d == 0 ? (long)8 * DM : -(long)8 * DM, yjump = d == 0 ? 0 : (long)TPB * DM;
#define RW_YKEEP(gv_, y_, chk_) do { yk = (kq == ((gv_) & 7)) ? (y_) : yk; \
        if (((gv_) & 7) == 7) { *yp = yk; yp += ystep; if ((chk_) && (gv_) == CTXL - 1) yp += yjump; } } while (0)
#pragma unroll 1
    for (int ck = 0; ck < NCHUNK; ++ck) {
        const int p = ck & 1;
        if (wave >= 4) { if (ck + 1 < NCHUNK) ST_WRITE(p ^ 1); __builtin_amdgcn_s_waitcnt(0x0F70);     bg_finish(ck, wave - 4); if (ck + 2 < NCHUNK) ST_ISSUE(ck + 2); bg(ck, wave - 4); }
        else {
            const LAS float* cb = buf + p * T * 6 * 64 + kq * 8;
            const LAS float* vb = buf + p * T * 6 * 64 + 5 * 64 + rh * 32 + rl;
            f32x4 w0, w1, k0, k1, a0, a1, b0, b1, r0, r1; float vt;
            f32x4 nw0, nw1, nk0, nk1, na0, na1, nb0, nb1, nr0, nr1; float nvt;
            RW_LD(w0, w1, k0, k1, a0, a1, b0, b1, r0, r1, vt, 0);
#pragma unroll
            for (int s = 0; s < T; ++s) {
#define FENCE_() __builtin_amdgcn_sched_barrier(0)
#define DPPADD_(x_, c_) x_ += __int_as_float(__builtin_amdgcn_update_dpp(0, __float_as_int(x_), c_, 0xF, 0xF, false))
                const bool nx = (s + 1 < T);
                const LAS float* nb_ = cb + (s + 1) * 6 * 64;
                FENCE_();
                if (nx) { na0 = *(const LAS f32x4*)(nb_ + 128); na1 = *(const LAS f32x4*)(nb_ + 132); }
                FENCE_();
                f32x2 da = S0 * (f32x2){a0.x, a0.y};
                da = S2 * (f32x2){a1.x, a1.y} + da;
                f32x2 ya = S0 * (f32x2){rp0.x, rp0.y};
                ya = S2 * (f32x2){rp1.x, rp1.y} + ya;
                FENCE_();
                if (nx) { nk0 = *(const LAS f32x4*)(nb_ + 64); nvt = vb[(s + 1) * 6 * 64]; }
                FENCE_();
                da = S1 * (f32x2){a0.z, a0.w} + da; da = S3 * (f32x2){a1.z, a1.w} + da;
                ya = S1 * (f32x2){rp0.z, rp0.w} + ya; ya = S3 * (f32x2){rp1.z, rp1.w} + ya;
                FENCE_();
                if (nx) { nk1 = *(const LAS f32x4*)(nb_ + 68); nb0 = *(const LAS f32x4*)(nb_ + 192); }
                FENCE_();
                float xs = da.x + da.y, ys = ya.x + ya.y;
                const f32x2 vt2 = (f32x2){vt, vt};
                f32x2 t0 = vt2 * (f32x2){k0.x, k0.y}, t1 = vt2 * (f32x2){k0.z, k0.w};
                asm volatile("" : "+v"(t0), "+v"(t1));
                DPPADD_(xs, 0xB1); DPPADD_(ys, 0xB1);
                FENCE_();
                if (nx) { nb1 = *(const LAS f32x4*)(nb_ + 196); nw0 = *(const LAS f32x4*)(nb_); }
                FENCE_();
                f32x2 t2 = vt2 * (f32x2){k1.x, k1.y}, t3 = vt2 * (f32x2){k1.z, k1.w};
                asm volatile("" : "+v"(t2), "+v"(t3));
                DPPADD_(xs, 0x4E); DPPADD_(ys, 0x4E);
                FENCE_();
                if (nx) { nw1 = *(const LAS f32x4*)(nb_ + 4); nr0 = *(const LAS f32x4*)(nb_ + 256); }
                FENCE_();
                f32x2 p0 = S0 * (f32x2){w0.x, w0.y} + t0, p1 = S1 * (f32x2){w0.z, w0.w} + t1, p2 = S2 * (f32x2){w1.x, w1.y} + t2, p3 = S3 * (f32x2){w1.z, w1.w} + t3;
                asm volatile("" : "+v"(p0), "+v"(p1), "+v"(p2), "+v"(p3));
                DPPADD_(xs, 0x141); DPPADD_(ys, 0x141);
                FENCE_();
                if (nx) { nr1 = *(const LAS f32x4*)(nb_ + 260); }
                FENCE_();
                const f32x2 sa2 = (f32x2){-xs, -xs};
                S0 = sa2 * (f32x2){b0.x, b0.y} + p0; S1 = sa2 * (f32x2){b0.z, b0.w} + p1; S2 = sa2 * (f32x2){b1.x, b1.y} + p2; S3 = sa2 * (f32x2){b1.z, b1.w} + p3;
                if (s > 0) { RW_YKEEP(ck * T + s - 1, ys, false); } else if (ck > 0) { RW_YKEEP(ck * T - 1, ys, true); }
                FENCE_();
#undef FENCE_
#undef DPPADD_
                rp0 = r0; rp1 = r1;
                w0 = nw0; w1 = nw1; k0 = nk0; k1 = nk1; a0 = na0; a1 = na1; b0 = nb0; b1 = nb1; r0 = nr0; r1 = nr1; vt = nvt;
            }
        }
        __syncthreads();
    }
    if (wave < 4) {
        f32x2 ya = S0 * (f32x2){rp0.x, rp0.y}, yb = S2 * (f32x2){rp1.x, rp1.y};
        ya = S1 * (f32x2){rp0.z, rp0.w} + ya; yb = S3 * (f32x2){rp1.z, rp1.w} + yb; ya = ya + yb;
        const float ys = dpp_sum8(ya.x + ya.y);
        RW_YKEEP(TPB - 1, ys, false);
    }
    __builtin_amdgcn_s_setprio(0);
#undef RW_YKEEP
#undef RW_LD
#undef ST_ISSUE
#undef BF4_
#undef ST_WRITE
#undef RW_ROW
}
__device__ __forceinline__ float head_sum16(float v) { v += __shfl_xor(v, 1); v += __shfl_xor(v, 2); v += __shfl_xor(v, 4); v += __shfl_xor(v, 8); return v; }
__device__ __forceinline__ void rwkv_shift_row(const bf16_t* HLF, const float* mix, bf16_t* XS, int r, int lane) {
    const int t = r % TPB;
    const bool hp = (t != 0) && (t != CTXL), hn = (t != CTXL - 1) && (t != TPB - 1);
    const bf16_t* h0 = HLF + (size_t)r * DM + 8 * lane;
    const f32x4 z4 = (f32x4){0.f, 0.f, 0.f, 0.f};
#pragma unroll 2
    for (int j = 0; j < 4; ++j) {
        f32x4 ha, hb, pa = z4, pb = z4, na = z4, nb = z4;
        ld8bf(h0 + 512 * j, ha, hb); if (hp) ld8bf(h0 + 512 * j - DM, pa, pb); if (hn) ld8bf(h0 + 512 * j + DM, na, nb);
        const f32x4 dpa = pa - ha, dpb = pb - hb, dna = na - ha, dnb = nb - hb;
#pragma unroll
        for (int k = 0; k < 6; ++k) {
            const f32x4* m0 = (const f32x4*)(mix + (size_t)k * DM) + 2 * lane + 128 * j; const f32x4* m1 = (const f32x4*)(mix + (size_t)(6 + k) * DM) + 2 * lane + 128 * j;
            st8bf(XS + ((size_t)k * ROWS + r) * DM + 8 * lane + 512 * j, ha + dpa * m0[0] + dna * m1[0], hb + dpb * m0[1] + dnb * m1[1]);
        }
    }
}
__device__ __forceinline__ void rwkv_prep_row(const float* Kf, const float* k_k, float* KK, int r, int lane) {
#pragma unroll 2
    for (int j = 0; j < 8; ++j) {
        const int q = lane + 64 * j;
        const f32x4 k = ((const f32x4*)(Kf + (size_t)r * DM))[q], kkw = ((const f32x4*)k_k)[q];
        f32x4 kk = k * kkw;
        const float ss = head_sum16((kk.x * kk.x + kk.y * kk.y) + (kk.z * kk.z + kk.w * kk.w));
        ((f32x4*)(KK + (size_t)r * DM))[q] = kk * rsqrtf(ss + 1e-12f);
    }
}
__device__ __forceinline__ void rwkv_readout_row(const float* Y, const bf16_t* RKV, const bf16_t* ASIG, const float* k_a, const bf16_t* Gf, const float* r_k, const float* ln_w, const float* ln_b, bf16_t* out, int r, int lane) {
#pragma unroll 2
    for (int j = 0; j < 4; ++j) {
        const int c8 = 8 * lane + 512 * j, q = 2 * lane + 128 * j;
        const f32x4* y0 = (const f32x4*)(Y + (size_t)r * DM) + q; const f32x4* y1 = (const f32x4*)(Y + ((size_t)ROWS + r) * DM) + q;
        const f32x4 ya = y0[0] + y1[0], yb = y0[1] + y1[1];
        const float mu = dpp_sum8(((ya.x + ya.y) + (ya.z + ya.w)) + ((yb.x + yb.y) + (yb.z + yb.w))) * (1.0f / 64.0f);
        const f32x4 da = ya - mu, db = yb - mu;
        const float var = dpp_sum8(((da.x * da.x + da.y * da.y) + (da.z * da.z + da.w * da.w)) + ((db.x * db.x + db.y * db.y) + (db.z * db.z + db.w * db.w))) * (1.0f / 64.0f);
        const float rs = rsqrtf(var + 64e-5f);
        f32x4 na = da * rs * ((const f32x4*)ln_w)[q] + ((const f32x4*)ln_b)[q], nb = db * rs * ((const f32x4*)ln_w)[q + 1] + ((const f32x4*)ln_b)[q + 1];
        f32x4 ra, rb, va, vb, ka, kb, a0a, a0b, a1a, a1b, ga, gb;
        ld8bf(RKV + (size_t)r * DM + c8, ra, rb); ld8bf(RKV + ((size_t)2 * ROWS + r) * DM + c8, va, vb); ld8bf(RKV + ((size_t)ROWS + r) * DM + c8, ka, kb);
        ld8bf(ASIG + (size_t)r * 2 * DM + c8, a0a, a0b); ld8bf(ASIG + (size_t)r * 2 * DM + DM + c8, a1a, a1b); ld8bf(Gf + (size_t)r * DM + c8, ga, gb);
        const f32x4 ksa = ka * (2.0f + ((a0a + a1a) - 2.0f) * ((const f32x4*)k_a)[q]), ksb = kb * (2.0f + ((a0b + a1b) - 2.0f) * ((const f32x4*)k_a)[q + 1]);
        const f32x4 pa = ra * ((const f32x4*)r_k)[q] * ksa, pb = rb * ((const f32x4*)r_k)[q + 1] * ksb;
        const float bs = dpp_sum8(((pa.x + pa.y) + (pa.z + pa.w)) + ((pb.x + pb.y) + (pb.z + pb.w)));
        na = (na + bs * va) * ga; nb = (nb + bs * vb) * gb;
        st8bf(out + (size_t)r * DM + c8, na, nb);
    }
}

template <int HALF> __device__ __forceinline__ void rope_sincos(float pos, int lane, float& sn, float& cs) { sincosf(pos * rope_invfreq(lane & (HALF - 1), HALF), &sn, &cs); }
template <int HALF> __device__ __forceinline__ float rope_apply(float u, float sn, float cs, int lane) {
    const float up = __shfl_xor(u, HALF);
    return (lane & HALF) ? (up * sn + u * cs) : (u * cs - up * sn);
}
__device__ __forceinline__ void mla_row_a(const bf16_t* RAW, const float* qg, const float* kvg, bf16_t* CQN, bf16_t* CKVN, bf16_t* Kb, const LAS f32x2* rope_t, int r, int lane) {
    const bf16_t* raw = RAW + (size_t)r * 1280;
    const int t = r % TPB;
#pragma unroll
    for (int part = 0; part < 2; ++part) {
        f32x4 a, b; ld8bf(raw + part * 512 + 8 * lane, a, b);
        const float ss = wave_sum((a.x * a.x + a.y * a.y) + (a.z * a.z + a.w * a.w) + (b.x * b.x + b.y * b.y) + (b.z * b.z + b.w * b.w));
        const float rinv = rsqrtf(ss * (1.0f / 512.0f) + 1e-6f);
        const float* g = part ? kvg : qg;
        st8bf((part ? CKVN : CQN) + (size_t)r * 512 + 8 * lane, a * rinv * ((const f32x4*)g)[2 * lane], b * rinv * ((const f32x4*)g)[2 * lane + 1]);
    }
    float kp = bf2f(raw[1024 + lane]);
    if (t >= CTXL) { const int l = t - CTXL, pos = (lane < 32) ? (l >> 6) : (l & 63); const f32x2 cs = rope_t[pos * 16 + (lane & 15)];
        const float up = __shfl_xor(kp, 16); kp = (lane & 16) ? (up * cs.y + kp * cs.x) : (kp * cs.x - up * cs.y); }
    float kv[8];
#pragma unroll
    for (int e = 0; e < 8; ++e) kv[e] = __shfl(kp, (lane & 7) * 8 + e);
    const f32x4 ka = (f32x4){kv[0], kv[1], kv[2], kv[3]}, kb = (f32x4){kv[4], kv[5], kv[6], kv[7]};
#pragma unroll
    for (int p = 0; p < 2; ++p) st8bf(Kb + (size_t)r * 3072 + (8 * p + (lane >> 3)) * 192 + 128 + (lane & 7) * 8, ka, kb);
}
__device__ __forceinline__ void mla_row_q(const bf16_t* QRAW, bf16_t* Qb, const LAS f32x2* rope_t, int r, int lane) {
    const bf16_t* q = QRAW + (size_t)r * 3072; bf16_t* o = Qb + (size_t)r * 3072;
    const int l = (r % TPB) - CTXL; const bool lat = l >= 0;
#pragma unroll
    for (int p = 0; p < 4; ++p) { const int gi = p * 64 + lane, off = (gi >> 4) * 192 + (gi & 15) * 8; *(u32x4*)(o + off) = *(const u32x4*)(q + off); }
    const int e8 = (lane & 7) * 8; const bool second = (lane & 2) != 0;
    f32x2 cssn[8];
    if (lat) { const int pos = (e8 < 32) ? (l >> 6) : (l & 63); const LAS f32x2* tp = rope_t + pos * 16 + (e8 & 15);
#pragma unroll
        for (int e = 0; e < 8; ++e) cssn[e] = tp[e]; }
#pragma unroll
    for (int p = 0; p < 2; ++p) { const int off = (8 * p + (lane >> 3)) * 192 + 128 + e8;
        if (!lat) { *(u32x4*)(o + off) = *(const u32x4*)(q + off); continue; }
        f32x4 xa, xb; ld8bf(q + off, xa, xb);
        float y[8] = {xa.x, xa.y, xa.z, xa.w, xb.x, xb.y, xb.z, xb.w};
#pragma unroll
        for (int e = 0; e < 8; ++e) { const float yp = __shfl_xor(y[e], 2); y[e] = second ? (yp * cssn[e].y + y[e] * cssn[e].x) : (y[e] * cssn[e].x - yp * cssn[e].y); }
        st8bf(o + off, (f32x4){y[0], y[1], y[2], y[3]}, (f32x4){y[4], y[5], y[6], y[7]}); }
}
__device__ __forceinline__ void gqa_row(const bf16_t* RAW, const float* qg, const float* kg, bf16_t* Qb, bf16_t* Kb, bf16_t* Vb, const LAS f32x2* rope_t, int r, int lane) {
    const bf16_t* raw = RAW + (size_t)r * 4096;
    const int l = (r % TPB) - CTXL;
    const int d8 = (lane & 15) * 8, hl = lane >> 4;
    const bool lat = l >= 0, second = (lane & 4) != 0;
    f32x2 cssn[8];
    if (lat) { const int pos = (d8 < 64) ? (l >> 6) : (l & 63); const LAS f32x2* tp = rope_t + pos * 32 + (d8 & 31);
#pragma unroll
        for (int e = 0; e < 8; ++e) cssn[e] = tp[e]; }
#pragma unroll 1
    for (int p = lat ? 0 : 4; p < 6; ++p) {
        const int hh = 4 * p + hl;
        f32x4 xa, xb; ld8bf(raw + hh * 128 + d8, xa, xb);
        const float ss = dpp_sum16((xa.x * xa.x + xa.y * xa.y) + (xa.z * xa.z + xa.w * xa.w) + (xb.x * xb.x + xb.y * xb.y) + (xb.z * xb.z + xb.w * xb.w));
        const float rinv = rsqrtf(ss * (1.0f / 128.0f) + 1e-6f);
        const float* g = (p < 4) ? qg : kg;
        xa = xa * rinv * *(const f32x4*)(g + d8); xb = xb * rinv * *(const f32x4*)(g + d8 + 4);
        if (lat) {
            float y[8] = {xa.x, xa.y, xa.z, xa.w, xb.x, xb.y, xb.z, xb.w};
#pragma unroll
            for (int e = 0; e < 8; ++e) { const float yp = __shfl_xor(y[e], 4); y[e] = second ? (yp * cssn[e].y + y[e] * cssn[e].x) : (y[e] * cssn[e].x - yp * cssn[e].y); }
            xa = (f32x4){y[0], y[1], y[2], y[3]}; xb = (f32x4){y[4], y[5], y[6], y[7]};
        }
        st8bf((p < 4) ? (Qb + (size_t)r * 2048 + hh * 128 + d8) : (Kb + (size_t)r * 1024 + (hh - 16) * 128 + d8), xa, xb);
    }
#pragma unroll
    for (int j = 0; j < 2; ++j) ((u32x4*)(Vb + (size_t)r * 1024))[lane + 64 * j] = ((const u32x4*)(raw + 3072))[lane + 64 * j];
}
struct Args { const float* in[49]; float* out; unsigned char* ws; int ph_lo, ph_hi, li, pad; };
constexpr int N_PHASES = 52;

#ifndef WGM_DN
#define WGM_DN 2
#endif
#define RUN_GEMM(EPI_T, epi, A_, Bt_, K_, ...) RUN_GEMM_W(2, EPI_T, epi, A_, Bt_, K_, __VA_ARGS__)
#define RUN_GEMM_W(W_, EPI_T, epi, A_, Bt_, K_, ...) do { typedef pg8::TSched<W_, __VA_ARGS__> Sch_; Sch_ S_; S_.init(F.G, F.bid); pg8::gemm_phase<EPI_T, Sch_>(F.lds, pg8::Gemm{(const bf16_t*)(A_), (const bf16_t*)(Bt_), (K_)}, S_, (epi)); } while (0)

#define FFN_PHASES(p0, l, s, lat_only, nsp) do { \
    const float* mods_l_ = MODS + (size_t)(l) * 3 * NMOD * DM; const int h_ = (s) ? 1 : 0; \
    PHASE((p0)) { const float* g_ = AIN(6) + (size_t)((l) * 3 + (s)) * DM; \
        for (int r = F.gw; r < ROWS; r += F.NGW) { if ((lat_only) && (r % TPB) < CTXL) continue; f32x4 y[8]; modnorm_row(X, g_, mods_l_, (s), r, F.lane, y, (nsp) ? PART : nullptr, (nsp)); store_row_bf16(NBF + (size_t)r * DM, F.lane, y); } \
        if (BOTH((p0))) GRID_BAR(); } \
    PHASE((p0) + 1) { pg8::EpiSwiglu E{ACT}; \
        RUN_GEMM(pg8::EpiSwiglu, E, NBF, ws + WS_W + W_GU((l), h_), DM, (lat_only) ? 32 : NPAN, 44, 0, 0, 1, (lat_only) ? 1 : 0); if (BOTH((p0) + 1)) GRID_BAR(); } \
    PHASE((p0) + 2) { pg8::EpiResid E{X, mods_l_, 3 * (s) + 2, A.pad ? 0.f : 0.5f, nullptr}; \
        RUN_GEMM_W(WGM_DN, pg8::EpiResid, E, ACT, ws + WS_W + W_DN((l), h_), FF, 32, 8, 0, 0, 1, 1, (lat_only) ? 0 : 2, 8, 0, 0, 11, 2);     if (BOTH((p0) + 2)) GRID_BAR(); } \
} while (0)

__device__ __forceinline__ const float* ain_(const Args& A, int i) { asm volatile("" : "+s"(i)); return A.in[i]; }
constexpr int BG_NFFN = 5 * 16896, BG_NSLOTS = BG_NFFN + 2048 + 1280 + 1792 + 2048 + 4096 + 2048;
template <bool ISSUE_ONLY>
__device__ __forceinline__ bool bg_convert_slot(const Args& A, int slot, LAS float* scr, int lane, f32x4 (&v)[8], bf16_t*& dstp, int& Kd) {
    if (slot >= BG_NSLOTS) return false;
    unsigned char* W = A.ws + WS_W;
    int idx, stride, KD, n0, k0, kind = 0; size_t soff = 0, doff;
#define TILE_(ND_, it_) do { n0 = ((it_) % ((ND_) / 32)) * 32; k0 = ((it_) / ((ND_) / 32)) * 64; } while (0)
    if (slot < BG_NFFN) {
        const int lh = 3 + slot / 16896, r = slot % 16896;
        if (r < 11264) { idx = 7; soff = (size_t)lh * DM * (2 * FF); stride = 2 * FF; KD = DM; doff = W_GU(lh >> 1, lh & 1); TILE_(2 * FF, r); kind = 1; }
        else { idx = 8; soff = (size_t)lh * FF * DM; stride = DM; KD = FF; doff = W_DN(lh >> 1, lh & 1); TILE_(DM, r - 11264); }
    } else {
        int r = slot - BG_NFFN;
        if (r < 2048) { idx = 37; stride = DM; KD = DM; doff = W_RW_WO; TILE_(DM, r); }
        else if ((r -= 2048) < 1280) { idx = 38; stride = 1088; KD = DM; doff = W_ML_WD; TILE_(1280, r); kind = 2; }
        else if ((r -= 1280) < 1792) { idx = 40; stride = 3072; KD = 512; doff = W_ML_BT3; TILE_(7168, r); kind = 3; }
        else if ((r -= 1792) < 2048) { idx = 43; stride = DM; KD = DM; doff = W_ML_WO; TILE_(DM, r); }
        else if ((r -= 2048) < 4096) { idx = 44; stride = 2 * DM; KD = DM; doff = W_GQ_QKV; TILE_(2 * DM, r); }
        else { r -= 4096; idx = 47; stride = DM; KD = DM; doff = W_GQ_WO; TILE_(DM, r); }
    }
#undef TILE_
    bf16_t* dp = (bf16_t*)(W + doff) + (size_t)n0 * KD + k0;
    const int kr = lane >> 3, n = n0 + (lane & 7) * 4;
    int col = n;
    if (kind == 1) col = ((n >> 7) & 1) * FF + (n >> 8) * 128 + (n & 127);
    if (kind == 2 && n0 >= 1088) {
        const u32x4 z = (u32x4){0u, 0u, 0u, 0u};
#pragma unroll
        for (int j = 0; j < 4; ++j) *(u32x4*)(dp + (size_t)((lane >> 3) + 8 * j) * KD + 8 * (lane & 7)) = z;
        return false; }
    if (kind == 3 && n0 >= 3072) { idx = 42; stride = 4096; col = n - 3072; }
    const float* sp = ain_(A, idx) + soff + (size_t)(k0 + 8 * kr) * stride + col;
#pragma unroll
    for (int i = 0; i < 8; ++i) v[i] = *(const f32x4*)(sp + (size_t)i * stride);
    if (ISSUE_ONLY) { dstp = dp; Kd = KD; return true; }
    conv_tile_store(v, dp, KD, scr, lane); return false;
}
__global__ void __launch_bounds__(NTHR, 2) fwd_kernel(Args A) {
    extern __shared__ __attribute__((aligned(16))) unsigned char lds_raw[];
    Ctx F;
    F.lds = (LAS unsigned char*)lds_raw;
    F.tid = threadIdx.x; F.lane = F.tid & 63; F.wave = __builtin_amdgcn_readfirstlane(F.tid >> 6);
    F.bid = blockIdx.x; F.G = gridDim.x; F.gw = F.bid * NWAVES + F.wave; F.NGW = F.G * NWAVES;
    volatile LAS unsigned* MISC = (volatile LAS unsigned*)(F.lds + MISC_OFF);
    if (F.tid < 32) MISC[F.tid] = 0u;
    __syncthreads();
    const int lo = A.ph_lo, hi = A.ph_hi;
#ifdef STAMP_PH
    if (F.bid == 0 && F.tid == 0) { const unsigned long long t_ = wall_clock64(); MISC[16] = (unsigned)t_; MISC[17] = (unsigned)(t_ >> 32); }
#endif
    XcdBarrier bar; bar.bar = (unsigned*)(A.ws + WS_CTL) + CW_BAR + A.li * XCD_BAR_WORDS; bar.x = 0; bar.st = MISC + 8;
    if (hi - lo > 1) bar = xcd_barrier_post((unsigned*)(A.ws + WS_CTL) + CW_BAR + A.li * XCD_BAR_WORDS, MISC + 8);
#ifndef PH_MIN
#define PH_MIN 0
#define PH_MAX 1000
#endif
#define IN(k) ((k) >= PH_MIN && (k) <= PH_MAX && lo <= (k) && (k) < hi)
#define BOTH(k) (IN(k) && IN((k) + 1))
#ifdef STAMP_PH
#define PHASE(k) if ((k) == STAMP_PH + 1) { if (F.bid == 0 && F.tid == 0) { const unsigned long long t_ = wall_clock64(); MISC[18] = (unsigned)t_; MISC[19] = (unsigned)(t_ >> 32); } } if (IN(k))
#else
#define PHASE(k) if (IN(k))
#endif
#define GRID_BAR() xcd_barrier(bar)
#define ws (A.ws)
#define AIN(i) ain_(A, (i))
#define MODS ((float*)(ws + WS_MODS))
#define TW ((f32x2*)(ws + WS_TW))
#define HIDA ((bf16_t*)(ws + WS_HIDA))
#define ADAP ((float*)(ws + WS_ADAP))
#define X ((bf16_t*)(ws + WS_X))
#define NBF ((bf16_t*)(ws + WS_NB))
#define ACT ((bf16_t*)(ws + WS_ACT))
#define mix (ws + WS_MIX)
#define PART ((bf16_t*)(ws + WS_PART))

    PHASE(0) {
        { const float* xin = AIN(0); const float* cin = AIN(2);
          for (size_t i = (size_t)F.bid * NTHR + F.tid; i < (size_t)ROWS * (DM / 4); i += (size_t)F.G * NTHR) {
              const int r = (int)(i / (DM / 4)), c4 = (int)(i % (DM / 4)), b = r / TPB, t = r % TPB;
              const float* src = (t < CTXL) ? cin + ((size_t)b * CTXL + t) * DM : xin + ((size_t)b * SEQ + (t - CTXL)) * DM;
              const f32x4 v_ = ((const f32x4*)src)[c4]; u32x2 w_; w_.x = cvt_pk_bf16(v_.x, v_.y); w_.y = cvt_pk_bf16(v_.z, v_.w); ((u32x2*)(X + (size_t)r * DM))[c4] = w_; } }
        for (int k = F.bid * NTHR + F.tid; k < 8192; k += F.G * NTHR) { float sn, cs; sincospif((float)k * (1.0f / 4096.0f), &sn, &cs); TW[k] = (f32x2){cs, -sn}; }
        { LAS float* sl = (LAS float*)(F.lds + 73728);
          for (int i = F.tid; i < 3 * DM; i += NTHR) { const float v = (i < 2 * DM) ? AIN(1)[i] : AIN(3)[i - 2 * DM]; sl[i] = v / (1.0f + expf(-v)); }
          __syncthreads(); }
        { LAS float* scr = (LAS float*)(F.lds + F.wave * 8448);
          unsigned char* W = ws + WS_W;
#define LD4(p_) (*(const f32x4*)(p_))
          const f32x4 z4 = (f32x4){0.f, 0.f, 0.f, 0.f};
#pragma unroll 1
          for (int lh = 0; lh < 3; ++lh) {
              const float* sg = AIN(7) + (size_t)lh * DM * (2 * FF); const float* sd = AIN(8) + (size_t)lh * FF * DM;
              CONV_JOB(2 * FF, DM, W + W_GU(lh >> 1, lh & 1), [=](int n, int k) { const int sn = ((n >> 7) & 1) * FF + (n >> 8) * 128 + (n & 127); return LD4(sg + (size_t)k * (2 * FF) + sn); });
              CONV_JOB(DM, FF, W + W_DN(lh >> 1, lh & 1), [=](int n, int k) { return LD4(sd + (size_t)k * DM + n); });
          }
          { const float* s = AIN(9);  CONV_JOB(3 * DM, DM, W + W_HY_IN, [=](int n, int k) { return LD4(s + (size_t)k * (3 * DM) + n); }); }
          { const float* s = AIN(20); CONV_JOB(DM, DM, W + W_HY_OUT, [=](int n, int k) { return LD4(s + (size_t)k * DM + n); }); }
          { const float* s = AIN(17); CONV_JOB(4 * DM, 256, W + W_HY_F3, [=](int n, int k) { const int seg = k >> 6; if (seg == 3) return z4; const f32x4 w = LD4(s + (size_t)(k & 63) * (4 * DM) + n);
                const f32x4 h = (f32x4){bf_hi(w.x), bf_hi(w.y), bf_hi(w.z), bf_hi(w.w)}; return seg == 2 ? w - h : h; }); }
          { const float* s = AIN(23); const float* w1 = AIN(25); const float* a1 = AIN(28); const float* g1 = AIN(30);
            CONV_JOB(6912, DM, W + W_RW_BT1, [=](int n, int k) { if (n < 3 * DM) return LD4(s + ((size_t)(n >> 11) * DM + k) * DM + (n & (DM - 1)));
                const int j = n - 3 * DM, blk = j >> 8, jj = j & 255; if (blk == 2) return LD4(g1 + (size_t)k * 256 + jj); if (jj >= 192) return z4;
                const int d = jj / 96, e = jj - d * 96; return LD4((blk ? a1 : w1) + ((size_t)d * DM + k) * 96 + e); }); }
          { const float* w2 = AIN(26); const float* a2 = AIN(29); const float* g2 = AIN(31);
            CONV_JOB(10240, 256, W + W_RW_BT2, [=](int n, int k) { if (n >= 4 * DM) return LD4(g2 + (size_t)k * DM + (n - 4 * DM));
                const int blk = n >> 12, nn = n & 4095, d = nn >> 11, c = nn & (DM - 1), kk = k - 96 * d; if (kk < 0 || kk >= 96) return z4;
                return LD4((blk ? a2 : w2) + ((size_t)d * 96 + kk) * DM + c); }); }
#undef LD4
        }
        {
        const float* fw1 = AIN(13); const float* fb1 = AIN(14); const float* fw2 = AIN(15); const float* fb2 = AIN(16); const float* sf = AIN(18);
        for (int m = F.gw; m < 4352; m += F.NGW) {
            const int L = (m < 4096) ? 4096 : 256, mm = (m < 4096) ? m : m - 4096, j = F.lane;
            const float wv = (float)(6.283185307179586 / (double)L) * (float)mm;
            float z = 0.f;
            if (j == 0) z = (float)mm / (float)(L - 1);
            else if (j <= 16) z = cosf((1e-4f + (float)(j - 1) * ((15.0f - 1e-4f) / 15.0f)) * wv);
            else if (j <= 32) z = -sinf((1e-4f + (float)(j - 17) * ((15.0f - 1e-4f) / 15.0f)) * wv);
            float acc = fb1[j];
#pragma unroll
            for (int i = 0; i < 33; ++i) acc += __shfl(z, i) * fw1[i * 64 + j];
            const float h1 = sinf(sf[j] * acc);
            acc = fb2[j];
#pragma unroll
            for (int i = 0; i < 64; ++i) acc += __shfl(h1, i) * fw2[i * 64 + j];
            const float h2 = sinf(sf[64 + j] * acc);
            const float hh = bf_hi(h2);
            bf16_t* o = HIDA + (size_t)m * 256;
            const bf16_t bh = (bf16_t)(cvt_pk_bf16(hh, 0.f) & 0xffffu), bl = (bf16_t)(cvt_pk_bf16(h2 - hh, 0.f) & 0xffffu);
            o[j] = bh; o[64 + j] = bl; o[128 + j] = bh; o[192 + j] = 0; }
        }
        {
          LAS float* sl = (LAS float*)(F.lds + 73728);
          const float* aw = AIN(4); unsigned* qctr = (unsigned*)(ws + WS_CTL) + 200000;
          for (;;) {
              if (F.tid == 0) MISC[24] = __hip_atomic_fetch_add(qctr, 1u, __ATOMIC_RELAXED, __HIP_MEMORY_SCOPE_AGENT);
              __syncthreads(); const int unit = (int)MISC[24]; __syncthreads();
              if (unit >= 4 * 9 * 16) break;
              const int l = unit / 144, rem = unit % 144, cc = rem / 16, kc = rem % 16, col = cc * 2048 + F.tid * 4;
              f32x4 a0 = (f32x4){0.f, 0.f, 0.f, 0.f}, a1 = a0, a2 = a0;
              const float* wp = aw + ((size_t)l * DM + kc * 128) * NADA + col;
#pragma unroll 8
              for (int k = 0; k < 128; ++k) { const f32x4 w = *(const f32x4*)(wp + (size_t)k * NADA); const int kk = kc * 128 + k;
                  a0 += w * sl[kk]; a1 += w * sl[DM + kk]; a2 += w * sl[2 * DM + kk]; }
              float* op = ADAP + ((size_t)(kc * 4 + l) * 3) * NADA + col;
              *(f32x4*)op = a0; *(f32x4*)(op + NADA) = a1; *(f32x4*)(op + 2 * NADA) = a2; }
        }
        if (BOTH(0)) GRID_BAR();
    }
    PHASE(1) {
        const float* ab = AIN(5);
        for (int i = F.bid * NTHR + F.tid; i < 4 * 3 * NADA; i += F.G * NTHR) {
            const int l = i / (3 * NADA), n = i % NADA; float s = ab[(size_t)l * NADA + n];
#pragma unroll
            for (int kc = 0; kc < 16; ++kc) s += ADAP[(size_t)kc * 12 * NADA + i];
            MODS[i] = s; }
        if (BOTH(1)) GRID_BAR();
    }
    FFN_PHASES(2, 0, 0, 0, 0);
    { const float* mods_l = MODS;
      bf16_t* U = (bf16_t*)(mix + HY_U); float* VXT = (float*)(mix + HY_VXT); float* HFT = (float*)(mix + HY_HFT); bf16_t* ZT = (bf16_t*)(mix + HY_U);
      PHASE(5) { const float* g = AIN(6) + (size_t)(0 * 3 + 1) * DM;
          for (int r = F.gw; r < ROWS; r += F.NGW) { f32x4 y[8]; modnorm_row(X, g, mods_l, 1, r, F.lane, y, PART, 11); store_row_bf16(NBF + (size_t)r * DM, F.lane, y); }
          { pg8::EpiHyF E{HFT, HFT + (size_t)8192 * 4096}; RUN_GEMM(pg8::EpiHyF, E, HIDA, ws + WS_W + W_HY_F3, 256, 17, 32, 0, 0, 1, 0); }
          if (BOTH(5)) GRID_BAR(); }
      PHASE(6) { pg8::EpiBf16B E{U, 3 * DM, AIN(10)};
          RUN_GEMM(pg8::EpiBf16B, E, NBF, ws + WS_W + W_HY_IN, DM, NPAN, 24, 0, 0, 1, 0); if (BOTH(6)) GRID_BAR(); }
      PHASE(7) { __syncthreads(); for (int unit = F.gw; unit < 2 * 68 * 96; unit += F.NGW) hyena_conv3_unit(unit, U, AIN(11), AIN(12), VXT, (LAS float*)(F.lds + F.wave * 16640), F.lane); if (BOTH(7)) GRID_BAR(); }
      PHASE(8) { __syncthreads();
          { LAS f32x2* twl = (LAS f32x2*)(F.lds + 69632);
            for (int e = F.tid; e < FFT_TW; e += NTHR) { const int s = e < 2048 ? 0 : (e < 2560 ? 1 : (e < 2688 ? 2 : (e < 2720 ? 3 : (e < 2728 ? 4 : 5)))); const int ix = (e - fft_toff(s)) << (2 * s);
                twl[e] = TW[ix]; twl[FFT_TW + e] = TW[2 * ix]; twl[2 * FFT_TW + e] = TW[3 * ix]; }
            __syncthreads(); }
          { const LAS f32x2* twl = (const LAS f32x2*)(F.lds + 69632);
            for (int c = F.bid; c < DM; c += F.G) hyena_channel<12, NTHR, false>(F.lds, twl, (LAS float*)(F.lds + 135168), F.tid, c, VXT, HFT, AIN(19), ZT);
            __syncthreads();
            for (int c = F.gw; c < DM; c += F.NGW) hyena_channel<8, 64, true>(F.lds + F.wave * 4352, twl, nullptr, F.lane, c, VXT, HFT + (size_t)8192 * 4096, AIN(19), ZT); }
          if (BOTH(8)) GRID_BAR(); }
      PHASE(9) { __syncthreads();
          LAS bf16_t* tile = (LAS bf16_t*)F.lds;
          for (int unit = F.bid; unit < 136 * 32; unit += F.G) { const int r0 = (unit % 136) * 64, c0 = (unit / 136) * 64;
#pragma unroll
              for (int k = 0; k < 8; ++k) { const int cl = 8 * k + (F.tid >> 6); tile[cl * 66 + F.lane] = ZT[(size_t)(c0 + cl) * ROWS + r0 + F.lane]; }
              __syncthreads();
              { const int rl = F.tid >> 3, cs = (F.tid & 7) * 8; unsigned w[4];
#pragma unroll
                for (int e = 0; e < 4; ++e) w[e] = (unsigned)tile[(cs + 2 * e) * 66 + rl] | ((unsigned)tile[(cs + 2 * e + 1) * 66 + rl] << 16);
                *(u32x4*)(NBF + (size_t)(r0 + rl) * DM + c0 + cs) = (u32x4){w[0], w[1], w[2], w[3]}; }
              __syncthreads(); }
          if (BOTH(9)) GRID_BAR(); }
      PHASE(10) { pg8::EpiResid E{X, mods_l, 5, A.pad ? 0.f : 1.0f, AIN(21)};
          RUN_GEMM(pg8::EpiResid, E, NBF, ws + WS_W + W_HY_OUT, DM, 32, 8, 0, 0, 1, 1, 2, 8, 0, 0, 4, 2); if (BOTH(10)) GRID_BAR(); }
    }
    FFN_PHASES(11, 0, 2, 0, 4);
    FFN_PHASES(14, 1, 0, 0, 11);
    { const float* mods_l = MODS + (size_t)1 * 3 * NMOD * DM;
      bf16_t* XS = (bf16_t*)(mix + RW_XS); bf16_t* HLF = (bf16_t*)(mix + RW_HLF);
      bf16_t* RKV = (bf16_t*)(mix + RW_RKV); bf16_t* LM = (bf16_t*)(mix + RW_LM); bf16_t* DEC = (bf16_t*)(mix + RW_DEC); bf16_t* ASIG = (bf16_t*)(mix + RW_ASIG); float* Y = (float*)(mix + RW_Y);
      bf16_t* Gf = (bf16_t*)(mix + RW_G);
      PHASE(17) { const float* g = AIN(6) + (size_t)(1 * 3 + 1) * DM;
          for (int r = F.gw; r < ROWS; r += F.NGW) { f32x4 y[8]; modnorm_row(X, g, mods_l, 1, r, F.lane, y, PART, 11); store_row_bf16(HLF + (size_t)r * DM, F.lane, y); }
          if (BOTH(17)) GRID_BAR(); }
      PHASE(18) { for (int r = F.gw; r < ROWS; r += F.NGW) rwkv_shift_row(HLF, AIN(22), XS, r, F.lane); if (BOTH(18)) GRID_BAR(); }
      PHASE(19) {
          pg8::EpiRw1 E{RKV, LM}; RUN_GEMM(pg8::EpiRw1, E, XS, ws + WS_W + W_RW_BT1, DM, NPAN, 8, 0 * NPAN, 0, 1, 0, NPAN, 8, 2 * NPAN, 8, 1, 0, NPAN, 8, 3 * NPAN, 16, 1, 0, NPAN, 1, 1 * NPAN, 24, 1, 0, NPAN, 1, 4 * NPAN, 25, 1, 0, NPAN, 1, 5 * NPAN, 26, 1, 0);
          if (BOTH(19)) GRID_BAR(); }
      PHASE(20) { pg8::EpiRw2 E{DEC, ASIG, Gf, AIN(24), AIN(27)};
          RUN_GEMM(pg8::EpiRw2, E, LM, ws + WS_W + W_RW_BT2, 256, NPAN, 16, 0 * NPAN, 0, 1, 0, NPAN, 16, 1 * NPAN, 16, 1, 0, NPAN, 8, 2 * NPAN, 32, 1, 0); if (BOTH(20)) GRID_BAR(); }
      PHASE(21) {
          int nslot_done = 0;
          f32x4 bv[8]; bf16_t* bdst = nullptr; int bKd = 0; bool bpend = false;
          for (int unit = F.bid; unit < 256; unit += F.G) {
              const int first = (unit == F.bid);
              auto bgf = [&](int ck, int w4) { if (!first) return; LAS float* scr = (LAS float*)(F.lds + 98304 + w4 * 8448);
                  if (bpend) { conv_tile_store(bv, bdst, bKd, scr, F.lane); bpend = false; } };
              auto bg = [&](int ck, int w4) { if (!first) return; LAS float* scr = (LAS float*)(F.lds + 98304 + w4 * 8448);
                  const int slot = ck * (F.G * 4) + F.bid * 4 + w4;
                  bpend = bg_convert_slot<true>(A, slot, scr, F.lane, bv, bdst, bKd); };
              rwkv_scan_unit(F, unit, DEC, ASIG, AIN(32), AIN(33), RKV, Y, bgf, bg);
              if (first) nslot_done = (TPB / 32) * F.G * 4; }
          if (F.wave >= 4 && bpend) conv_tile_store(bv, bdst, bKd, (LAS float*)(F.lds + 98304 + (F.wave - 4) * 8448), F.lane);
          __syncthreads();
          { f32x4 tv[8]; bf16_t* td = nullptr; int tk = 0;
            for (int slot = nslot_done + F.gw; slot < BG_NSLOTS; slot += F.NGW) bg_convert_slot<false>(A, slot, (LAS float*)(F.lds + F.wave * 8448), F.lane, tv, td, tk); }
          if (BOTH(21)) GRID_BAR(); }
      PHASE(22) { for (int r = F.gw; r < ROWS; r += F.NGW) rwkv_readout_row(Y, RKV, ASIG, AIN(33), Gf, AIN(34), AIN(35), AIN(36), NBF, r, F.lane); if (BOTH(22)) GRID_BAR(); }
      PHASE(23) { pg8::EpiResid E{X, mods_l, 5, A.pad ? 0.f : 1.0f, nullptr};
          RUN_GEMM(pg8::EpiResid, E, NBF, ws + WS_W + W_RW_WO, DM, 32, 8, 0, 0, 1, 1, 2, 8, 0, 0, 4, 2); if (BOTH(23)) GRID_BAR(); }
    }
    FFN_PHASES(24, 1, 2, 0, 4);
    FFN_PHASES(27, 2, 0, 0, 11);
    { const float* mods_l = MODS + (size_t)2 * 3 * NMOD * DM;
      bf16_t* RAW = (bf16_t*)(mix + ML_RAW); bf16_t* CN = (bf16_t*)(mix + ML_CN); bf16_t* QRAW = (bf16_t*)(mix + ML_QRAW);
      bf16_t* Qb = (bf16_t*)(mix + ML_Q); bf16_t* Kb = (bf16_t*)(mix + ML_K); bf16_t* Vb = (bf16_t*)(mix + ML_V);
      PHASE(30) { const float* g = AIN(6) + (size_t)(2 * 3 + 1) * DM;
          for (int r = F.gw; r < ROWS; r += F.NGW) { f32x4 y[8]; modnorm_row(X, g, mods_l, 1, r, F.lane, y, PART, 11); store_row_bf16(NBF + (size_t)r * DM, F.lane, y); }
          if (BOTH(30)) GRID_BAR(); }
      PHASE(31) { pg8::EpiBf16B E{RAW, 1280, nullptr};
          RUN_GEMM(pg8::EpiBf16B, E, NBF, ws + WS_W + W_ML_WD, DM, NPAN, 5, 0, 0, 1, 0); if (BOTH(31)) GRID_BAR(); }
#define MLA_ROPE_TABLE() do { __syncthreads(); LAS f32x2* rt_ = (LAS f32x2*)F.lds;     \
          for (int e_ = F.tid; e_ < 64 * 16; e_ += NTHR) { float sn_, cs_; sincosf((float)(e_ >> 4) * rope_invfreq(e_ & 15, 16), &sn_, &cs_); rt_[e_] = (f32x2){cs_, sn_}; } __syncthreads(); } while (0)
      PHASE(32) { MLA_ROPE_TABLE(); for (int r = F.gw; r < ROWS; r += F.NGW) mla_row_a(RAW, AIN(39), AIN(41), CN, CN + (size_t)ROWS * 512, Kb, (const LAS f32x2*)F.lds, r, F.lane); if (BOTH(32)) GRID_BAR(); }
      PHASE(33) { pg8::EpiMla3 E{QRAW, Kb, Vb};
          RUN_GEMM(pg8::EpiMla3, E, CN, ws + WS_W + W_ML_BT3, 512, NPAN, 12, 0, 0, 1, 0, NPAN, 16, NPAN, 12, 1, 0); if (BOTH(33)) GRID_BAR(); }
      PHASE(34) { MLA_ROPE_TABLE(); for (int r = F.gw; r < ROWS; r += F.NGW) mla_row_q(QRAW, Qb, (const LAS f32x2*)F.lds, r, F.lane); if (BOTH(34)) GRID_BAR(); }
#undef MLA_ROPE_TABLE
      PHASE(35) { const int vc = (F.G % 8 == 0) ? (F.bid % 8) * (F.G / 8) + F.bid / 8 : F.bid;
          for (int i = 0;; ++i) { const int L = i * F.G + vc; if (L >= 544) break;
              int b, h, q0, seq; if (L < 512) { b = L >> 8; h = (L & 255) >> 4; q0 = b * TPB + CTXL + (L & 15) * 256; seq = TPB; } else { const int u = L - 512; b = u >> 4; h = u & 15; q0 = b * TPB; seq = CTXL; }
              __syncthreads();
              att::attn_dense_body<192, 3072, 3072, 2048, 2048>(Qb + (size_t)q0 * 3072 + h * 192, Kb + (size_t)b * TPB * 3072 + h * 192, Vb + (size_t)b * TPB * 2048 + h * 128, NBF + (size_t)q0 * DM + h * 128, seq, (char*)lds_raw); }
          if (BOTH(35)) GRID_BAR(); }
      PHASE(36) { pg8::EpiResid E{X, mods_l, 5, A.pad ? 0.f : 1.0f, nullptr};
          RUN_GEMM(pg8::EpiResid, E, NBF, ws + WS_W + W_ML_WO, DM, 32, 8, 0, 0, 1, 1, 2, 8, 0, 0, 4, 2); if (BOTH(36)) GRID_BAR(); }
    }
    FFN_PHASES(37, 2, 2, 0, 4);
    FFN_PHASES(40, 3, 0, 0, 11);
    { const float* mods_l = MODS + (size_t)3 * 3 * NMOD * DM;
      bf16_t* RAW = (bf16_t*)(mix + GQ_RAW); bf16_t* Qb = (bf16_t*)(mix + GQ_Q); bf16_t* Kb = (bf16_t*)(mix + GQ_K); bf16_t* Vb = (bf16_t*)(mix + GQ_V);
      PHASE(43) { const float* g = AIN(6) + (size_t)(3 * 3 + 1) * DM;
          for (int r = F.gw; r < ROWS; r += F.NGW) { f32x4 y[8]; modnorm_row(X, g, mods_l, 1, r, F.lane, y, PART, 11); store_row_bf16(NBF + (size_t)r * DM, F.lane, y); }
          if (BOTH(43)) GRID_BAR(); }
      PHASE(44) { pg8::EpiBf16B E{RAW, 4096, nullptr};
          RUN_GEMM(pg8::EpiBf16B, E, NBF, ws + WS_W + W_GQ_QKV, DM, NPAN, 16, 0, 0, 1, 0); if (BOTH(44)) GRID_BAR(); }
      PHASE(45) { __syncthreads();
          { LAS f32x2* rt = (LAS f32x2*)F.lds;
            for (int e = F.tid; e < 64 * 32; e += NTHR) { float sn, cs; sincosf((float)(e >> 5) * rope_invfreq(e & 31, 32), &sn, &cs); rt[e] = (f32x2){cs, sn}; }
            __syncthreads(); }
          for (int r = F.gw; r < ROWS; r += F.NGW) gqa_row(RAW, AIN(45), AIN(46), Qb, Kb, Vb, (const LAS f32x2*)F.lds, r, F.lane);
          if (BOTH(45)) GRID_BAR(); }
      PHASE(46) { const int vc = (F.G % 8 == 0) ? (F.bid % 8) * (F.G / 8) + F.bid / 8 : F.bid;
          for (int i = 0;; ++i) { const int L = i * F.G + vc; if (L >= 512) break;
              const int b = L >> 8, h = (L & 255) >> 4, q0 = b * TPB + CTXL + (L & 15) * 256;
              __syncthreads();
#ifdef STAMP_PH
              att::attn_dense_body<128, 2048, 1024, 1024, 2048>(
#else
              att::attn_dense_body2<128, 2048, 1024, 1024, 2048, 2>(
#endif
                  Qb + (size_t)q0 * 2048 + h * 128, Kb + (size_t)b * TPB * 1024 + (h >> 1) * 128, Vb + (size_t)b * TPB * 1024 + (h >> 1) * 128, NBF + (size_t)q0 * DM + h * 128, TPB, (char*)lds_raw); }
          if (BOTH(46)) GRID_BAR(); }
      PHASE(47) { pg8::EpiResid E{X, mods_l, 5, A.pad ? 0.f : 1.0f, nullptr};
          RUN_GEMM(pg8::EpiResid, E, NBF, ws + WS_W + W_GQ_WO, DM, 32, 8, 0, 0, 1, 1); if (BOTH(47)) GRID_BAR(); }
    }
    FFN_PHASES(48, 3, 2, 1, 0);
#ifdef EXTRA_BARS
    if (IN(51) && hi - lo > 1) { for (int eb = 0; eb < EXTRA_BARS; ++eb) GRID_BAR(); }
#endif
    PHASE(51) {
        const f32x4* fg = (const f32x4*)AIN(48) + F.lane;
        for (int i = F.gw; i < NB * SEQ; i += F.NGW) {
            const int b = i / SEQ, t = i % SEQ; const bf16_t* xr = X + ((size_t)b * TPB + CTXL + t) * DM + 4 * F.lane;
            f32x4 y[8]; float ss = 0.f;
#pragma unroll
            for (int j = 0; j < 8; ++j) { y[j] = ld4bf(xr + 256 * j); ss += (y[j].x * y[j].x + y[j].y * y[j].y) + (y[j].z * y[j].z + y[j].w * y[j].w); }
            const float rinv = rsqrtf(wave_sum(ss) * (1.0f / DM) + 1e-6f);
            f32x4* o = (f32x4*)(A.out + (size_t)i * DM) + F.lane;
#pragma unroll
            for (int j = 0; j < 8; ++j) o[64 * j] = y[j] * rinv * fg[64 * j];
        }
    }
#ifdef STAMP_PH
    __syncthreads(); if (F.bid == 0 && F.tid == 0) { const unsigned long long t0_ = ((unsigned long long)MISC[17] << 32) | MISC[16], t1_ = ((unsigned long long)MISC[19] << 32) | MISC[18]; int z_ = 0; asm volatile("" : "+s"(z_)); float* o_ = *(float* const*)((const char*)&A.out + z_); o_[0] = (float)(t1_ - t0_) * 0.01f; }
#endif
#undef IN
#undef BOTH
#undef GRID_BAR
#undef AIN
#undef ws
#undef MODS
#undef TW
#undef HIDA
#undef ADAP
#undef X
#undef NBF
#undef ACT
#undef mix
#undef PART
}

#ifndef MK_PER_PHASE
#define MK_PER_PHASE 0
#endif
extern "C" void kernel_launch(void* const* d_in, const int* in_sizes, int n_in, void* d_out, int out_size, void* d_ws, size_t ws_size, hipStream_t stream) {
    static int grid = 0;
    if (grid == 0) {
        if (n_in != 49 || ws_size < WS_END) { fprintf(stderr, "kernel_launch: expected 49 inputs and >= %zu bytes of workspace; got %d, %zu\n", (size_t)WS_END, n_in, ws_size); grid = -1; return; }
        int dev = 0, cus = 0;
        if (hipGetDevice(&dev) != hipSuccess || hipDeviceGetAttribute(&cus, hipDeviceAttributeMultiprocessorCount, dev) != hipSuccess) { grid = -1; return; }
        if (hipFuncSetAttribute((const void*)fwd_kernel, hipFuncAttributeMaxDynamicSharedMemorySize, LDS_BYTES) != hipSuccess) { fprintf(stderr, "kernel_launch: hipFuncSetAttribute failed\n"); grid = -1; return; }
        int per_cu = 0;
        if (hipOccupancyMaxActiveBlocksPerMultiprocessor(&per_cu, (const void*)fwd_kernel, NTHR, LDS_BYTES) != hipSuccess || per_cu < 1) fprintf(stderr, "kernel_launch: occupancy query reports %d\n", per_cu);
        (void)hipGetLastError();
        grid = cus;
    }
    if (grid < 0) return;
    (void)hipMemsetAsync((char*)d_ws + WS_CTL, 0, CTL_ZERO_BYTES, stream);
    Args a{};
    for (int i = 0; i < 49; ++i) a.in[i] = (const float*)d_in[i];
    a.out = (float*)d_out; a.ws = (unsigned char*)d_ws;
#if MK_PER_PHASE
    for (int p = 0; p < N_PHASES; ++p) { a.ph_lo = p; a.ph_hi = p + 1; hipLaunchKernelGGL(fwd_kernel, dim3(grid), dim3(NTHR), LDS_BYTES, stream, a); }
#elif defined(PROBE_PHASES)
    { const int pp[] = {PROBE_PHASES}; const int np = (int)(sizeof(pp) / sizeof(int)); int cur = 0, li = 0;
      for (int i = 0; i < np; ++i) { if (pp[i] > cur) { a.ph_lo = cur; a.ph_hi = pp[i]; a.li = li++; a.pad = 0; hipLaunchKernelGGL(fwd_kernel, dim3(grid), dim3(NTHR), LDS_BYTES, stream, a); }
          a.ph_lo = pp[i]; a.ph_hi = pp[i] + 1; a.li = li++; a.pad = 1; hipLaunchKernelGGL(fwd_kernel, dim3(grid), dim3(NTHR), LDS_BYTES, stream, a); cur = pp[i]; }
      a.ph_lo = cur; a.ph_hi = N_PHASES; a.li = li++; a.pad = 0; hipLaunchKernelGGL(fwd_kernel, dim3(grid), dim3(NTHR), LDS_BYTES, stream, a); }
#else
    a.ph_lo = 0; a.ph_hi = N_PHASES; a.li = 0; hipLaunchKernelGGL(fwd_kernel, dim3(grid), dim3(NTHR), LDS_BYTES, stream, a);
#endif
}
```
